# Optimizing an MI355X kernel written in HIP

```python
import math
import jax, jax.numpy as jnp
from jax import lax
import numpy as np

D_MODEL = 2048
BATCH = 4
SEQ = 2048
DEPTH = 1

MIX_WIDTH = D_MODEL
LRU_WIDTH = MIX_WIDTH // 2
LRU_BLOCKS = 8
LRU_BLOCK_DIM = LRU_WIDTH // LRU_BLOCKS
CONV_WIDTH = 4
LRU_C = 8.0
ATT_WIDTH = MIX_WIDTH - LRU_WIDTH
ATT_HEADS = 8
HEAD_DIM = ATT_WIDTH // ATT_HEADS
KV_LATENT = 256
IDX_HEADS = 16
IDX_DIM = 64
INDEX_TOPK = 256
Q_BLOCK = 128
REL_BUCKETS = 32
REL_MAX_DIST = 128
EPS = 1e-6

IN_SIZES = (
    LRU_WIDTH,
    LRU_WIDTH,
    ATT_HEADS * HEAD_DIM,
    KV_LATENT,
    ATT_WIDTH,
    IDX_HEADS * IDX_DIM,
    IDX_DIM,
    IDX_HEADS,
)
IN_COLS = sum(IN_SIZES)
IN_SPLITS = tuple(int(v) for v in np.cumsum(IN_SIZES)[:-1])

kernel_name = "hymba_rglru_dsa_hybrid"


def _rmsnorm(x, g):
    x32 = x.astype(jnp.float32)
    y = x32 * lax.rsqrt(jnp.mean(x32 * x32, axis=-1, keepdims=True) + EPS)
    return (y * g.astype(jnp.float32)).astype(x.dtype)


def _layernorm(x, g, b):
    x32 = x.astype(jnp.float32)
    mu = jnp.mean(x32, axis=-1, keepdims=True)
    var = jnp.mean(jnp.square(x32 - mu), axis=-1, keepdims=True)
    y = (x32 - mu) * lax.rsqrt(var + EPS)
    return (y * g.astype(jnp.float32) + b.astype(jnp.float32)).astype(x.dtype)


def _t5_bucket(dist):
    n = jnp.maximum(dist, 0)
    max_exact = REL_BUCKETS // 2
    nf = jnp.maximum(n, 1).astype(jnp.float32)
    large = max_exact + (jnp.log(nf / max_exact) / math.log(REL_MAX_DIST / max_exact)
                         * (REL_BUCKETS - max_exact)).astype(jnp.int32)
    large = jnp.minimum(large, REL_BUCKETS - 1)
    return jnp.where(n < max_exact, n, large)


def _lru_combine(left, right):
    a1, b1 = left
    a2, b2 = right
    return a1 * a2, a2 * b1 + b2


def _rglru_branch(xa, conv_w, conv_b, wa, ba, wx, bx, lam):
    B, S, W = xa.shape
    xp = jnp.pad(xa, ((0, 0), (CONV_WIDTH - 1, 0), (0, 0)))
    xc = conv_b + sum(xp[:, j:j + S] * conv_w[j] for j in range(CONV_WIDTH))
    xb = xc.reshape(B, S, LRU_BLOCKS, LRU_BLOCK_DIM)
    r = jax.nn.sigmoid(jnp.einsum('bsgi,gij->bsgj', xb, wa).reshape(B, S, W) + ba)
    i = jax.nn.sigmoid(jnp.einsum('bsgi,gij->bsgj', xb, wx).reshape(B, S, W) + bx)
    log_a = -LRU_C * r.astype(jnp.float32) * jax.nn.softplus(-lam.astype(jnp.float32))
    a = jnp.exp(log_a)
    mult = jnp.sqrt(-jnp.expm1(2.0 * log_a))
    mult = jnp.where((jnp.arange(S) == 0)[None, :, None], 1.0, mult)
    bvals = mult * (i * xc).astype(jnp.float32)
    _, h = lax.associative_scan(_lru_combine, (a, bvals), axis=1)
    return h.astype(xa.dtype)


def _dsa_branch(q, ckv, qi, ki, wi, ckv_norm_g, ik_g, ik_b, w_uk, w_uv, rel_bias):
    B, S, _ = q.shape
    topk = min(INDEX_TOPK, S // 4)
    nblk = S // Q_BLOCK
    neg = jnp.finfo(jnp.float32).min
    q = q.reshape(B, S, ATT_HEADS, HEAD_DIM)
    q_abs = jnp.einsum('bshd,hdc->bshc', q, w_uk)
    c = _rmsnorm(ckv, ckv_norm_g)
    qi = qi.reshape(B, S, IDX_HEADS, IDX_DIM)
    ki = _layernorm(ki, ik_g, ik_b)
    wi = wi * (IDX_HEADS ** -0.5 * IDX_DIM ** -0.5)
    pos = jnp.arange(S, dtype=jnp.int32)

    def to_blocks(t):
        return jnp.moveaxis(t.reshape((B, nblk, Q_BLOCK) + t.shape[2:]), 1, 0)

    def block_fn(args):
        qa_b, qi_b, wi_b, pos_b = args
        s_idx = jnp.einsum('bqhd,bsd->bqhs', qi_b, ki).astype(jnp.float32)
        score = jnp.einsum('bqhs,bqh->bqs', jax.nn.relu(s_idx), wi_b.astype(jnp.float32))
        causal = pos[None, None, :] <= pos_b[None, :, None]
        score = jnp.where(causal, score, neg)
        _, sel = lax.top_k(score, topk)
        c_sel = jax.vmap(lambda cb, ib: cb[ib])(c, sel)
        logits = jnp.einsum('bqhc,bqkc->bqhk', qa_b, c_sel).astype(jnp.float32) * (HEAD_DIM ** -0.5)
        dist = pos_b[None, :, None] - sel
        bias = rel_bias[_t5_bucket(dist)].astype(jnp.float32)
        logits = logits + jnp.moveaxis(bias, -1, 2)
        logits = jnp.where((dist >= 0)[:, :, None, :], logits, neg)
        p = jax.nn.softmax(logits, axis=-1).astype(c.dtype)
        return jnp.einsum('bqhk,bqkc->bqhc', p, c_sel)

    o = lax.map(block_fn, (to_blocks(q_abs), to_blocks(qi), to_blocks(wi), pos.reshape(nblk, Q_BLOCK)))
    o = jnp.moveaxis(o, 0, 1).reshape(B, S, ATT_HEADS, KV_LATENT)
    out = jnp.einsum('bshc,hcd->bshd', o, w_uv)
    return out.reshape(B, S, ATT_WIDTH)


def setup_inputs(seed: int = 0) -> dict:
    key = jax.random.key(seed)
    ks = jax.random.split(key, 20)
    f32 = jnp.float32
    nrm = lambda k, shape, scale: jax.random.normal(k, shape, f32) * scale
    a0 = jax.random.uniform(ks[9], (DEPTH, LRU_WIDTH), f32, 0.9, 0.999)
    s0 = a0 ** (1.0 / LRU_C)
    lam = jnp.log(s0) - jnp.log1p(-s0)
    return {
        "x": nrm(ks[0], (BATCH, SEQ, D_MODEL), 1.0),
        "norm_g": 1.0 + nrm(ks[1], (DEPTH, D_MODEL), 0.02),
        "w_in": nrm(ks[2], (DEPTH, D_MODEL, IN_COLS), D_MODEL ** -0.5),
        "conv_w": nrm(ks[3], (DEPTH, CONV_WIDTH, LRU_WIDTH), CONV_WIDTH ** -0.5),
        "conv_b": nrm(ks[4], (DEPTH, LRU_WIDTH), 0.01),
        "lru_wa": nrm(ks[5], (DEPTH, LRU_BLOCKS, LRU_BLOCK_DIM, LRU_BLOCK_DIM), LRU_BLOCK_DIM ** -0.5),
        "lru_ba": nrm(ks[6], (DEPTH, LRU_WIDTH), 0.01),
        "lru_wx": nrm(ks[7], (DEPTH, LRU_BLOCKS, LRU_BLOCK_DIM, LRU_BLOCK_DIM), LRU_BLOCK_DIM ** -0.5),
        "lru_bx": nrm(ks[8], (DEPTH, LRU_WIDTH), 0.01),
        "lru_lambda": lam,
        "ckv_norm_g": 1.0 + nrm(ks[10], (DEPTH, KV_LATENT), 0.02),
        "idx_k_norm_g": 1.0 + nrm(ks[11], (DEPTH, IDX_DIM), 0.02),
        "idx_k_norm_b": nrm(ks[12], (DEPTH, IDX_DIM), 0.01),
        "w_uk": nrm(ks[13], (DEPTH, ATT_HEADS, HEAD_DIM, KV_LATENT), HEAD_DIM ** -0.5),
        "w_uv": nrm(ks[14], (DEPTH, ATT_HEADS, KV_LATENT, HEAD_DIM), KV_LATENT ** -0.5),
        "w_out": nrm(ks[15], (DEPTH, MIX_WIDTH, D_MODEL), MIX_WIDTH ** -0.5),
        "rel_bias": nrm(ks[16], (REL_BUCKETS, ATT_HEADS), 0.5),
        "final_norm_g": 1.0 + nrm(ks[17], (D_MODEL,), 0.02),
    }


def reference(x, norm_g, w_in, conv_w, conv_b, lru_wa, lru_ba, lru_wx, lru_bx, lru_lambda,
              ckv_norm_g, idx_k_norm_g, idx_k_norm_b, w_uk, w_uv, w_out, rel_bias, final_norm_g):
    for l in range(DEPTH):
        h = _rmsnorm(x, norm_g[l])
        proj = jnp.einsum('bsd,de->bse', h, w_in[l])
        xa, ga, q, ckv, gb, qi, ki, wi = jnp.split(proj, IN_SPLITS, axis=-1)
        ya = _rglru_branch(xa, conv_w[l], conv_b[l], lru_wa[l], lru_ba[l],
                           lru_wx[l], lru_bx[l], lru_lambda[l]) * jax.nn.silu(ga)
        yb = _dsa_branch(q, ckv, qi, ki, wi, ckv_norm_g[l], idx_k_norm_g[l], idx_k_norm_b[l],
                         w_uk[l], w_uv[l], rel_bias) * jax.nn.silu(gb)
        y = jnp.concatenate([ya, yb], axis=-1)
        x = x + jnp.einsum('bse,ed->bsd', y, w_out[l])
    return _rmsnorm(x, final_norm_g)
```

```cpp
#include <hip/hip_runtime.h>
#include <cstdint>
#include <cstdio>

constexpr int BATCH = 4, SEQ = 2048, DM = 2048, M = BATCH * SEQ;
constexpr int LRU_W = 1024, LRU_BLK = 8, LRU_BD = 128;
constexpr int ATT_W = 1024, NH = 8, HD = 128, CL = 256, IH = 16, ID = 64, TOPK = 256;
constexpr int C_XA = 0, C_GA = 1024, C_Q = 2048, C_CKV = 3072, C_GB = 3328, C_QI = 4352, C_KI = 5376, C_WI = 5440, NIN = 5456;
constexpr float EPS = 1e-6f;

__constant__ unsigned char BUCKET[128] = {0, 1, 2, 3, 4, 5, 6, 7, 8, 9, 10, 11, 12, 13, 14, 15, 16, 16, 16, 17, 17, 18, 18, 18, 19, 19, 19, 20, 20, 20, 20, 21, 21, 21, 21, 22, 22, 22, 22, 22, 23, 23, 23, 23, 23, 23, 24, 24, 24, 24, 24, 24, 25, 25, 25, 25, 25, 25, 25, 26, 26, 26, 26, 26, 26, 26, 26, 27, 27, 27, 27, 27, 27, 27, 27, 27, 27, 28, 28, 28, 28, 28, 28, 28, 28, 28, 28, 29, 29, 29, 29, 29, 29, 29, 29, 29, 29, 29, 29, 30, 30, 30, 30, 30, 30, 30, 30, 30, 30, 30, 30, 30, 30, 31, 31, 31, 31, 31, 31, 31, 31, 31, 31, 31, 31, 31, 31, 31};

__device__ __forceinline__ float sigmoidf_(float x) { return 1.f / (1.f + expf(-x)); }
__device__ __forceinline__ float siluf_(float x) { return x / (1.f + expf(-x)); }

__device__ __forceinline__ float block_sum_256(float v, float* red) {
#pragma unroll
    for (int o = 32; o > 0; o >>= 1) v += __shfl_xor(v, o);
    const int w = threadIdx.x >> 6;
    __syncthreads();
    if ((threadIdx.x & 63) == 0) red[w] = v;
    __syncthreads();
    return red[0] + red[1] + red[2] + red[3];
}

__global__ void __launch_bounds__(256) rms_kernel(const float* __restrict__ x, const float* __restrict__ g, float* __restrict__ out) {
    __shared__ float red[4];
    const int row = blockIdx.x; const float* xr = x + (size_t)row * DM;
    float v[8]; float s = 0.f;
#pragma unroll
    for (int j = 0; j < 8; ++j) { v[j] = xr[threadIdx.x + 256 * j]; s += v[j] * v[j]; }
    s = block_sum_256(s, red);
    const float r = rsqrtf(s * (1.f / DM) + EPS);
#pragma unroll
    for (int j = 0; j < 8; ++j) out[(size_t)row * DM + threadIdx.x + 256 * j] = v[j] * r * g[threadIdx.x + 256 * j];
}

__global__ void __launch_bounds__(256) final_kernel(const float* __restrict__ x, const float* __restrict__ g, float* out) {
    __shared__ float red[4];
    const int row = blockIdx.x; const float* xr = x + (size_t)row * DM; float* orow = out + (size_t)row * DM;
    float v[8]; float s = 0.f;
#pragma unroll
    for (int j = 0; j < 8; ++j) { v[j] = xr[threadIdx.x + 256 * j] + orow[threadIdx.x + 256 * j]; s += v[j] * v[j]; }
    s = block_sum_256(s, red);
    const float r = rsqrtf(s * (1.f / DM) + EPS);
#pragma unroll
    for (int j = 0; j < 8; ++j) orow[threadIdx.x + 256 * j] = v[j] * r * g[threadIdx.x + 256 * j];
}

__global__ void __launch_bounds__(256) gemm_f32(const float* __restrict__ A, int lda, size_t sA, const float* __restrict__ B, int ldb, size_t sB,
                                                 float* __restrict__ C, int ldc, size_t sC, int Mm, int Nn, int Kk) {
    __shared__ float As[16][64 + 4];
    __shared__ float Bs[16][64 + 4];
    A += sA * blockIdx.z; B += sB * blockIdx.z; C += sC * blockIdx.z;
    const int m0 = blockIdx.y * 64, n0 = blockIdx.x * 64, tid = threadIdx.x, tx = tid & 15, ty = tid >> 4;
    float acc[4][4];
#pragma unroll
    for (int i = 0; i < 4; ++i)
#pragma unroll
        for (int j = 0; j < 4; ++j) acc[i][j] = 0.f;
    for (int k0 = 0; k0 < Kk; k0 += 16) {
#pragma unroll
        for (int i = 0; i < 4; ++i) { const int e = tid + 256 * i, r = e >> 4, c = e & 15; As[c][r] = A[(size_t)(m0 + r) * lda + k0 + c]; }
#pragma unroll
        for (int i = 0; i < 4; ++i) { const int e = tid + 256 * i, r = e >> 6, c = e & 63; Bs[r][c] = (n0 + c < Nn) ? B[(size_t)(k0 + r) * ldb + n0 + c] : 0.f; }
        __syncthreads();
#pragma unroll
        for (int k = 0; k < 16; ++k) {
            float a[4], b[4];
#pragma unroll
            for (int i = 0; i < 4; ++i) { a[i] = As[k][ty * 4 + i]; b[i] = Bs[k][tx * 4 + i]; }
#pragma unroll
            for (int i = 0; i < 4; ++i)
#pragma unroll
                for (int j = 0; j < 4; ++j) acc[i][j] += a[i] * b[j];
        }
        __syncthreads();
    }
#pragma unroll
    for (int i = 0; i < 4; ++i)
#pragma unroll
        for (int j = 0; j < 4; ++j) { const int n = n0 + tx * 4 + j; if (n < Nn) C[(size_t)(m0 + ty * 4 + i) * ldc + n] = acc[i][j]; }
}

__global__ void __launch_bounds__(256) conv_kernel(const float* __restrict__ proj, const float* __restrict__ cw, const float* __restrict__ cb, float* __restrict__ xc) {
    const size_t e = (size_t)blockIdx.x * 256 + threadIdx.x; const int row = (int)(e >> 10), ch = (int)(e & 1023), t = row & (SEQ - 1);
    float v = cb[ch];
#pragma unroll
    for (int j = 0; j < 4; ++j) { const int tt = t - 3 + j; if (tt >= 0) v += proj[(size_t)(row - 3 + j) * NIN + C_XA + ch] * cw[j * LRU_W + ch]; }
    xc[e] = v;
}

__global__ void __launch_bounds__(256) gates_kernel(float* xc, float* __restrict__ abuf, const float* __restrict__ wa, const float* __restrict__ ba,
                                                     const float* __restrict__ wx, const float* __restrict__ bx, const float* __restrict__ lam) {
    __shared__ float xs[16][128];
    const int g = blockIdx.x, r0 = blockIdx.y * 16, tid = threadIdx.x;
#pragma unroll
    for (int i = 0; i < 8; ++i) { const int e = tid + 256 * i, r = e >> 7, c = e & 127; xs[r][c] = xc[(size_t)(r0 + r) * LRU_W + g * 128 + c]; }
    __syncthreads();
    const int j = tid & 127, rh = tid >> 7;
    float ar[8], ai[8];
#pragma unroll
    for (int r = 0; r < 8; ++r) { ar[r] = 0.f; ai[r] = 0.f; }
    const float* wag = wa + (size_t)g * 128 * 128; const float* wxg = wx + (size_t)g * 128 * 128;
    for (int i = 0; i < 128; ++i) {
        const float w1 = wag[i * 128 + j], w2 = wxg[i * 128 + j];
#pragma unroll
        for (int r = 0; r < 8; ++r) { const float xv = xs[rh * 8 + r][i]; ar[r] += xv * w1; ai[r] += xv * w2; }
    }
    const int ch = g * 128 + j;
    const float sp = log1pf(expf(-lam[ch]));
    const float bav = ba[ch], bxv = bx[ch];
#pragma unroll
    for (int r = 0; r < 8; ++r) {
        const int row = r0 + rh * 8 + r, t = row & (SEQ - 1);
        const float rg = sigmoidf_(ar[r] + bav), ig = sigmoidf_(ai[r] + bxv);
        const float la = -8.f * rg * sp; const float a = expf(la);
        float mult = sqrtf(-expm1f(2.f * la)); if (t == 0) mult = 1.f;
        const float bv = mult * (ig * xs[rh * 8 + r][j]);
        abuf[(size_t)row * LRU_W + ch] = a;
        xc[(size_t)row * LRU_W + ch] = bv;
    }
}

__global__ void __launch_bounds__(64) scan_kernel(const float* __restrict__ abuf, const float* __restrict__ bbuf, const float* __restrict__ proj, float* __restrict__ y) {
    const int gid = blockIdx.x * 64 + threadIdx.x, b = gid >> 10, ch = gid & 1023;
    float h = 0.f;
    for (int t = 0; t < SEQ; ++t) {
        const size_t row = (size_t)b * SEQ + t;
        h = abuf[row * LRU_W + ch] * h + bbuf[row * LRU_W + ch];
        y[row * DM + ch] = h * siluf_(proj[row * NIN + C_GA + ch]);
    }
}

__global__ void __launch_bounds__(256) norms_kernel(const float* __restrict__ proj, const float* __restrict__ cg, const float* __restrict__ kg, const float* __restrict__ kb,
                                                     float* __restrict__ cbuf, float* __restrict__ kin) {
    __shared__ float red[4];
    const int row = blockIdx.x, tid = threadIdx.x;
    const float v = proj[(size_t)row * NIN + C_CKV + tid];
    const float ss = block_sum_256(v * v, red);
    cbuf[(size_t)row * CL + tid] = v * rsqrtf(ss * (1.f / CL) + EPS) * cg[tid];
    const float kv = tid < 64 ? proj[(size_t)row * NIN + C_KI + tid] : 0.f;
    const float mu = block_sum_256(kv, red) * (1.f / ID);
    const float d = tid < 64 ? kv - mu : 0.f;
    const float var = block_sum_256(d * d, red) * (1.f / ID);
    if (tid < 64) kin[(size_t)row * ID + tid] = d * rsqrtf(var + EPS) * kg[tid] + kb[tid];
}

__device__ __forceinline__ unsigned fkey(float f) { const unsigned u = __float_as_uint(f); return (u & 0x80000000u) ? ~u : (u | 0x80000000u); }
__global__ void __launch_bounds__(256) index_kernel(const float* __restrict__ proj, const float* __restrict__ kin, int* __restrict__ sel) {
    __shared__ float qs[IH * ID];
    __shared__ float ws_[IH];
    __shared__ unsigned keys[SEQ];
    __shared__ int redi[8];
    __shared__ int scan_a[256], scan_b[256];
    const int row = blockIdx.x, b = row >> 11, t = row & (SEQ - 1), tid = threadIdx.x, n = t + 1;
#pragma unroll
    for (int i = 0; i < 4; ++i) qs[tid + 256 * i] = proj[(size_t)row * NIN + C_QI + tid + 256 * i];
    if (tid < IH) ws_[tid] = proj[(size_t)row * NIN + C_WI + tid] * 0.03125f;
    __syncthreads();
    for (int s = tid; s < SEQ; s += 256) {
        unsigned kk = 0u;
        if (s < n) {
            const float* kr = kin + ((size_t)b * SEQ + s) * ID;
            float kvv[ID];
#pragma unroll
            for (int d = 0; d < ID; ++d) kvv[d] = kr[d];
            float sc = 0.f;
            for (int h = 0; h < IH; ++h) { float dsum = 0.f;
#pragma unroll
                for (int d = 0; d < ID; ++d) dsum += qs[h * ID + d] * kvv[d];
                sc += fmaxf(dsum, 0.f) * ws_[h]; }
            kk = fkey(sc); if (kk == 0u) kk = 1u;
        }
        keys[s] = kk;
    }
    __syncthreads();
    int* out = sel + (size_t)row * TOPK;
    if (n <= TOPK) { out[tid] = tid < n ? tid : -1; return; }
    unsigned lo = 0u, hi = 0xFFFFFFFFu;
    while (lo < hi) {
        const unsigned mid = lo + (unsigned)(((unsigned long long)hi - lo + 1ull) >> 1);
        int c = 0;
        for (int s = tid; s < SEQ; s += 256) c += keys[s] >= mid;
#pragma unroll
        for (int o = 32; o > 0; o >>= 1) c += __shfl_xor(c, o);
        __syncthreads();
        if ((tid & 63) == 0) redi[tid >> 6] = c;
        __syncthreads();
        c = redi[0] + redi[1] + redi[2] + redi[3];
        if (c >= TOPK) lo = mid; else hi = mid - 1u;
    }
    const unsigned K = lo;
    int cg = 0, ce = 0;
#pragma unroll
    for (int i = 0; i < 8; ++i) { const unsigned kk = keys[tid * 8 + i]; cg += kk > K; ce += kk == K; }
    scan_a[tid] = cg; scan_b[tid] = ce;
    __syncthreads();
    if (tid == 0) { int sa = 0, sb = 0; for (int i = 0; i < 256; ++i) { const int a = scan_a[i], bb = scan_b[i]; scan_a[i] = sa; scan_b[i] = sb; sa += a; sb += bb; } redi[4] = sa; }
    __syncthreads();
    const int total_gt = redi[4], need_eq = TOPK - total_gt;
    int pg = scan_a[tid], pe = scan_b[tid];
#pragma unroll
    for (int i = 0; i < 8; ++i) { const unsigned kk = keys[tid * 8 + i];
        if (kk > K) { out[pg + (pe < need_eq ? pe : need_eq)] = tid * 8 + i; ++pg; }
        else if (kk == K) { if (pe < need_eq) out[pg + pe] = tid * 8 + i; ++pe; } }
}

__global__ void __launch_bounds__(256) attn_kernel(const float* __restrict__ proj, const float* __restrict__ qabs, const float* __restrict__ cbuf, const int* __restrict__ sel,
                                                    const float* __restrict__ w_uv, const float* __restrict__ rel_bias, float* __restrict__ y) {
    __shared__ float qa[NH * CL];
    __shared__ float lg[NH][TOPK];
    __shared__ float os[NH * CL];
    __shared__ int idx[TOPK];
    const int row = blockIdx.x, b = row >> 11, t = row & (SEQ - 1), tid = threadIdx.x;
#pragma unroll
    for (int i = 0; i < 8; ++i) qa[tid + 256 * i] = qabs[(size_t)row * (NH * CL) + tid + 256 * i];
    idx[tid] = sel[(size_t)row * TOPK + tid];
    __syncthreads();
    {
        const int s = idx[tid];
        float l[NH];
        if (s >= 0) {
            const float* cr = cbuf + ((size_t)b * SEQ + s) * CL;
#pragma unroll
            for (int h = 0; h < NH; ++h) l[h] = 0.f;
            for (int c = 0; c < CL; ++c) { const float cv = cr[c];
#pragma unroll
                for (int h = 0; h < NH; ++h) l[h] += qa[h * CL + c] * cv; }
            const int dist = t - s; const int bk = dist < 128 ? (int)BUCKET[dist] : 31;
#pragma unroll
            for (int h = 0; h < NH; ++h) l[h] = l[h] * 0.08838834764831845f + rel_bias[bk * NH + h];
        } else {
#pragma unroll
            for (int h = 0; h < NH; ++h) l[h] = -INFINITY;
        }
#pragma unroll
        for (int h = 0; h < NH; ++h) lg[h][tid] = l[h];
    }
    __syncthreads();
    {
        const int w = tid >> 6, lane = tid & 63;
        for (int hh = 0; hh < 2; ++hh) { const int h = w * 2 + hh;
            float v[4], mx = -INFINITY;
#pragma unroll
            for (int i = 0; i < 4; ++i) { v[i] = lg[h][lane + 64 * i]; mx = fmaxf(mx, v[i]); }
#pragma unroll
            for (int o = 32; o > 0; o >>= 1) mx = fmaxf(mx, __shfl_xor(mx, o));
            float sm = 0.f;
#pragma unroll
            for (int i = 0; i < 4; ++i) { v[i] = expf(v[i] - mx); sm += v[i]; }
#pragma unroll
            for (int o = 32; o > 0; o >>= 1) sm += __shfl_xor(sm, o);
            const float inv = 1.f / sm;
#pragma unroll
            for (int i = 0; i < 4; ++i) lg[h][lane + 64 * i] = v[i] * inv; }
    }
    __syncthreads();
    {
        float o[NH];
#pragma unroll
        for (int h = 0; h < NH; ++h) o[h] = 0.f;
        for (int j = 0; j < TOPK; ++j) { const int s = idx[j]; if (s < 0) continue;
            const float cv = cbuf[((size_t)b * SEQ + s) * CL + tid];
#pragma unroll
            for (int h = 0; h < NH; ++h) o[h] += lg[h][j] * cv; }
#pragma unroll
        for (int h = 0; h < NH; ++h) os[h * CL + tid] = o[h];
    }
    __syncthreads();
#pragma unroll
    for (int i = 0; i < 4; ++i) { const int h = i * 2 + (tid >> 7), d = tid & 127;
        const float* wv = w_uv + (size_t)h * CL * HD + d; float acc = 0.f;
        for (int c = 0; c < CL; ++c) acc += os[h * CL + c] * wv[(size_t)c * HD];
        const float gb = proj[(size_t)row * NIN + C_GB + h * HD + d];
        y[(size_t)row * DM + LRU_W + h * HD + d] = acc * siluf_(gb); }
}

extern "C" void kernel_launch(void* const* d_in, const int* in_sizes, int n_in, void* d_out, int out_size, void* d_ws, size_t ws_size, hipStream_t stream) {
    const float* x = (const float*)d_in[0]; const float* norm_g = (const float*)d_in[1]; const float* w_in = (const float*)d_in[2];
    const float* conv_w = (const float*)d_in[3]; const float* conv_b = (const float*)d_in[4]; const float* wa = (const float*)d_in[5];
    const float* ba = (const float*)d_in[6]; const float* wx = (const float*)d_in[7]; const float* bx = (const float*)d_in[8];
    const float* lam = (const float*)d_in[9]; const float* ckv_g = (const float*)d_in[10]; const float* ikg = (const float*)d_in[11];
    const float* ikb = (const float*)d_in[12]; const float* w_uk = (const float*)d_in[13]; const float* w_uv = (const float*)d_in[14];
    const float* w_out = (const float*)d_in[15]; const float* rel_bias = (const float*)d_in[16]; const float* fin_g = (const float*)d_in[17];
    float* out = (float*)d_out; char* ws = (char*)d_ws;
    const size_t MiB = 1u << 20;
    float* proj = (float*)ws;
    float* Hb = (float*)(ws + 171 * MiB);
    float* cbuf = (float*)(ws + 235 * MiB);
    float* kin = (float*)(ws + 243 * MiB);
    int* sel = (int*)(ws + 245 * MiB);
    float* xc = out;
    float* abuf = out + (size_t)M * LRU_W;
    float* qabs = out;
    float* y = Hb;

    rms_kernel<<<M, 256, 0, stream>>>(x, norm_g, Hb);
    gemm_f32<<<dim3((NIN + 63) / 64, M / 64, 1), 256, 0, stream>>>(Hb, DM, 0, w_in, NIN, 0, proj, NIN, 0, M, NIN, DM);
    conv_kernel<<<(M * LRU_W) / 256, 256, 0, stream>>>(proj, conv_w, conv_b, xc);
    gates_kernel<<<dim3(LRU_BLK, M / 16), 256, 0, stream>>>(xc, abuf, wa, ba, wx, bx, lam);
    scan_kernel<<<(BATCH * LRU_W) / 64, 64, 0, stream>>>(abuf, xc, proj, y);
    gemm_f32<<<dim3(CL / 64, M / 64, NH), 256, 0, stream>>>(proj + C_Q, NIN, HD, w_uk, CL, (size_t)HD * CL, qabs, NH * CL, CL, M, CL, HD);
    norms_kernel<<<M, 256, 0, stream>>>(proj, ckv_g, ikg, ikb, cbuf, kin);
    index_kernel<<<M, 256, 0, stream>>>(proj, kin, sel);
    attn_kernel<<<M, 256, 0, stream>>>(proj, qabs, cbuf, sel, w_uv, rel_bias, y);
    gemm_f32<<<dim3(DM / 64, M / 64, 1), 256, 0, stream>>>(y, DM, 0, w_out, DM, 0, out, DM, 0, M, DM, DM);
    final_kernel<<<M, 256, 0, stream>>>(x, fin_g, out);
}
```

```cpp
#include <hip/hip_runtime.h>
#include <cstdio>
#include <cstdint>
namespace pg8 {
#define PG8_LAS __attribute__((address_space(3)))
typedef unsigned short bf16_t;
typedef _Float16 f16x8 __attribute__((ext_vector_type(8)));
typedef _Float16 f16x2 __attribute__((ext_vector_type(2)));
typedef float f32x2 __attribute__((ext_vector_type(2)));
typedef float f32x4 __attribute__((ext_vector_type(4)));
typedef unsigned u32x4 __attribute__((ext_vector_type(4)));
constexpr int BM = 256, BK = 64, HALF = 128, HTB = HALF * BK * 2  , STAGE_BYTES = 8 * HTB, NXCD = 8, WGM = 8;

__host__ __device__ __forceinline__ int lds_byte(int r, int c) { const int st = (r >> 4) * 2 + (c >> 5), rr = r & 15, cc = c & 31, ob = rr * 64 + cc * 2; return st * 1024 + (ob ^ (((ob >> 9) & 1) << 5)); }
__host__ __device__ __forceinline__ void stage_rc(int b, int& R, int& C) { const int st = b / 1024, sb = b % 1024, swz = sb ^ (((sb >> 9) & 1) << 5); R = (st >> 1) * 16 + swz / 64; C = (st & 1) * 32 + (swz % 64) / 2; }
__host__ __device__ __forceinline__ int perm32(int rho) { const int n = rho >> 4, i = rho & 15; return 8 * (i >> 2) + 4 * n + (i & 3); }

struct Unit { int pm, pn; };
struct Gemm { const bf16_t* A; const bf16_t* Bt; int M, N, K; };

struct StaticOrder {
    int nM, nN, nwg, G, c;
    __host__ __device__ void init(int M, int N, int G_, int c_) { nM = M / BM; nN = N / BM; nwg = nM * nN; G = G_; c = c_; }
    __host__ __device__ bool next(int i, Unit& u) const {
        const long L = (long)i * G + c; if (L >= nwg) return false;
        int wgid = (int)L; { const int q = nwg / NXCD, r = nwg % NXCD, xcd = wgid % NXCD, off = wgid / NXCD; wgid = (xcd < r ? xcd * (q + 1) : r * (q + 1) + (xcd - r) * q) + off; }
        const int nig = WGM * nN, gid = wgid / nig, fm = gid * WGM, gsz = (nM - fm) < WGM ? (nM - fm) : WGM;
        u.pm = fm + ((wgid % nig) % gsz); u.pn = (wgid % nig) / gsz; return true;
    }
    __device__ __forceinline__ void a_ready(const Unit&) const {}
    __device__ __forceinline__ void done(const Unit&) const {}
};

__device__ __forceinline__ unsigned cvt_pk_f16(float lo, float hi) { const f32x2 v = {lo, hi}; return __builtin_bit_cast(unsigned, __builtin_convertvector(v, f16x2)); }
struct EpiF16 {
    static constexpr bool PERM = true, AFTER_DRAIN = false;
    bf16_t* O; int ldc;
    __device__ __forceinline__ void operator()(const f32x4 (&acc)[2][2][4][2], const Unit& u, int wr, int wc, int fr, int fq) const {
        const int row0 = u.pm * BM + wr * 64 + fr, col0 = u.pn * BM + wc * 32 + 8 * fq;
#pragma unroll
        for (int ai = 0; ai < 2; ++ai)
#pragma unroll
            for (int m = 0; m < 4; ++m) { bf16_t* rowp = O + (size_t)(row0 + ai * HALF + m * 16) * ldc + col0;
#pragma unroll
                for (int bj = 0; bj < 2; ++bj) { const f32x4 v0 = acc[ai][bj][m][0], v1 = acc[ai][bj][m][1];
                    u32x4 w; w.x = cvt_pk_f16(v0[0], v0[1]); w.y = cvt_pk_f16(v0[2], v0[3]); w.z = cvt_pk_f16(v1[0], v1[1]); w.w = cvt_pk_f16(v1[2], v1[3]);
                    *(u32x4*)(rowp + bj * HALF) = w; } }
    }
};
struct EpiResF32 {
    static constexpr bool PERM = false, AFTER_DRAIN = false;
    const float* base; float* out; int ldc;
    __device__ __forceinline__ void operator()(const f32x4 (&acc)[2][2][4][2], const Unit& u, int wr, int wc, int fr, int fq) const {
        const int row0 = u.pm * BM + wr * 64 + fr, col0 = u.pn * BM + wc * 32 + 4 * fq;
#pragma unroll
        for (int ai = 0; ai < 2; ++ai)
#pragma unroll
            for (int m = 0; m < 4; ++m) { const size_t off = (size_t)(row0 + ai * HALF + m * 16) * ldc + col0;
#pragma unroll
                for (int bj = 0; bj < 2; ++bj)
#pragma unroll
                    for (int n = 0; n < 2; ++n) *(f32x4*)(out + off + bj * HALF + n * 16) = *(const f32x4*)(base + off + bj * HALF + n * 16) + acc[ai][bj][m][n]; }
    }
};

template <class Epi, class Sched, bool ALIGN_EPI = false, bool SP2 = false>
__device__ __forceinline__ void gemm_phase(PG8_LAS unsigned char* lds, const Gemm g, const Sched& S, const Epi& E) {
    const int tid = threadIdx.x, wid = __builtin_amdgcn_readfirstlane(tid >> 6), lane = tid & 63, wr = wid >> 2, wc = wid & 3, fr = lane & 15, fq = lane >> 4;
    const int K = g.K, nt = K / BK;
    unsigned voffA[2], voffB[2];
#pragma unroll
    for (int i = 0; i < 2; ++i) { int R, C; stage_rc(tid * 16 + i * 8192, R, C); const int Rb = Epi::PERM ? ((R & ~31) + perm32(R & 31)) : R;
        voffA[i] = (unsigned)(R * K + C) * 2u; voffB[i] = (unsigned)(Rb * K + C) * 2u; }
    const size_t kstep = (size_t)(BK * 2);
    const size_t hstep = (size_t)HALF * K * 2;
    const size_t tstep = 2 * hstep;
    const unsigned ldsw = (unsigned)wid * 1024u;
    const int aoff = lds_byte(wr * 64 + fr, fq * 8), boff = lds_byte(wc * 32 + fr, fq * 8);
#define PG8_SA(b, h) (((b) * 2 + (h)) * HTB)
#define PG8_SB(b, h) ((4 + (b) * 2 + (h)) * HTB)
#define PG8_STAGE(bufoff, gbase, voff) do { _Pragma("unroll") for (int _i = 0; _i < 2; ++_i) \
        __builtin_amdgcn_global_load_lds((const unsigned*)((const char*)(gbase) + (voff)[_i]), (PG8_LAS unsigned*)(lds + (bufoff) + ldsw + _i * 8192), 16, 0, 0); } while (0)
#define PG8_LDA(dst, b, h) do { _Pragma("unroll") for (int m = 0; m < 4; ++m) _Pragma("unroll") for (int k = 0; k < 2; ++k) dst[m][k] = *(const PG8_LAS f16x8*)(lds + PG8_SA(b, h) + aoff + m * 2048 + k * 1024); } while (0)
#define PG8_LDB(dst, b, h) do { _Pragma("unroll") for (int n = 0; n < 2; ++n) _Pragma("unroll") for (int k = 0; k < 2; ++k) dst[n][k] = *(const PG8_LAS f16x8*)(lds + PG8_SB(b, h) + boff + n * 2048 + k * 1024); } while (0)
#define PG8_MMA(ai, bj, At, Bt) do { __builtin_amdgcn_s_setprio(1); _Pragma("unroll") for (int m = 0; m < 4; ++m) _Pragma("unroll") for (int n = 0; n < 2; ++n) _Pragma("unroll") for (int k = 0; k < 2; ++k) \
        acc[ai][bj][m][n] = __builtin_amdgcn_mfma_f32_16x16x32_f16(Bt[n][k], At[m][k], acc[ai][bj][m][n], 0, 0, 0); __builtin_amdgcn_s_setprio(0); } while (0)
#define PG8_WAIT_V(n) asm volatile("s_waitcnt vmcnt(" #n ")" ::: "memory")
#define PG8_WAIT_L(n) asm volatile("s_waitcnt lgkmcnt(" #n ")" ::: "memory")
#define PG8_BAR __builtin_amdgcn_s_barrier()
#define PG8_SCHED __builtin_amdgcn_sched_barrier(0)
    Unit cur, nxt; int ui = 0;
    if (!S.next(0, cur)) return;
    f32x4 acc[2][2][4][2];
#pragma unroll
    for (int a = 0; a < 2; ++a)
#pragma unroll
        for (int b = 0; b < 2; ++b)
#pragma unroll
            for (int m = 0; m < 4; ++m)
#pragma unroll
                for (int n = 0; n < 2; ++n) acc[a][b][m][n] = (f32x4){0.f, 0.f, 0.f, 0.f};
    f16x8 At[4][2], B0[2][2], B1[2][2];
    const char* cA = (const char*)g.A + (size_t)cur.pm * tstep; const char* cB = (const char*)g.Bt + (size_t)cur.pn * tstep;
    S.a_ready(cur);
    if constexpr (SP2) {
        PG8_STAGE(PG8_SB(0, 0), cB, voffB); PG8_STAGE(PG8_SB(0, 1), cB + hstep, voffB); PG8_STAGE(PG8_SA(0, 0), cA, voffA); PG8_STAGE(PG8_SA(0, 1), cA + hstep, voffA);
        if (wr == 1) PG8_BAR;
        PG8_WAIT_V(2); PG8_BAR;
        PG8_STAGE(PG8_SB(1, 0), cB + kstep, voffB); PG8_STAGE(PG8_SA(1, 0), cA + kstep, voffA); PG8_STAGE(PG8_SB(1, 1), cB + hstep + kstep, voffB);
        PG8_WAIT_V(6); PG8_BAR;
    } else {
        PG8_STAGE(PG8_SB(0, 0), cB, voffB); PG8_STAGE(PG8_SA(0, 0), cA, voffA); PG8_STAGE(PG8_SB(0, 1), cB + hstep, voffB); PG8_STAGE(PG8_SA(0, 1), cA + hstep, voffA);
        if (wr == 1) PG8_BAR;
        PG8_WAIT_V(4); PG8_BAR;
        PG8_STAGE(PG8_SB(1, 0), cB + kstep, voffB); PG8_STAGE(PG8_SA(1, 0), cA + kstep, voffA); PG8_STAGE(PG8_SB(1, 1), cB + hstep + kstep, voffB);
        PG8_WAIT_V(6); PG8_BAR;
    }
    for (;;) {
        const bool has_next = S.next(ui + 1, nxt);
        const char* nA = has_next ? (const char*)g.A + (size_t)nxt.pm * tstep : cA; const char* nB = has_next ? (const char*)g.Bt + (size_t)nxt.pn * tstep : cB;
        for (int t = 0; t < nt; t += 2) {
            const bool last = (t == nt - 2);
            const char* a1 = cA + (size_t)(t + 1) * kstep;
            const char* a2 = last ? nA : cA + (size_t)(t + 2) * kstep; const char* b2 = last ? nB : cB + (size_t)(t + 2) * kstep;
            const char* a3 = a2 + kstep; const char* b3 = b2 + kstep;
            if (last && has_next) S.a_ready(nxt);
            if constexpr (SP2) {
            PG8_LDB(B0, 0, 0); PG8_LDB(B1, 0, 1); PG8_SCHED; PG8_LDA(At, 0, 0); PG8_STAGE(PG8_SA(1, 1), a1 + hstep, voffA);
            PG8_WAIT_V(8); PG8_WAIT_L(0); PG8_BAR; PG8_MMA(0, 0, At, B0); PG8_MMA(0, 1, At, B1); PG8_BAR; PG8_SCHED;
            PG8_LDA(At, 0, 1); PG8_STAGE(PG8_SB(0, 0), b2, voffB); PG8_STAGE(PG8_SB(0, 1), b2 + hstep, voffB); PG8_STAGE(PG8_SA(0, 0), a2, voffA);
            PG8_WAIT_V(8); PG8_WAIT_L(0); PG8_BAR; PG8_MMA(1, 0, At, B0); PG8_MMA(1, 1, At, B1); PG8_BAR; PG8_SCHED;
            PG8_LDB(B0, 1, 0); PG8_LDB(B1, 1, 1); PG8_SCHED; PG8_LDA(At, 1, 0); PG8_STAGE(PG8_SA(0, 1), a2 + hstep, voffA);
            PG8_WAIT_V(8); PG8_WAIT_L(0); PG8_BAR; PG8_MMA(0, 0, At, B0); PG8_MMA(0, 1, At, B1); PG8_BAR; PG8_SCHED;
            PG8_LDA(At, 1, 1); PG8_STAGE(PG8_SB(1, 0), b3, voffB); PG8_STAGE(PG8_SB(1, 1), b3 + hstep, voffB); PG8_STAGE(PG8_SA(1, 0), a3, voffA);
            PG8_WAIT_V(8); PG8_WAIT_L(0); PG8_BAR; PG8_MMA(1, 0, At, B0); PG8_MMA(1, 1, At, B1); PG8_BAR; PG8_SCHED;
            } else {
            PG8_LDB(B0, 0, 0); PG8_SCHED; PG8_LDA(At, 0, 0); PG8_STAGE(PG8_SA(1, 1), a1 + hstep, voffA);
            PG8_WAIT_L(8); PG8_BAR; PG8_WAIT_L(0); PG8_MMA(0, 0, At, B0); PG8_BAR; PG8_SCHED;
            PG8_LDB(B1, 0, 1); PG8_STAGE(PG8_SB(0, 0), b2, voffB);
            PG8_BAR; PG8_WAIT_L(0); PG8_MMA(0, 1, At, B1); PG8_BAR;
            PG8_LDA(At, 0, 1); PG8_STAGE(PG8_SA(0, 0), a2, voffA);
            PG8_BAR; PG8_WAIT_L(0); PG8_MMA(1, 0, At, B0); PG8_BAR; PG8_SCHED;
            PG8_STAGE(PG8_SB(0, 1), b2 + hstep, voffB);
            PG8_WAIT_V(6); PG8_BAR; PG8_MMA(1, 1, At, B1); PG8_BAR;
            PG8_LDB(B0, 1, 0); PG8_SCHED; PG8_LDA(At, 1, 0); PG8_STAGE(PG8_SA(0, 1), a2 + hstep, voffA);
            PG8_WAIT_L(8); PG8_BAR; PG8_WAIT_L(0); PG8_MMA(0, 0, At, B0); PG8_BAR; PG8_SCHED;
            PG8_LDB(B1, 1, 1); PG8_STAGE(PG8_SB(1, 0), b3, voffB);
            PG8_BAR; PG8_WAIT_L(0); PG8_MMA(0, 1, At, B1); PG8_BAR;
            PG8_LDA(At, 1, 1); PG8_STAGE(PG8_SA(1, 0), a3, voffA);
            PG8_BAR; PG8_WAIT_L(0); PG8_MMA(1, 0, At, B0); PG8_BAR; PG8_SCHED;
            PG8_STAGE(PG8_SB(1, 1), b3 + hstep, voffB);
            PG8_WAIT_V(6); PG8_BAR; PG8_MMA(1, 1, At, B1); PG8_BAR;
            }
        }
        if constexpr (ALIGN_EPI) { if (wr == 0) PG8_BAR; }
        if constexpr (!Epi::AFTER_DRAIN) { E(acc, cur, wr, wc, fr, fq); S.done(cur); }
        if (!has_next) break;
#pragma unroll
        for (int a = 0; a < 2; ++a)
#pragma unroll
            for (int b = 0; b < 2; ++b)
#pragma unroll
                for (int m = 0; m < 4; ++m)
#pragma unroll
                    for (int n = 0; n < 2; ++n) acc[a][b][m][n] = (f32x4){0.f, 0.f, 0.f, 0.f};
        cur = nxt; cA = nA; cB = nB; ++ui;
        if constexpr (ALIGN_EPI) { if (wr == 1) PG8_BAR; }
    }
    PG8_WAIT_V(0);
    if constexpr (!ALIGN_EPI) { if (wr == 0) PG8_BAR; }
    PG8_BAR;
    if constexpr (Epi::AFTER_DRAIN) { E.fused(acc, cur, wr, wc, fr, fq, lds, wid, lane); S.done(cur); }
#undef PG8_SA
#undef PG8_SB
#undef PG8_STAGE
#undef PG8_LDA
#undef PG8_LDB
#undef PG8_MMA
#undef PG8_WAIT_V
#undef PG8_WAIT_L
#undef PG8_BAR
#undef PG8_SCHED
}
}
constexpr int NWAVES = 8, NT = NWAVES * 64;
constexpr int BATCH = 4, SEQ = 2048, DM = 2048, M = BATCH * SEQ;
constexpr int LRU_W = 1024, LRU_BLK = 8, LRU_BD = 128;
constexpr int ATT_W = 1024, NH = 8, HD = 128, CL = 256, IH = 16, ID = 64, TOPK = 256;
constexpr int C_XA = 0, C_GA = 1024, C_Q = 2048, C_CKV = 3072, C_GB = 3328, C_QI = 4352, C_KI = 5376, C_WI = 5440, NIN = 5456, NINP = 5632;
constexpr float EPS = 1e-6f;
__constant__ unsigned char BUCKET[128] = {0, 1, 2, 3, 4, 5, 6, 7, 8, 9, 10, 11, 12, 13, 14, 15, 16, 16, 16, 17, 17, 18, 18, 18, 19, 19, 19, 20, 20, 20, 20, 21, 21, 21, 21, 22, 22, 22, 22, 22, 23, 23, 23, 23, 23, 23, 24, 24, 24, 24, 24, 24, 25, 25, 25, 25, 25, 25, 25, 26, 26, 26, 26, 26, 26, 26, 26, 27, 27, 27, 27, 27, 27, 27, 27, 27, 27, 28, 28, 28, 28, 28, 28, 28, 28, 28, 28, 29, 29, 29, 29, 29, 29, 29, 29, 29, 29, 29, 29, 30, 30, 30, 30, 30, 30, 30, 30, 30, 30, 30, 30, 30, 30, 31, 31, 31, 31, 31, 31, 31, 31, 31, 31, 31, 31, 31, 31, 31};

constexpr size_t MiB = 1u << 20;
constexpr size_t WS_CTL = 0, CTL_ZERO_BYTES = 1 * MiB;
constexpr size_t WS_WIN = 2 * MiB;
constexpr size_t WS_WOUT = 24 * MiB;
constexpr size_t WS_H = 32 * MiB;
constexpr size_t WS_PROJ = 64 * MiB;
constexpr size_t WS_A = 152 * MiB;
constexpr size_t WS_B = 184 * MiB;
constexpr size_t WS_QABS = 216 * MiB;
constexpr size_t WS_CN = 248 * MiB;
constexpr size_t WS_KN = 252 * MiB;
constexpr size_t WS_END = 256 * MiB;
constexpr int CW_TMO = 0, CW_CODE = 1, CW_BAR = 4096;

constexpr int RING_OFF = 0, RING_BYTES = 131072;
constexpr int LDSCTL_OFF = RING_BYTES, MISC_OFF = LDSCTL_OFF + 320;
constexpr int LDS_BYTES = 147456;

#define GAS __attribute__((address_space(1)))
#define LAS __attribute__((address_space(3)))
typedef unsigned short f16s;
typedef _Float16 f16;
typedef _Float16 h4 __attribute__((ext_vector_type(4)));
typedef _Float16 h8 __attribute__((ext_vector_type(8)));
typedef unsigned v4u __attribute__((ext_vector_type(4)));
typedef unsigned v2u __attribute__((ext_vector_type(2)));
typedef float f32x4 __attribute__((ext_vector_type(4)));
typedef float f32x2 __attribute__((ext_vector_type(2)));
typedef GAS unsigned gu32;
#define RLX_AGENT __ATOMIC_RELAXED, __HIP_MEMORY_SCOPE_AGENT
#define LDS_WAIT() asm volatile("s_waitcnt lgkmcnt(0)" ::: "memory")
#define VM_WAIT() asm volatile("s_waitcnt vmcnt(0)" ::: "memory")
__device__ __forceinline__ unsigned pkh(float lo, float hi) { return pg8::cvt_pk_f16(lo, hi); }
__device__ __forceinline__ float sigmoidf_(float x) { return 1.f / (1.f + __expf(-x)); }
__device__ __forceinline__ float siluf_(float x) { return x / (1.f + __expf(-x)); }
__device__ __forceinline__ float h2f(f16s v) { return (float)__builtin_bit_cast(f16, v); }

#define XB_TMO      128
#define XB_XCNT(j)  (256  + 64 * (j))
#define XB_XSUB(j)  (1280 + 64 * (j))
#define XB_XGEN(j)  (2304 + 64 * (j))
#define XB_TOP      3328
#define XB_TOPGEN   3392
#define XCD_BAR_WORDS 3456
#define XB_SPIN_CAP (1u << 18)

__device__ __forceinline__ unsigned xb_ld(unsigned* p)              { return __hip_atomic_load(p, __ATOMIC_RELAXED, __HIP_MEMORY_SCOPE_AGENT); }
__device__ __forceinline__ unsigned xb_add(unsigned* p, unsigned v) { return __hip_atomic_fetch_add(p, v, __ATOMIC_RELAXED, __HIP_MEMORY_SCOPE_AGENT); }
__device__ __forceinline__ unsigned xb_xcc_id() { return (unsigned)__builtin_amdgcn_s_getreg((3 << 11) | 20) & 0xFu; }
#define XB_SPIN(cond, bar) do { unsigned _sp = 0; while (cond) { __builtin_amdgcn_s_sleep(1); \
    if ((++_sp & 255u) == 0u) { if (xb_ld(&(bar)[XB_TMO])) break; if (_sp > XB_SPIN_CAP) { atomicAdd(&(bar)[XB_TMO], 1u); break; } } } } while (0)

struct XcdBarrier {
    unsigned* bar; unsigned x;
    volatile LAS unsigned* st;
};

__device__ __forceinline__ XcdBarrier xcd_barrier_post(unsigned* bar, volatile LAS unsigned* st) {
    XcdBarrier b; b.bar = bar; b.x = xb_xcc_id(); b.st = st;
    if (threadIdx.x == 0) (void)xb_add(&bar[XB_XCNT(b.x)], 1u);
    return b;
}
__device__ __forceinline__ void xcd_barrier_complete(unsigned* bar, unsigned x, unsigned& nloc, unsigned& nx) {
    const unsigned G = gridDim.x * gridDim.y * gridDim.z;
    unsigned sum, cnt, mine, sp = 0u;
    for (;;) {
        sum = 0u; cnt = 0u; mine = 0u;
#pragma unroll
        for (unsigned j = 0; j < 16; ++j) { const unsigned c = xb_ld(&bar[XB_XCNT(j)]); sum += c; cnt += (c > 0u) ? 1u : 0u; mine = (j == x) ? c : mine; }
        if (sum == G) break;
        __builtin_amdgcn_s_sleep(1);
        if ((++sp & 255u) == 0u) { if (xb_ld(&bar[XB_TMO])) break; if (sp > XB_SPIN_CAP) { atomicAdd(&bar[XB_TMO], 1u); break; } }
    }
    nloc = mine > 0u ? mine : 1u; nx = cnt > 0u ? cnt : 1u;
}

__device__ __forceinline__ void xcd_barrier(const XcdBarrier& b) {
    asm volatile("s_waitcnt vmcnt(0)" ::: "memory");
    __syncthreads();
    if (threadIdx.x == 0) {
        unsigned* bar = b.bar;
        __builtin_amdgcn_s_waitcnt(0);
        unsigned nloc = b.st[0], nx = b.st[1];
        if (nloc == 0u) { xcd_barrier_complete(bar, b.x, nloc, nx); b.st[0] = nloc; b.st[1] = nx; }
        const unsigned old = xb_add(&bar[XB_XSUB(b.x)], 1u);
        const unsigned gen = old / nloc;
        if (old + 1u == (gen + 1u) * nloc) {
            __builtin_amdgcn_fence(__ATOMIC_RELEASE, "agent");
            asm volatile("s_waitcnt vmcnt(0)" ::: "memory");
            const unsigned og = xb_add(&bar[XB_TOP], 1u);
            const unsigned tg = og / nx;
            if (og + 1u == (tg + 1u) * nx) xb_add(&bar[XB_TOPGEN], 1u);
            else XB_SPIN(xb_ld(&bar[XB_TOPGEN]) == tg, bar);
            __builtin_amdgcn_fence(__ATOMIC_ACQUIRE, "agent");
            xb_add(&bar[XB_XGEN(b.x)], 1u);
            asm volatile("s_waitcnt vmcnt(0)" ::: "memory");
        } else {
            XB_SPIN(xb_ld(&bar[XB_XGEN(b.x)]) == gen, bar);
            __builtin_amdgcn_fence(__ATOMIC_ACQUIRE, "agent");
            asm volatile("s_waitcnt vmcnt(0)" ::: "memory");
        }
    }
    __syncthreads();
}
struct Params {
    const float *x, *norm_g, *w_in, *conv_w, *conv_b, *wa, *ba, *wx, *bx, *lam, *ckv_g, *ikg, *ikb, *w_uk, *w_uv, *w_out, *rel_bias, *fin_g;
    float* out; unsigned char* ws;
};
struct Frame {
    LAS unsigned char* lds;
    volatile LAS unsigned* MISC;
    gu32* ctl;
    int tid, lane, wave, vcu, G;
};
__device__ __forceinline__ float wave_sum(float v) {
#pragma unroll
    for (int o = 1; o < 64; o <<= 1) v += __shfl_xor(v, o);
    return v;
}
__device__ __forceinline__ int wave_sum_i(int v) {
#pragma unroll
    for (int o = 1; o < 64; o <<= 1) v += __shfl_xor(v, o);
    return v;
}
__device__ __forceinline__ float wave_max(float v) {
#pragma unroll
    for (int o = 1; o < 64; o <<= 1) v = fmaxf(v, __shfl_xor(v, o));
    return v;
}

__device__ __forceinline__ void p0_transpose_item(const float* W, int K, int N, int nblk, f16s* WT, LAS float* scr, int item, int lane) {
    const int kb = item / nblk, nb = item % nblk, k0 = 64 * kb, n0 = 32 * nb;
    const bool nok = (n0 + (lane & 31)) < N;
#pragma unroll 8
    for (int i = 0; i < 32; ++i) { const int kk = 2 * i + (lane >> 5); scr[kk * 33 + (lane & 31)] = nok ? W[(size_t)(k0 + kk) * N + n0 + (lane & 31)] : 0.f; }
    LDS_WAIT(); asm volatile("" ::: "memory");
    const int c = lane & 7;
#pragma unroll
    for (int j = 0; j < 4; ++j) { const int n = (lane >> 3) + 8 * j; const LAS float* s = scr + (8 * c) * 33 + n;
        v4u o; o.x = pkh(s[0 * 33], s[1 * 33]); o.y = pkh(s[2 * 33], s[3 * 33]); o.z = pkh(s[4 * 33], s[5 * 33]); o.w = pkh(s[6 * 33], s[7 * 33]);
        *(GAS v4u*)(WT + (size_t)(n0 + n) * K + k0 + 8 * c) = o; }
    LDS_WAIT(); asm volatile("" ::: "memory");
}
__device__ __forceinline__ void rms_row_to_f16(const float* xrow, const float* g, f16s* orow, int lane) {
    const GAS f32x4* xr = (const GAS f32x4*)xrow + lane; const GAS f32x4* gr = (const GAS f32x4*)g + lane;
    f32x4 v[8]; float s = 0.f;
#pragma unroll
    for (int j = 0; j < 8; ++j) { v[j] = xr[64 * j]; s += (v[j].x * v[j].x + v[j].y * v[j].y) + (v[j].z * v[j].z + v[j].w * v[j].w); }
    const float r = rsqrtf(wave_sum(s) * (1.f / DM) + EPS);
    GAS v2u* o8 = (GAS v2u*)orow + lane;
#pragma unroll
    for (int j = 0; j < 8; ++j) { const f32x4 gg = gr[64 * j]; v2u o; o.x = pkh(v[j].x * r * gg.x, v[j].y * r * gg.y); o.y = pkh(v[j].z * r * gg.z, v[j].w * r * gg.w); o8[64 * j] = o; }
}
__device__ __forceinline__ void p0_prologue(Frame& F, const Params& P) {
    LAS float* scr = (LAS float*)(F.lds + RING_OFF + F.wave * 16384);
    const int gw = F.vcu * NWAVES + F.wave, NGW = F.G * NWAVES;
    constexpr int NB_IN = NINP / 32, I_IN = (DM / 64) * NB_IN, NB_OUT = DM / 32, I_OUT = (DM / 64) * NB_OUT;
    f16s* WinT = (f16s*)(P.ws + WS_WIN); f16s* WoutT = (f16s*)(P.ws + WS_WOUT); f16s* Hn = (f16s*)(P.ws + WS_H);
    for (int it = gw; it < I_IN + I_OUT; it += NGW) {
        if (it < I_IN) p0_transpose_item(P.w_in, DM, NIN, NB_IN, WinT, scr, it, F.lane);
        else p0_transpose_item(P.w_out, DM, DM, NB_OUT, WoutT, scr, it - I_IN, F.lane);
    }
    for (int m = gw; m < M; m += NGW) rms_row_to_f16(P.x + (size_t)m * DM, P.norm_g, Hn + (size_t)m * DM, F.lane);
}

__device__ __forceinline__ void p2_gates_naive(Frame& F, const Params& P) {
    const f16s* proj = (const f16s*)(P.ws + WS_PROJ); float* abuf = (float*)(P.ws + WS_A); float* bbuf = (float*)(P.ws + WS_B);
    LAS float* xs = (LAS float*)(F.lds + RING_OFF);
    const int tid = F.tid;
    for (int it = F.vcu; it < (M / 16) * LRU_BLK; it += F.G) {
        const int rt = it >> 3, g = it & 7, r0 = rt * 16;
#pragma unroll
        for (int i = 0; i < 4; ++i) { const int e = tid + NT * i, r = e >> 7, c = e & 127, row = r0 + r, t = row & (SEQ - 1), ch = g * 128 + c;
            float v = P.conv_b[ch];
#pragma unroll
            for (int j = 0; j < 4; ++j) { const int tt = t - 3 + j; if (tt >= 0) v += h2f(proj[(size_t)(row - 3 + j) * NINP + C_XA + ch]) * P.conv_w[j * LRU_W + ch]; }
            xs[r * 128 + c] = v; }
        __syncthreads();
        const int j = tid & 127, rh = tid >> 7;
        float ar[4] = {0.f, 0.f, 0.f, 0.f}, ai[4] = {0.f, 0.f, 0.f, 0.f};
        const float* wag = P.wa + (size_t)g * 128 * 128; const float* wxg = P.wx + (size_t)g * 128 * 128;
        for (int i = 0; i < 128; ++i) { const float w1 = wag[i * 128 + j], w2 = wxg[i * 128 + j];
#pragma unroll
            for (int r = 0; r < 4; ++r) { const float xv = xs[(rh * 4 + r) * 128 + i]; ar[r] += xv * w1; ai[r] += xv * w2; } }
        const int ch = g * 128 + j; const float sp = log1pf(expf(-P.lam[ch])), bav = P.ba[ch], bxv = P.bx[ch];
#pragma unroll
        for (int r = 0; r < 4; ++r) { const int row = r0 + rh * 4 + r, t = row & (SEQ - 1);
            const float rg = sigmoidf_(ar[r] + bav), ig = sigmoidf_(ai[r] + bxv), la = -8.f * rg * sp, a = expf(la);
            float mult = sqrtf(-expm1f(2.f * la)); if (t == 0) mult = 1.f;
            abuf[(size_t)row * LRU_W + ch] = a; bbuf[(size_t)row * LRU_W + ch] = mult * (ig * xs[(rh * 4 + r) * 128 + j]); }
        __syncthreads();
    }
}
__device__ __forceinline__ void p2_qabs_naive(Frame& F, const Params& P) {
    const f16s* proj = (const f16s*)(P.ws + WS_PROJ); f16s* qabs = (f16s*)(P.ws + WS_QABS);
    LAS float* qs = (LAS float*)(F.lds + RING_OFF);
    const int tid = F.tid;
    for (int it = F.vcu; it < (M / 16) * NH; it += F.G) {
        const int rt = it >> 3, h = it & 7, r0 = rt * 16;
#pragma unroll
        for (int i = 0; i < 4; ++i) { const int e = tid + NT * i, r = e >> 7, c = e & 127; qs[r * 128 + c] = h2f(proj[(size_t)(r0 + r) * NINP + C_Q + h * HD + c]); }
        __syncthreads();
        const int c = tid & 255, rh = tid >> 8;
        float acc[8];
#pragma unroll
        for (int r = 0; r < 8; ++r) acc[r] = 0.f;
        const float* wk = P.w_uk + (size_t)h * HD * CL + c;
        for (int d = 0; d < HD; ++d) { const float w = wk[(size_t)d * CL];
#pragma unroll
            for (int r = 0; r < 8; ++r) acc[r] += qs[(rh * 8 + r) * 128 + d] * w; }
#pragma unroll
        for (int r = 0; r < 8; ++r) qabs[(size_t)(r0 + rh * 8 + r) * (NH * CL) + h * CL + c] = __builtin_bit_cast(f16s, (f16)acc[r]);
        __syncthreads();
    }
}
__device__ __forceinline__ void p2_norms(Frame& F, const Params& P) {
    const f16s* proj = (const f16s*)(P.ws + WS_PROJ); f16s* cn = (f16s*)(P.ws + WS_CN); f16s* kn = (f16s*)(P.ws + WS_KN);
    const int gw = F.vcu * NWAVES + F.wave, NGW = F.G * NWAVES, lane = F.lane;
    for (int row = gw; row < M; row += NGW) {
        const h4 cv = *(const GAS h4*)(proj + (size_t)row * NINP + C_CKV + 4 * lane);
        const float c0 = (float)cv[0], c1 = (float)cv[1], c2 = (float)cv[2], c3 = (float)cv[3];
        const float r = rsqrtf(wave_sum(c0 * c0 + c1 * c1 + c2 * c2 + c3 * c3) * (1.f / CL) + EPS);
        const f32x4 g = *(const GAS f32x4*)(P.ckv_g + 4 * lane);
        v2u o; o.x = pkh(c0 * r * g.x, c1 * r * g.y); o.y = pkh(c2 * r * g.z, c3 * r * g.w);
        *(GAS v2u*)(cn + (size_t)row * CL + 4 * lane) = o;
        const float kv = h2f(proj[(size_t)row * NINP + C_KI + lane]);
        const float mu = wave_sum(kv) * (1.f / ID), d = kv - mu, var = wave_sum(d * d) * (1.f / ID);
        kn[(size_t)row * ID + lane] = __builtin_bit_cast(f16s, (f16)(d * rsqrtf(var + EPS) * P.ikg[lane] + P.ikb[lane]));
    }
}

__device__ __forceinline__ void p3_scan_naive(Frame& F, const Params& P) {
    const int gw = F.vcu * NWAVES + F.wave;
    if (gw >= (BATCH * LRU_W) / 64) return;
    const f16s* proj = (const f16s*)(P.ws + WS_PROJ); const float* abuf = (const float*)(P.ws + WS_A); const float* bbuf = (const float*)(P.ws + WS_B); f16s* y = (f16s*)(P.ws + WS_H);
    const int gid = gw * 64 + F.lane, b = gid >> 10, ch = gid & 1023;
    float h = 0.f;
#pragma unroll 8
    for (int t = 0; t < SEQ; ++t) { const size_t row = (size_t)b * SEQ + t;
        h = abuf[row * LRU_W + ch] * h + bbuf[row * LRU_W + ch];
        y[row * DM + ch] = __builtin_bit_cast(f16s, (f16)(h * siluf_(h2f(proj[row * NINP + C_GA + ch])))); }
}
__device__ __forceinline__ unsigned fkey(float f) { const unsigned u = __float_as_uint(f); return (u & 0x80000000u) ? ~u : (u | 0x80000000u); }
__device__ __forceinline__ void p3_attn_naive(Frame& F, const Params& P) {
    const f16s* proj = (const f16s*)(P.ws + WS_PROJ); const f16s* kn = (const f16s*)(P.ws + WS_KN); const f16s* cn = (const f16s*)(P.ws + WS_CN);
    const f16s* qabs = (const f16s*)(P.ws + WS_QABS); f16s* y = (f16s*)(P.ws + WS_H);
    LAS float* qs = (LAS float*)(F.lds + RING_OFF);
    LAS float* wsc = qs + 1024;
    LAS unsigned* keys = (LAS unsigned*)(wsc + 16);
    LAS int* redi = (LAS int*)(keys + 2048);
    LAS int* scan_a = redi + 16; LAS int* scan_b = scan_a + 512;
    LAS float* qa = (LAS float*)(scan_b + 512);
    LAS float* lg = qa + 2048;
    LAS float* os = lg + 2048;
    LAS int* idx = (LAS int*)(os + 2048);
    const int tid = F.tid, lane = F.lane, wave = F.wave;
    for (int row = F.vcu; row < M; row += F.G) {
        const int b = row >> 11, t = row & (SEQ - 1), n = t + 1;
        qs[tid] = h2f(proj[(size_t)row * NINP + C_QI + tid]); qs[tid + 512] = h2f(proj[(size_t)row * NINP + C_QI + tid + 512]);
        if (tid < IH) wsc[tid] = h2f(proj[(size_t)row * NINP + C_WI + tid]) * 0.03125f;
#pragma unroll
        for (int i = 0; i < 4; ++i) qa[tid + NT * i] = h2f(qabs[(size_t)row * (NH * CL) + tid + NT * i]);
        __syncthreads();
        for (int s = tid; s < SEQ; s += NT) {
            unsigned kk = 0u;
            if (s < n) {
                const GAS h8* kr = (const GAS h8*)(kn + ((size_t)b * SEQ + s) * ID);
                float kvv[ID];
#pragma unroll
                for (int d8 = 0; d8 < 8; ++d8) { const h8 v = kr[d8];
#pragma unroll
                    for (int e = 0; e < 8; ++e) kvv[d8 * 8 + e] = (float)v[e]; }
                float sc = 0.f;
                for (int h = 0; h < IH; ++h) { float dsum = 0.f;
#pragma unroll
                    for (int d = 0; d < ID; ++d) dsum += qs[h * ID + d] * kvv[d];
                    sc += fmaxf(dsum, 0.f) * wsc[h]; }
                kk = fkey(sc); if (kk == 0u) kk = 1u;
            }
            keys[s] = kk;
        }
        __syncthreads();
        if (n <= TOPK) { if (tid < TOPK) idx[tid] = tid < n ? tid : -1; }
        else {
            unsigned lo = 0u, hi = 0xFFFFFFFFu;
            while (lo < hi) {
                const unsigned mid = lo + (unsigned)(((unsigned long long)hi - lo + 1ull) >> 1);
                int c = 0;
#pragma unroll
                for (int i = 0; i < 4; ++i) c += keys[tid + NT * i] >= mid;
                c = wave_sum_i(c);
                __syncthreads();
                if (lane == 0) redi[wave] = c;
                __syncthreads();
                c = 0;
#pragma unroll
                for (int w = 0; w < NWAVES; ++w) c += redi[w];
                if (c >= TOPK) lo = mid; else hi = mid - 1u;
            }
            const unsigned K = lo;
            int cg = 0, ce = 0;
#pragma unroll
            for (int i = 0; i < 4; ++i) { const unsigned kk = keys[tid * 4 + i]; cg += kk > K; ce += kk == K; }
            scan_a[tid] = cg; scan_b[tid] = ce;
            __syncthreads();
            if (tid == 0) { int sa = 0, sb = 0; for (int i = 0; i < NT; ++i) { const int a = scan_a[i], bb = scan_b[i]; scan_a[i] = sa; scan_b[i] = sb; sa += a; sb += bb; } redi[8] = sa; }
            __syncthreads();
            const int need_eq = TOPK - redi[8];
            int pg = scan_a[tid], pe = scan_b[tid];
#pragma unroll
            for (int i = 0; i < 4; ++i) { const unsigned kk = keys[tid * 4 + i];
                if (kk > K) { idx[pg + (pe < need_eq ? pe : need_eq)] = tid * 4 + i; ++pg; }
                else if (kk == K) { if (pe < need_eq) idx[pg + pe] = tid * 4 + i; ++pe; } }
        }
        __syncthreads();
        {
            const int j = tid & 255, hh = tid >> 8, s = idx[j];
            float l[4] = {0.f, 0.f, 0.f, 0.f};
            if (s >= 0) {
                const GAS h8* cr = (const GAS h8*)(cn + ((size_t)b * SEQ + s) * CL);
                for (int c8 = 0; c8 < CL / 8; ++c8) { const h8 v = cr[c8];
#pragma unroll
                    for (int e = 0; e < 8; ++e) { const float cv = (float)v[e];
#pragma unroll
                        for (int h = 0; h < 4; ++h) l[h] += qa[(hh * 4 + h) * CL + c8 * 8 + e] * cv; } }
                const int dist = t - s, bk = dist < 128 ? (int)BUCKET[dist] : 31;
#pragma unroll
                for (int h = 0; h < 4; ++h) l[h] = l[h] * 0.08838834764831845f + P.rel_bias[bk * NH + hh * 4 + h];
            } else {
#pragma unroll
                for (int h = 0; h < 4; ++h) l[h] = -INFINITY;
            }
#pragma unroll
            for (int h = 0; h < 4; ++h) lg[(hh * 4 + h) * TOPK + j] = l[h];
        }
        __syncthreads();
        {
            float v[4], mx = -INFINITY;
#pragma unroll
            for (int i = 0; i < 4; ++i) { v[i] = lg[wave * TOPK + lane + 64 * i]; mx = fmaxf(mx, v[i]); }
            mx = wave_max(mx);
            float sm = 0.f;
#pragma unroll
            for (int i = 0; i < 4; ++i) { v[i] = expf(v[i] - mx); sm += v[i]; }
            const float inv = 1.f / wave_sum(sm);
#pragma unroll
            for (int i = 0; i < 4; ++i) lg[wave * TOPK + lane + 64 * i] = v[i] * inv;
        }
        __syncthreads();
        {
            const int c = tid & 255, hh = tid >> 8;
            float o[4] = {0.f, 0.f, 0.f, 0.f};
            for (int j = 0; j < TOPK; ++j) { const int s = idx[j]; if (s < 0) continue;
                const float cv = h2f(cn[((size_t)b * SEQ + s) * CL + c]);
#pragma unroll
                for (int h = 0; h < 4; ++h) o[h] += lg[(hh * 4 + h) * TOPK + j] * cv; }
#pragma unroll
            for (int h = 0; h < 4; ++h) os[(hh * 4 + h) * CL + c] = o[h];
        }
        __syncthreads();
#pragma unroll
        for (int i = 0; i < 2; ++i) { const int h = i * 4 + (tid >> 7), d = tid & 127;
            const float* wv = P.w_uv + (size_t)h * CL * HD + d; float acc = 0.f;
            for (int c = 0; c < CL; ++c) acc += os[h * CL + c] * wv[(size_t)c * HD];
            const float gb = h2f(proj[(size_t)row * NINP + C_GB + h * HD + d]);
            y[(size_t)row * DM + LRU_W + h * HD + d] = __builtin_bit_cast(f16s, (f16)(acc * siluf_(gb))); }
        __syncthreads();
    }
}

__device__ __forceinline__ void p5_final(Frame& F, const Params& P) {
    const int gw = F.vcu * NWAVES + F.wave, NGW = F.G * NWAVES, lane = F.lane;
    for (int m = gw; m < M; m += NGW) {
        GAS f32x4* xr = (GAS f32x4*)(P.out + (size_t)m * DM) + lane; const GAS f32x4* gr = (const GAS f32x4*)P.fin_g + lane;
        f32x4 v[8]; float s = 0.f;
#pragma unroll
        for (int j = 0; j < 8; ++j) { v[j] = xr[64 * j]; s += (v[j].x * v[j].x + v[j].y * v[j].y) + (v[j].z * v[j].z + v[j].w * v[j].w); }
        const float r = rsqrtf(wave_sum(s) * (1.f / DM) + EPS);
#pragma unroll
        for (int j = 0; j < 8; ++j) xr[64 * j] = v[j] * r * gr[64 * j];
    }
}

__global__ void __launch_bounds__(NT, 2) fwd_kernel(Params P) {
    extern __shared__ __attribute__((aligned(16))) unsigned char lds[];
    Frame F;
    F.lds = (LAS unsigned char*)lds;
    F.MISC = (volatile LAS unsigned*)(F.lds + MISC_OFF);
    F.tid = threadIdx.x; F.lane = F.tid & 63; F.wave = __builtin_amdgcn_readfirstlane(F.tid >> 6);
    F.G = gridDim.x; { const int bx = blockIdx.x; F.vcu = (F.G % 8 == 0) ? (bx % 8) * (F.G / 8) + bx / 8 : bx; }
    F.ctl = (gu32*)(P.ws + WS_CTL);
    for (int u = F.tid; u < (LDS_BYTES - LDSCTL_OFF) / 4; u += NT) ((LAS unsigned*)(F.lds + LDSCTL_OFF))[u] = 0u;
    __syncthreads();
    XcdBarrier bar = xcd_barrier_post((unsigned*)(F.ctl + CW_BAR), F.MISC + 8);

    p0_prologue(F, P);
    xcd_barrier(bar);
    {
        pg8::Gemm g{(const pg8::bf16_t*)(P.ws + WS_H), (const pg8::bf16_t*)(P.ws + WS_WIN), M, NINP, DM};
        pg8::StaticOrder S; S.init(M, NINP, F.G, (int)blockIdx.x);
        pg8::EpiF16 E{(pg8::bf16_t*)(P.ws + WS_PROJ), NINP};
        pg8::gemm_phase<pg8::EpiF16, pg8::StaticOrder, true, true>(F.lds + RING_OFF, g, S, E);
    }
    xcd_barrier(bar);
    p2_gates_naive(F, P);
    p2_qabs_naive(F, P);
    p2_norms(F, P);
    xcd_barrier(bar);
    p3_scan_naive(F, P);
    p3_attn_naive(F, P);
    xcd_barrier(bar);
    {
        pg8::Gemm g{(const pg8::bf16_t*)(P.ws + WS_H), (const pg8::bf16_t*)(P.ws + WS_WOUT), M, DM, DM};
        pg8::StaticOrder S; S.init(M, DM, F.G, (int)blockIdx.x);
        pg8::EpiResF32 E{P.x, P.out, DM};
        pg8::gemm_phase<pg8::EpiResF32, pg8::StaticOrder, false, true>(F.lds + RING_OFF, g, S, E);
    }
    xcd_barrier(bar);
    p5_final(F, P);
}

extern "C" void kernel_launch(void* const* d_in, const int* in_sizes, int n_in, void* d_out, int out_size, void* d_ws, size_t ws_size, hipStream_t stream) {
    static int grid = 0;
    if (grid == 0) {
        if (n_in != 18 || out_size != M * DM || ws_size < WS_END) { fprintf(stderr, "kernel_launch: unexpected shapes (n_in %d out %d ws %zu)\n", n_in, out_size, ws_size); grid = -1; return; }
        int dev = 0, cus = 0, per_cu = 0;
        if (hipGetDevice(&dev) != hipSuccess || hipDeviceGetAttribute(&cus, hipDeviceAttributeMultiprocessorCount, dev) != hipSuccess) { grid = -1; return; }
        if (hipFuncSetAttribute((const void*)fwd_kernel, hipFuncAttributeMaxDynamicSharedMemorySize, LDS_BYTES) != hipSuccess) { fprintf(stderr, "kernel_launch: hipFuncSetAttribute failed\n"); grid = -1; return; }
        if (hipOccupancyMaxActiveBlocksPerMultiprocessor(&per_cu, (const void*)fwd_kernel, NT, LDS_BYTES) != hipSuccess || per_cu < 1) fprintf(stderr, "kernel_launch: occupancy query says %d\n", per_cu);
        (void)hipGetLastError();
        grid = cus;
    }
    if (grid < 0) return;
    (void)hipMemsetAsync((char*)d_ws + WS_CTL, 0, CTL_ZERO_BYTES, stream);
    Params p{};
    p.x = (const float*)d_in[0]; p.norm_g = (const float*)d_in[1]; p.w_in = (const float*)d_in[2]; p.conv_w = (const float*)d_in[3]; p.conv_b = (const float*)d_in[4];
    p.wa = (const float*)d_in[5]; p.ba = (const float*)d_in[6]; p.wx = (const float*)d_in[7]; p.bx = (const float*)d_in[8]; p.lam = (const float*)d_in[9];
    p.ckv_g = (const float*)d_in[10]; p.ikg = (const float*)d_in[11]; p.ikb = (const float*)d_in[12]; p.w_uk = (const float*)d_in[13]; p.w_uv = (const float*)d_in[14];
    p.w_out = (const float*)d_in[15]; p.rel_bias = (const float*)d_in[16]; p.fin_g = (const float*)d_in[17];
    p.out = (float*)d_out; p.ws = (unsigned char*)d_ws;
    hipLaunchKernelGGL(fwd_kernel, dim3(grid), dim3(NT), LDS_BYTES, stream, p);
}
```

```cpp
#include <hip/hip_runtime.h>
#include <cstdio>
#include <cstdint>
namespace pg8 {
#define PG8_LAS __attribute__((address_space(3)))
typedef unsigned short bf16_t;
typedef _Float16 f16x8 __attribute__((ext_vector_type(8)));
typedef _Float16 f16x2 __attribute__((ext_vector_type(2)));
typedef float f32x2 __attribute__((ext_vector_type(2)));
typedef float f32x4 __attribute__((ext_vector_type(4)));
typedef unsigned u32x4 __attribute__((ext_vector_type(4)));
constexpr int BM = 256, BK = 64, HALF = 128, HTB = HALF * BK * 2  , STAGE_BYTES = 8 * HTB, NXCD = 8, WGM = 8;

__host__ __device__ __forceinline__ int lds_byte(int r, int c) { const int st = (r >> 4) * 2 + (c >> 5), rr = r & 15, cc = c & 31, ob = rr * 64 + cc * 2; return st * 1024 + (ob ^ (((ob >> 9) & 1) << 5)); }
__host__ __device__ __forceinline__ void stage_rc(int b, int& R, int& C) { const int st = b / 1024, sb = b % 1024, swz = sb ^ (((sb >> 9) & 1) << 5); R = (st >> 1) * 16 + swz / 64; C = (st & 1) * 32 + (swz % 64) / 2; }
__host__ __device__ __forceinline__ int perm32(int rho) { const int n = rho >> 4, i = rho & 15; return 8 * (i >> 2) + 4 * n + (i & 3); }

struct Unit { int pm, pn; };
struct Gemm { const bf16_t* A; const bf16_t* Bt; int M, N, K; };

struct StaticOrder {
    int nM, nN, nwg, G, c;
    __host__ __device__ void init(int M, int N, int G_, int c_) { nM = M / BM; nN = N / BM; nwg = nM * nN; G = G_; c = c_; }
    __host__ __device__ bool next(int i, Unit& u) const {
        const long L = (long)i * G + c; if (L >= nwg) return false;
        int wgid = (int)L; { const int q = nwg / NXCD, r = nwg % NXCD, xcd = wgid % NXCD, off = wgid / NXCD; wgid = (xcd < r ? xcd * (q + 1) : r * (q + 1) + (xcd - r) * q) + off; }
        const int nig = WGM * nN, gid = wgid / nig, fm = gid * WGM, gsz = (nM - fm) < WGM ? (nM - fm) : WGM;
        u.pm = fm + ((wgid % nig) % gsz); u.pn = (wgid % nig) / gsz; return true;
    }
    __device__ __forceinline__ void a_ready(const Unit&) const {}
    __device__ __forceinline__ void done(const Unit&) const {}
};

__device__ __forceinline__ unsigned cvt_pk_f16(float lo, float hi) { const f32x2 v = {lo, hi}; return __builtin_bit_cast(unsigned, __builtin_convertvector(v, f16x2)); }
struct EpiF16 {
    static constexpr bool PERM = true, AFTER_DRAIN = false;
    bf16_t* O; int ldc;
    __device__ __forceinline__ void operator()(const f32x4 (&acc)[2][2][4][2], const Unit& u, int wr, int wc, int fr, int fq) const {
        const int row0 = u.pm * BM + wr * 64 + fr, col0 = u.pn * BM + wc * 32 + 8 * fq;
#pragma unroll
        for (int ai = 0; ai < 2; ++ai)
#pragma unroll
            for (int m = 0; m < 4; ++m) { bf16_t* rowp = O + (size_t)(row0 + ai * HALF + m * 16) * ldc + col0;
#pragma unroll
                for (int bj = 0; bj < 2; ++bj) { const f32x4 v0 = acc[ai][bj][m][0], v1 = acc[ai][bj][m][1];
                    u32x4 w; w.x = cvt_pk_f16(v0[0], v0[1]); w.y = cvt_pk_f16(v0[2], v0[3]); w.z = cvt_pk_f16(v1[0], v1[1]); w.w = cvt_pk_f16(v1[2], v1[3]);
                    *(u32x4*)(rowp + bj * HALF) = w; } }
    }
};
struct EpiResF32 {
    static constexpr bool PERM = false, AFTER_DRAIN = false;
    const float* base; float* out; int ldc;
    __device__ __forceinline__ void operator()(const f32x4 (&acc)[2][2][4][2], const Unit& u, int wr, int wc, int fr, int fq) const {
        const int row0 = u.pm * BM + wr * 64 + fr, col0 = u.pn * BM + wc * 32 + 4 * fq;
#pragma unroll
        for (int ai = 0; ai < 2; ++ai)
#pragma unroll
            for (int m = 0; m < 4; ++m) { const size_t off = (size_t)(row0 + ai * HALF + m * 16) * ldc + col0;
#pragma unroll
                for (int bj = 0; bj < 2; ++bj)
#pragma unroll
                    for (int n = 0; n < 2; ++n) *(f32x4*)(out + off + bj * HALF + n * 16) = *(const f32x4*)(base + off + bj * HALF + n * 16) + acc[ai][bj][m][n]; }
    }
};

template <class Epi, class Sched, bool ALIGN_EPI = false, bool SP2 = false>
__device__ __forceinline__ void gemm_phase(PG8_LAS unsigned char* lds, const Gemm g, const Sched& S, const Epi& E) {
    const int tid = threadIdx.x, wid = __builtin_amdgcn_readfirstlane(tid >> 6), lane = tid & 63, wr = wid >> 2, wc = wid & 3, fr = lane & 15, fq = lane >> 4;
    const int K = g.K, nt = K / BK;
    unsigned voffA[2], voffB[2];
#pragma unroll
    for (int i = 0; i < 2; ++i) { int R, C; stage_rc(tid * 16 + i * 8192, R, C); const int Rb = Epi::PERM ? ((R & ~31) + perm32(R & 31)) : R;
        voffA[i] = (unsigned)(R * K + C) * 2u; voffB[i] = (unsigned)(Rb * K + C) * 2u; }
    const size_t kstep = (size_t)(BK * 2);
    const size_t hstep = (size_t)HALF * K * 2;
    const size_t tstep = 2 * hstep;
    const unsigned ldsw = (unsigned)wid * 1024u;
    const int aoff = lds_byte(wr * 64 + fr, fq * 8), boff = lds_byte(wc * 32 + fr, fq * 8);
#define PG8_SA(b, h) (((b) * 2 + (h)) * HTB)
#define PG8_SB(b, h) ((4 + (b) * 2 + (h)) * HTB)
#define PG8_STAGE(bufoff, gbase, voff) do { _Pragma("unroll") for (int _i = 0; _i < 2; ++_i) \
        __builtin_amdgcn_global_load_lds((const unsigned*)((const char*)(gbase) + (voff)[_i]), (PG8_LAS unsigned*)(lds + (bufoff) + ldsw + _i * 8192), 16, 0, 0); } while (0)
#define PG8_LDA(dst, b, h) do { _Pragma("unroll") for (int m = 0; m < 4; ++m) _Pragma("unroll") for (int k = 0; k < 2; ++k) dst[m][k] = *(const PG8_LAS f16x8*)(lds + PG8_SA(b, h) + aoff + m * 2048 + k * 1024); } while (0)
#define PG8_LDB(dst, b, h) do { _Pragma("unroll") for (int n = 0; n < 2; ++n) _Pragma("unroll") for (int k = 0; k < 2; ++k) dst[n][k] = *(const PG8_LAS f16x8*)(lds + PG8_SB(b, h) + boff + n * 2048 + k * 1024); } while (0)
#define PG8_MMA(ai, bj, At, Bt) do { __builtin_amdgcn_s_setprio(1); _Pragma("unroll") for (int m = 0; m < 4; ++m) _Pragma("unroll") for (int n = 0; n < 2; ++n) _Pragma("unroll") for (int k = 0; k < 2; ++k) \
        acc[ai][bj][m][n] = __builtin_amdgcn_mfma_f32_16x16x32_f16(Bt[n][k], At[m][k], acc[ai][bj][m][n], 0, 0, 0); __builtin_amdgcn_s_setprio(0); } while (0)
#define PG8_WAIT_V(n) asm volatile("s_waitcnt vmcnt(" #n ")" ::: "memory")
#define PG8_WAIT_L(n) asm volatile("s_waitcnt lgkmcnt(" #n ")" ::: "memory")
#define PG8_BAR __builtin_amdgcn_s_barrier()
#define PG8_SCHED __builtin_amdgcn_sched_barrier(0)
    Unit cur, nxt; int ui = 0;
    if (!S.next(0, cur)) return;
    f32x4 acc[2][2][4][2];
#pragma unroll
    for (int a = 0; a < 2; ++a)
#pragma unroll
        for (int b = 0; b < 2; ++b)
#pragma unroll
            for (int m = 0; m < 4; ++m)
#pragma unroll
                for (int n = 0; n < 2; ++n) acc[a][b][m][n] = (f32x4){0.f, 0.f, 0.f, 0.f};
    f16x8 At[4][2], B0[2][2], B1[2][2];
    const char* cA = (const char*)g.A + (size_t)cur.pm * tstep; const char* cB = (const char*)g.Bt + (size_t)cur.pn * tstep;
    S.a_ready(cur);
    if constexpr (SP2) {
        PG8_STAGE(PG8_SB(0, 0), cB, voffB); PG8_STAGE(PG8_SB(0, 1), cB + hstep, voffB); PG8_STAGE(PG8_SA(0, 0), cA, voffA); PG8_STAGE(PG8_SA(0, 1), cA + hstep, voffA);
        if (wr == 1) PG8_BAR;
        PG8_WAIT_V(2); PG8_BAR;
        PG8_STAGE(PG8_SB(1, 0), cB + kstep, voffB); PG8_STAGE(PG8_SA(1, 0), cA + kstep, voffA); PG8_STAGE(PG8_SB(1, 1), cB + hstep + kstep, voffB);
        PG8_WAIT_V(6); PG8_BAR;
    } else {
        PG8_STAGE(PG8_SB(0, 0), cB, voffB); PG8_STAGE(PG8_SA(0, 0), cA, voffA); PG8_STAGE(PG8_SB(0, 1), cB + hstep, voffB); PG8_STAGE(PG8_SA(0, 1), cA + hstep, voffA);
        if (wr == 1) PG8_BAR;
        PG8_WAIT_V(4); PG8_BAR;
        PG8_STAGE(PG8_SB(1, 0), cB + kstep, voffB); PG8_STAGE(PG8_SA(1, 0), cA + kstep, voffA); PG8_STAGE(PG8_SB(1, 1), cB + hstep + kstep, voffB);
        PG8_WAIT_V(6); PG8_BAR;
    }
    for (;;) {
        const bool has_next = S.next(ui + 1, nxt);
        const char* nA = has_next ? (const char*)g.A + (size_t)nxt.pm * tstep : cA; const char* nB = has_next ? (const char*)g.Bt + (size_t)nxt.pn * tstep : cB;
        for (int t = 0; t < nt; t += 2) {
            const bool last = (t == nt - 2);
            const char* a1 = cA + (size_t)(t + 1) * kstep;
            const char* a2 = last ? nA : cA + (size_t)(t + 2) * kstep; const char* b2 = last ? nB : cB + (size_t)(t + 2) * kstep;
            const char* a3 = a2 + kstep; const char* b3 = b2 + kstep;
            if (last && has_next) S.a_ready(nxt);
            if constexpr (SP2) {
            PG8_LDB(B0, 0, 0); PG8_LDB(B1, 0, 1); PG8_SCHED; PG8_LDA(At, 0, 0); PG8_STAGE(PG8_SA(1, 1), a1 + hstep, voffA);
            PG8_WAIT_V(8); PG8_WAIT_L(0); PG8_BAR; PG8_MMA(0, 0, At, B0); PG8_MMA(0, 1, At, B1); PG8_BAR; PG8_SCHED;
            PG8_LDA(At, 0, 1); PG8_STAGE(PG8_SB(0, 0), b2, voffB); PG8_STAGE(PG8_SB(0, 1), b2 + hstep, voffB); PG8_STAGE(PG8_SA(0, 0), a2, voffA);
            PG8_WAIT_V(8); PG8_WAIT_L(0); PG8_BAR; PG8_MMA(1, 0, At, B0); PG8_MMA(1, 1, At, B1); PG8_BAR; PG8_SCHED;
            PG8_LDB(B0, 1, 0); PG8_LDB(B1, 1, 1); PG8_SCHED; PG8_LDA(At, 1, 0); PG8_STAGE(PG8_SA(0, 1), a2 + hstep, voffA);
            PG8_WAIT_V(8); PG8_WAIT_L(0); PG8_BAR; PG8_MMA(0, 0, At, B0); PG8_MMA(0, 1, At, B1); PG8_BAR; PG8_SCHED;
            PG8_LDA(At, 1, 1); PG8_STAGE(PG8_SB(1, 0), b3, voffB); PG8_STAGE(PG8_SB(1, 1), b3 + hstep, voffB); PG8_STAGE(PG8_SA(1, 0), a3, voffA);
            PG8_WAIT_V(8); PG8_WAIT_L(0); PG8_BAR; PG8_MMA(1, 0, At, B0); PG8_MMA(1, 1, At, B1); PG8_BAR; PG8_SCHED;
            } else {
            PG8_LDB(B0, 0, 0); PG8_SCHED; PG8_LDA(At, 0, 0); PG8_STAGE(PG8_SA(1, 1), a1 + hstep, voffA);
            PG8_WAIT_L(8); PG8_BAR; PG8_WAIT_L(0); PG8_MMA(0, 0, At, B0); PG8_BAR; PG8_SCHED;
            PG8_LDB(B1, 0, 1); PG8_STAGE(PG8_SB(0, 0), b2, voffB);
            PG8_BAR; PG8_WAIT_L(0); PG8_MMA(0, 1, At, B1); PG8_BAR;
            PG8_LDA(At, 0, 1); PG8_STAGE(PG8_SA(0, 0), a2, voffA);
            PG8_BAR; PG8_WAIT_L(0); PG8_MMA(1, 0, At, B0); PG8_BAR; PG8_SCHED;
            PG8_STAGE(PG8_SB(0, 1), b2 + hstep, voffB);
            PG8_WAIT_V(6); PG8_BAR; PG8_MMA(1, 1, At, B1); PG8_BAR;
            PG8_LDB(B0, 1, 0); PG8_SCHED; PG8_LDA(At, 1, 0); PG8_STAGE(PG8_SA(0, 1), a2 + hstep, voffA);
            PG8_WAIT_L(8); PG8_BAR; PG8_WAIT_L(0); PG8_MMA(0, 0, At, B0); PG8_BAR; PG8_SCHED;
            PG8_LDB(B1, 1, 1); PG8_STAGE(PG8_SB(1, 0), b3, voffB);
            PG8_BAR; PG8_WAIT_L(0); PG8_MMA(0, 1, At, B1); PG8_BAR;
            PG8_LDA(At, 1, 1); PG8_STAGE(PG8_SA(1, 0), a3, voffA);
            PG8_BAR; PG8_WAIT_L(0); PG8_MMA(1, 0, At, B0); PG8_BAR; PG8_SCHED;
            PG8_STAGE(PG8_SB(1, 1), b3 + hstep, voffB);
            PG8_WAIT_V(6); PG8_BAR; PG8_MMA(1, 1, At, B1); PG8_BAR;
            }
        }
        if constexpr (ALIGN_EPI) { if (wr == 0) PG8_BAR; }
        if constexpr (!Epi::AFTER_DRAIN) { E(acc, cur, wr, wc, fr, fq); S.done(cur); }
        if (!has_next) break;
#pragma unroll
        for (int a = 0; a < 2; ++a)
#pragma unroll
            for (int b = 0; b < 2; ++b)
#pragma unroll
                for (int m = 0; m < 4; ++m)
#pragma unroll
                    for (int n = 0; n < 2; ++n) acc[a][b][m][n] = (f32x4){0.f, 0.f, 0.f, 0.f};
        cur = nxt; cA = nA; cB = nB; ++ui;
        if constexpr (ALIGN_EPI) { if (wr == 1) PG8_BAR; }
    }
    PG8_WAIT_V(0);
    if constexpr (!ALIGN_EPI) { if (wr == 0) PG8_BAR; }
    PG8_BAR;
    if constexpr (Epi::AFTER_DRAIN) { E.fused(acc, cur, wr, wc, fr, fq, lds, wid, lane); S.done(cur); }
#undef PG8_SA
#undef PG8_SB
#undef PG8_STAGE
#undef PG8_LDA
#undef PG8_LDB
#undef PG8_MMA
#undef PG8_WAIT_V
#undef PG8_WAIT_L
#undef PG8_BAR
#undef PG8_SCHED
}
}
constexpr int NWAVES = 8, NT = NWAVES * 64;
constexpr int BATCH = 4, SEQ = 2048, DM = 2048, M = BATCH * SEQ;
constexpr int LRU_W = 1024, LRU_BLK = 8, LRU_BD = 128;
constexpr int ATT_W = 1024, NH = 8, HD = 128, CL = 256, IH = 16, ID = 64, TOPK = 256;
constexpr int C_XA = 0, C_GA = 1024, C_Q = 2048, C_CKV = 3072, C_GB = 3328, C_QI = 4352, C_KI = 5376, C_WI = 5440, NIN = 5456, NINP = 5632;
constexpr float EPS = 1e-6f;
__constant__ unsigned char BUCKET[128] = {0, 1, 2, 3, 4, 5, 6, 7, 8, 9, 10, 11, 12, 13, 14, 15, 16, 16, 16, 17, 17, 18, 18, 18, 19, 19, 19, 20, 20, 20, 20, 21, 21, 21, 21, 22, 22, 22, 22, 22, 23, 23, 23, 23, 23, 23, 24, 24, 24, 24, 24, 24, 25, 25, 25, 25, 25, 25, 25, 26, 26, 26, 26, 26, 26, 26, 26, 27, 27, 27, 27, 27, 27, 27, 27, 27, 27, 28, 28, 28, 28, 28, 28, 28, 28, 28, 28, 29, 29, 29, 29, 29, 29, 29, 29, 29, 29, 29, 29, 30, 30, 30, 30, 30, 30, 30, 30, 30, 30, 30, 30, 30, 30, 31, 31, 31, 31, 31, 31, 31, 31, 31, 31, 31, 31, 31, 31, 31};

constexpr size_t MiB = 1u << 20;
constexpr size_t WS_CTL = 0, CTL_ZERO_BYTES = 1 * MiB;
constexpr size_t WS_WIN = 2 * MiB;
constexpr size_t WS_WOUT = 24 * MiB;
constexpr size_t WS_H = 32 * MiB;
constexpr size_t WS_PROJ = 64 * MiB;
constexpr size_t WS_A = 152 * MiB;
constexpr size_t WS_B = 184 * MiB;
constexpr size_t WS_QABS = 216 * MiB;
constexpr size_t WS_CN = 248 * MiB;
constexpr size_t WS_KN = 252 * MiB;
constexpr size_t WS_WUVT = 254 * MiB;
constexpr size_t WS_END = 256 * MiB;
constexpr int CW_TMO = 0, CW_CODE = 1, CW_BAR = 4096;

constexpr int RING_OFF = 0, RING_BYTES = 131072;
constexpr int LDSCTL_OFF = RING_BYTES, MISC_OFF = LDSCTL_OFF + 320;
constexpr int LDS_BYTES = 163840;

#define GAS __attribute__((address_space(1)))
#define LAS __attribute__((address_space(3)))
typedef unsigned short f16s;
typedef _Float16 f16;
typedef _Float16 h4 __attribute__((ext_vector_type(4)));
typedef _Float16 h8 __attribute__((ext_vector_type(8)));
typedef unsigned v4u __attribute__((ext_vector_type(4)));
typedef unsigned v2u __attribute__((ext_vector_type(2)));
typedef float f32x4 __attribute__((ext_vector_type(4)));
typedef float f32x2 __attribute__((ext_vector_type(2)));
typedef GAS unsigned gu32;
#define RLX_AGENT __ATOMIC_RELAXED, __HIP_MEMORY_SCOPE_AGENT
#define LDS_WAIT() asm volatile("s_waitcnt lgkmcnt(0)" ::: "memory")
#define VM_WAIT() asm volatile("s_waitcnt vmcnt(0)" ::: "memory")
__device__ __forceinline__ unsigned pkh(float lo, float hi) { return pg8::cvt_pk_f16(lo, hi); }
__device__ __forceinline__ float sigmoidf_(float x) { return 1.f / (1.f + __expf(-x)); }
__device__ __forceinline__ float siluf_(float x) { return x / (1.f + __expf(-x)); }
__device__ __forceinline__ float h2f(f16s v) { return (float)__builtin_bit_cast(f16, v); }

#define XB_TMO      128
#define XB_XCNT(j)  (256  + 64 * (j))
#define XB_XSUB(j)  (1280 + 64 * (j))
#define XB_XGEN(j)  (2304 + 64 * (j))
#define XB_TOP      3328
#define XB_TOPGEN   3392
#define XCD_BAR_WORDS 3456
#define XB_SPIN_CAP (1u << 18)

__device__ __forceinline__ unsigned xb_ld(unsigned* p)              { return __hip_atomic_load(p, __ATOMIC_RELAXED, __HIP_MEMORY_SCOPE_AGENT); }
__device__ __forceinline__ unsigned xb_add(unsigned* p, unsigned v) { return __hip_atomic_fetch_add(p, v, __ATOMIC_RELAXED, __HIP_MEMORY_SCOPE_AGENT); }
__device__ __forceinline__ unsigned xb_xcc_id() { return (unsigned)__builtin_amdgcn_s_getreg((3 << 11) | 20) & 0xFu; }
#define XB_SPIN(cond, bar) do { unsigned _sp = 0; while (cond) { __builtin_amdgcn_s_sleep(1); \
    if ((++_sp & 255u) == 0u) { if (xb_ld(&(bar)[XB_TMO])) break; if (_sp > XB_SPIN_CAP) { atomicAdd(&(bar)[XB_TMO], 1u); break; } } } } while (0)

struct XcdBarrier {
    unsigned* bar; unsigned x;
    volatile LAS unsigned* st;
};

__device__ __forceinline__ XcdBarrier xcd_barrier_post(unsigned* bar, volatile LAS unsigned* st) {
    XcdBarrier b; b.bar = bar; b.x = xb_xcc_id(); b.st = st;
    if (threadIdx.x == 0) (void)xb_add(&bar[XB_XCNT(b.x)], 1u);
    return b;
}
__device__ __forceinline__ void xcd_barrier_complete(unsigned* bar, unsigned x, unsigned& nloc, unsigned& nx) {
    const unsigned G = gridDim.x * gridDim.y * gridDim.z;
    unsigned sum, cnt, mine, sp = 0u;
    for (;;) {
        sum = 0u; cnt = 0u; mine = 0u;
#pragma unroll
        for (unsigned j = 0; j < 16; ++j) { const unsigned c = xb_ld(&bar[XB_XCNT(j)]); sum += c; cnt += (c > 0u) ? 1u : 0u; mine = (j == x) ? c : mine; }
        if (sum == G) break;
        __builtin_amdgcn_s_sleep(1);
        if ((++sp & 255u) == 0u) { if (xb_ld(&bar[XB_TMO])) break; if (sp > XB_SPIN_CAP) { atomicAdd(&bar[XB_TMO], 1u); break; } }
    }
    nloc = mine > 0u ? mine : 1u; nx = cnt > 0u ? cnt : 1u;
}

__device__ __forceinline__ void xcd_barrier(const XcdBarrier& b) {
    asm volatile("s_waitcnt vmcnt(0)" ::: "memory");
    __syncthreads();
    if (threadIdx.x == 0) {
        unsigned* bar = b.bar;
        __builtin_amdgcn_s_waitcnt(0);
        unsigned nloc = b.st[0], nx = b.st[1];
        if (nloc == 0u) { xcd_barrier_complete(bar, b.x, nloc, nx); b.st[0] = nloc; b.st[1] = nx; }
        const unsigned old = xb_add(&bar[XB_XSUB(b.x)], 1u);
        const unsigned gen = old / nloc;
        if (old + 1u == (gen + 1u) * nloc) {
            __builtin_amdgcn_fence(__ATOMIC_RELEASE, "agent");
            asm volatile("s_waitcnt vmcnt(0)" ::: "memory");
            const unsigned og = xb_add(&bar[XB_TOP], 1u);
            const unsigned tg = og / nx;
            if (og + 1u == (tg + 1u) * nx) xb_add(&bar[XB_TOPGEN], 1u);
            else XB_SPIN(xb_ld(&bar[XB_TOPGEN]) == tg, bar);
            __builtin_amdgcn_fence(__ATOMIC_ACQUIRE, "agent");
            xb_add(&bar[XB_XGEN(b.x)], 1u);
            asm volatile("s_waitcnt vmcnt(0)" ::: "memory");
        } else {
            XB_SPIN(xb_ld(&bar[XB_XGEN(b.x)]) == gen, bar);
            __builtin_amdgcn_fence(__ATOMIC_ACQUIRE, "agent");
            asm volatile("s_waitcnt vmcnt(0)" ::: "memory");
        }
    }
    __syncthreads();
}
struct Params {
    const float *x, *norm_g, *w_in, *conv_w, *conv_b, *wa, *ba, *wx, *bx, *lam, *ckv_g, *ikg, *ikb, *w_uk, *w_uv, *w_out, *rel_bias, *fin_g;
    float* out; unsigned char* ws;
};
struct Frame {
    LAS unsigned char* lds;
    volatile LAS unsigned* MISC;
    gu32* ctl;
    int tid, lane, wave, vcu, G;
};
__device__ __forceinline__ float wave_sum(float v) {
#pragma unroll
    for (int o = 1; o < 64; o <<= 1) v += __shfl_xor(v, o);
    return v;
}
__device__ __forceinline__ int wave_sum_i(int v) {
#pragma unroll
    for (int o = 1; o < 64; o <<= 1) v += __shfl_xor(v, o);
    return v;
}
__device__ __forceinline__ float wave_max(float v) {
#pragma unroll
    for (int o = 1; o < 64; o <<= 1) v = fmaxf(v, __shfl_xor(v, o));
    return v;
}

__device__ __forceinline__ void p0_transpose_item(const float* W, int K, int N, int nblk, f16s* WT, LAS float* scr, int item, int lane) {
    const int kb = item / nblk, nb = item % nblk, k0 = 64 * kb, n0 = 32 * nb;
    const bool nok = (n0 + (lane & 31)) < N;
#pragma unroll 8
    for (int i = 0; i < 32; ++i) { const int kk = 2 * i + (lane >> 5); scr[kk * 33 + (lane & 31)] = nok ? W[(size_t)(k0 + kk) * N + n0 + (lane & 31)] : 0.f; }
    LDS_WAIT(); asm volatile("" ::: "memory");
    const int c = lane & 7;
#pragma unroll
    for (int j = 0; j < 4; ++j) { const int n = (lane >> 3) + 8 * j; const LAS float* s = scr + (8 * c) * 33 + n;
        v4u o; o.x = pkh(s[0 * 33], s[1 * 33]); o.y = pkh(s[2 * 33], s[3 * 33]); o.z = pkh(s[4 * 33], s[5 * 33]); o.w = pkh(s[6 * 33], s[7 * 33]);
        *(GAS v4u*)(WT + (size_t)(n0 + n) * K + k0 + 8 * c) = o; }
    LDS_WAIT(); asm volatile("" ::: "memory");
}
__device__ __forceinline__ void rms_row_to_f16(const float* xrow, const float* g, f16s* orow, int lane) {
    const GAS f32x4* xr = (const GAS f32x4*)xrow + lane; const GAS f32x4* gr = (const GAS f32x4*)g + lane;
    f32x4 v[8]; float s = 0.f;
#pragma unroll
    for (int j = 0; j < 8; ++j) { v[j] = xr[64 * j]; s += (v[j].x * v[j].x + v[j].y * v[j].y) + (v[j].z * v[j].z + v[j].w * v[j].w); }
    const float r = rsqrtf(wave_sum(s) * (1.f / DM) + EPS);
    GAS v2u* o8 = (GAS v2u*)orow + lane;
#pragma unroll
    for (int j = 0; j < 8; ++j) { const f32x4 gg = gr[64 * j]; v2u o; o.x = pkh(v[j].x * r * gg.x, v[j].y * r * gg.y); o.y = pkh(v[j].z * r * gg.z, v[j].w * r * gg.w); o8[64 * j] = o; }
}
__device__ __forceinline__ void p0_prologue(Frame& F, const Params& P) {
    LAS float* scr = (LAS float*)(F.lds + RING_OFF + F.wave * 16384);
    const int gw = F.vcu * NWAVES + F.wave, NGW = F.G * NWAVES;
    constexpr int NB_IN = NINP / 32, I_IN = (DM / 64) * NB_IN, NB_OUT = DM / 32, I_OUT = (DM / 64) * NB_OUT;
    f16s* WinT = (f16s*)(P.ws + WS_WIN); f16s* WoutT = (f16s*)(P.ws + WS_WOUT); f16s* Hn = (f16s*)(P.ws + WS_H);
    for (int it = gw; it < I_IN + I_OUT; it += NGW) {
        if (it < I_IN) p0_transpose_item(P.w_in, DM, NIN, NB_IN, WinT, scr, it, F.lane);
        else p0_transpose_item(P.w_out, DM, DM, NB_OUT, WoutT, scr, it - I_IN, F.lane);
    }
    for (int it = gw; it < NH * 16; it += NGW) { const int h = it >> 4; p0_transpose_item(P.w_uv + (size_t)h * CL * HD, CL, HD, HD / 32, (f16s*)(P.ws + WS_WUVT) + (size_t)h * HD * CL, scr, it & 15, F.lane); }
    for (int m = gw; m < M; m += NGW) rms_row_to_f16(P.x + (size_t)m * DM, P.norm_g, Hn + (size_t)m * DM, F.lane);
}

__device__ __forceinline__ void p2_gates_naive(Frame& F, const Params& P) {
    const f16s* proj = (const f16s*)(P.ws + WS_PROJ); float* abuf = (float*)(P.ws + WS_A); float* bbuf = (float*)(P.ws + WS_B);
    LAS float* xs = (LAS float*)(F.lds + RING_OFF);
    const int tid = F.tid;
    for (int it = F.vcu; it < (M / 16) * LRU_BLK; it += F.G) {
        const int rt = it >> 3, g = it & 7, r0 = rt * 16;
#pragma unroll
        for (int i = 0; i < 4; ++i) { const int e = tid + NT * i, r = e >> 7, c = e & 127, row = r0 + r, t = row & (SEQ - 1), ch = g * 128 + c;
            float v = P.conv_b[ch];
#pragma unroll
            for (int j = 0; j < 4; ++j) { const int tt = t - 3 + j; if (tt >= 0) v += h2f(proj[(size_t)(row - 3 + j) * NINP + C_XA + ch]) * P.conv_w[j * LRU_W + ch]; }
            xs[r * 128 + c] = v; }
        __syncthreads();
        const int j = tid & 127, rh = tid >> 7;
        float ar[4] = {0.f, 0.f, 0.f, 0.f}, ai[4] = {0.f, 0.f, 0.f, 0.f};
        const float* wag = P.wa + (size_t)g * 128 * 128; const float* wxg = P.wx + (size_t)g * 128 * 128;
        for (int i = 0; i < 128; ++i) { const float w1 = wag[i * 128 + j], w2 = wxg[i * 128 + j];
#pragma unroll
            for (int r = 0; r < 4; ++r) { const float xv = xs[(rh * 4 + r) * 128 + i]; ar[r] += xv * w1; ai[r] += xv * w2; } }
        const int ch = g * 128 + j; const float sp = log1pf(expf(-P.lam[ch])), bav = P.ba[ch], bxv = P.bx[ch];
#pragma unroll
        for (int r = 0; r < 4; ++r) { const int row = r0 + rh * 4 + r, t = row & (SEQ - 1);
            const float rg = sigmoidf_(ar[r] + bav), ig = sigmoidf_(ai[r] + bxv), la = -8.f * rg * sp, a = expf(la);
            float mult = sqrtf(-expm1f(2.f * la)); if (t == 0) mult = 1.f;
            abuf[(size_t)row * LRU_W + ch] = a; bbuf[(size_t)row * LRU_W + ch] = mult * (ig * xs[(rh * 4 + r) * 128 + j]); }
        __syncthreads();
    }
}
__device__ __forceinline__ void p2_qabs_naive(Frame& F, const Params& P) {
    const f16s* proj = (const f16s*)(P.ws + WS_PROJ); f16s* qabs = (f16s*)(P.ws + WS_QABS);
    LAS float* qs = (LAS float*)(F.lds + RING_OFF);
    const int tid = F.tid;
    for (int it = F.vcu; it < (M / 16) * NH; it += F.G) {
        const int rt = it >> 3, h = it & 7, r0 = rt * 16;
#pragma unroll
        for (int i = 0; i < 4; ++i) { const int e = tid + NT * i, r = e >> 7, c = e & 127; qs[r * 128 + c] = h2f(proj[(size_t)(r0 + r) * NINP + C_Q + h * HD + c]); }
        __syncthreads();
        const int c = tid & 255, rh = tid >> 8;
        float acc[8];
#pragma unroll
        for (int r = 0; r < 8; ++r) acc[r] = 0.f;
        const float* wk = P.w_uk + (size_t)h * HD * CL + c;
        for (int d = 0; d < HD; ++d) { const float w = wk[(size_t)d * CL];
#pragma unroll
            for (int r = 0; r < 8; ++r) acc[r] += qs[(rh * 8 + r) * 128 + d] * w; }
#pragma unroll
        for (int r = 0; r < 8; ++r) qabs[(size_t)(r0 + rh * 8 + r) * (NH * CL) + h * CL + c] = __builtin_bit_cast(f16s, (f16)acc[r]);
        __syncthreads();
    }
}
__device__ __forceinline__ void p2_norms(Frame& F, const Params& P) {
    const f16s* proj = (const f16s*)(P.ws + WS_PROJ); f16s* cn = (f16s*)(P.ws + WS_CN); f16s* kn = (f16s*)(P.ws + WS_KN);
    const int gw = F.vcu * NWAVES + F.wave, NGW = F.G * NWAVES, lane = F.lane;
    for (int row = gw; row < M; row += NGW) {
        const h4 cv = *(const GAS h4*)(proj + (size_t)row * NINP + C_CKV + 4 * lane);
        const float c0 = (float)cv[0], c1 = (float)cv[1], c2 = (float)cv[2], c3 = (float)cv[3];
        const float r = rsqrtf(wave_sum(c0 * c0 + c1 * c1 + c2 * c2 + c3 * c3) * (1.f / CL) + EPS);
        const f32x4 g = *(const GAS f32x4*)(P.ckv_g + 4 * lane);
        v2u o; o.x = pkh(c0 * r * g.x, c1 * r * g.y); o.y = pkh(c2 * r * g.z, c3 * r * g.w);
        *(GAS v2u*)(cn + (size_t)row * CL + 4 * lane) = o;
        const float kv = h2f(proj[(size_t)row * NINP + C_KI + lane]);
        const float mu = wave_sum(kv) * (1.f / ID), d = kv - mu, var = wave_sum(d * d) * (1.f / ID);
        kn[(size_t)row * ID + lane] = __builtin_bit_cast(f16s, (f16)(d * rsqrtf(var + EPS) * P.ikg[lane] + P.ikb[lane]));
    }
}

__device__ __forceinline__ void p3_scan_naive(Frame& F, const Params& P) {
    const int gw = F.vcu * NWAVES + F.wave;
    if (gw >= (BATCH * LRU_W) / 64) return;
    const f16s* proj = (const f16s*)(P.ws + WS_PROJ); const float* abuf = (const float*)(P.ws + WS_A); const float* bbuf = (const float*)(P.ws + WS_B); f16s* y = (f16s*)(P.ws + WS_H);
    const int gid = gw * 64 + F.lane, b = gid >> 10, ch = gid & 1023;
    float h = 0.f;
#pragma unroll 8
    for (int t = 0; t < SEQ; ++t) { const size_t row = (size_t)b * SEQ + t;
        h = abuf[row * LRU_W + ch] * h + bbuf[row * LRU_W + ch];
        y[row * DM + ch] = __builtin_bit_cast(f16s, (f16)(h * siluf_(h2f(proj[row * NINP + C_GA + ch])))); }
}
constexpr int AF_OFF = 0;
constexpr int TAB_OFF = RING_BYTES + 1024;
constexpr int IL_OFF = TAB_OFF;
constexpr int SGT_OFF = IL_OFF + 8192;
constexpr int CNT_OFF = SGT_OFF + 1024;
constexpr int WCNT_OFF = CNT_OFF + 128;
constexpr int CNTQ_OFF = WCNT_OFF + 256;
constexpr int BIAS_OFF = CNTQ_OFF + 64;
constexpr int TAB_END = BIAS_OFF + 4224;
static_assert(TAB_END <= LDS_BYTES, "LDS map");
typedef short v4i16 __attribute__((ext_vector_type(4)));
typedef _Float16 h4v __attribute__((ext_vector_type(4)));

__device__ __forceinline__ unsigned fkey(float f) { const unsigned u = __float_as_uint(f); return (u & 0x80000000u) ? ~u : (u | 0x80000000u); }
__device__ __forceinline__ unsigned rowsum16(unsigned v) { v += __shfl_xor(v, 1); v += __shfl_xor(v, 2); v += __shfl_xor(v, 4); v += __shfl_xor(v, 8); return v; }

__device__ __forceinline__ void p3_d1(Frame& F, const Params& P, int b, int i) {
    const f16s* proj = (const f16s*)(P.ws + WS_PROJ); const f16s* kn = (const f16s*)(P.ws + WS_KN);
    int tid = F.tid; asm volatile("" : "+v"(tid));
    const int lane = tid & 63, wave = F.wave, q = lane >> 4, fr = lane & 15;
    const int row0 = b * SEQ + 16 * i, ntile = i + 1;
    LAS unsigned char* AF = F.lds + AF_OFF;
    LAS float* SGT = (LAS float*)(F.lds + SGT_OFF);
    LAS unsigned* CNT = (LAS unsigned*)(F.lds + CNT_OFF);
    LAS unsigned* WCNT = (LAS unsigned*)(F.lds + WCNT_OFF);
    LAS unsigned* CNTQ = (LAS unsigned*)(F.lds + CNTQ_OFF);
    LAS unsigned short* IL = (LAS unsigned short*)(F.lds + IL_OFF);
#pragma unroll
    for (int e = 0; e < 4; ++e) { const int f = tid + NT * e, h = f >> 7, ks = (f >> 6) & 1, ln = f & 63, r = ln & 15, kq = ln >> 4;
        const f16s* rowp = proj + (size_t)(row0 + r) * NINP;
        const h8 v = *(const GAS h8*)(rowp + C_QI + h * 64 + 32 * ks + 8 * kq); const float w = fabsf(h2f(rowp[C_WI + h]));
        h8 o;
#pragma unroll
        for (int j = 0; j < 8; ++j) o[j] = (f16)((float)v[j] * w);
        *(LAS h8*)(AF + (h * 2 + ks) * 1024 + ln * 16) = o; }
    if (tid < 128) { const int ks = tid >> 6, ln = tid & 63, r = ln & 15, kq = ln >> 4; const f16s* rowp = proj + (size_t)(row0 + r) * NINP;
        float acc[8];
#pragma unroll
        for (int j = 0; j < 8; ++j) acc[j] = 0.f;
        for (int h = 0; h < IH; ++h) { const h8 v = *(const GAS h8*)(rowp + C_QI + h * 64 + 32 * ks + 8 * kq); const float w = h2f(rowp[C_WI + h]);
#pragma unroll
            for (int j = 0; j < 8; ++j) acc[j] += (float)v[j] * w; }
        h8 o;
#pragma unroll
        for (int j = 0; j < 8; ++j) o[j] = (f16)acc[j];
        *(LAS h8*)(AF + (32 + ks) * 1024 + ln * 16) = o; }
    if (tid < 256) { const int r = tid >> 4, h = tid & 15; SGT[h * 16 + r] = h2f(proj[(size_t)(row0 + r) * NINP + C_WI + h]) >= 0.f ? 1.f : -1.f; }
    if (tid < 24) CNT[tid] = 0u;
    __syncthreads();
    unsigned key[16][4];
    const f32x4 zero4 = {0.f, 0.f, 0.f, 0.f};
#pragma unroll
    for (int p = 0; p < 4; ++p) {
        f32x4 sc[4] = {zero4, zero4, zero4, zero4};
        if (wave + 32 * p < ntile) {
            h8 bk[4][2];
#pragma unroll
            for (int jj = 0; jj < 4; ++jj) { int kt = wave + 8 * (4 * p + jj); kt = kt < ntile ? kt : ntile - 1;
                const f16s* kr = kn + ((size_t)b * SEQ + 16 * kt + fr) * ID + 8 * q; bk[jj][0] = *(const GAS h8*)kr; bk[jj][1] = *(const GAS h8*)(kr + 32); }
            h8 a0 = *(const LAS h8*)(AF + lane * 16), a1 = *(const LAS h8*)(AF + 1024 + lane * 16);
            f32x4 sg = *(const LAS f32x4*)(SGT + 4 * q);
#pragma unroll
            for (int h = 0; h <= IH; ++h) {
                h8 n0 = a0, n1 = a1; f32x4 ng = sg;
                if (h < IH) { n0 = *(const LAS h8*)(AF + (2 * h + 2) * 1024 + lane * 16); n1 = *(const LAS h8*)(AF + (2 * h + 3) * 1024 + lane * 16); if (h + 1 < IH) ng = *(const LAS f32x4*)(SGT + (h + 1) * 16 + 4 * q); }
#pragma unroll
                for (int jj = 0; jj < 4; ++jj) { f32x4 S = __builtin_amdgcn_mfma_f32_16x16x32_f16(a0, bk[jj][0], zero4, 0, 0, 0); S = __builtin_amdgcn_mfma_f32_16x16x32_f16(a1, bk[jj][1], S, 0, 0, 0);
                    if (h < IH) {
#pragma unroll
                        for (int e = 0; e < 4; ++e) sc[jj][e] = __builtin_fmaf(__builtin_fabsf(S[e]), sg[e], sc[jj][e]);
                    } else sc[jj] += S; }
                asm volatile("" : "+v"(sc[0]), "+v"(sc[1]), "+v"(sc[2]), "+v"(sc[3]));
                __builtin_amdgcn_sched_barrier(0);
                a0 = n0; a1 = n1; sg = ng;
            }
            __builtin_amdgcn_sched_barrier(0);
        }
#pragma unroll
        for (int jj = 0; jj < 4; ++jj) { const int kt = wave + 8 * (4 * p + jj);
#pragma unroll
            for (int e = 0; e < 4; ++e) { const bool valid = (kt < i) || (kt == i && fr <= 4 * q + e); key[4 * p + jj][e] = valid ? fkey(sc[jj][e]) : 0u; } }
        __builtin_amdgcn_sched_barrier(0);
    }
    unsigned lo[4], hi[4], thr[4]; bool dn[4];
#pragma unroll
    for (int e = 0; e < 4; ++e) { dn[e] = (16 * i + 4 * q + e + 1) <= TOPK; thr[e] = 1u; lo[e] = 0u; hi[e] = 0xFFFFFFFFu; }
    for (int it = 0; it < 40; ++it) {
        if (__all(dn[0] && dn[1] && dn[2] && dn[3])) break;
        unsigned mid[4];
#pragma unroll
        for (int e = 0; e < 4; ++e) { const unsigned d = hi[e] - lo[e]; mid[e] = lo[e] + (d >> 1) + (d & 1u); }
        unsigned c01 = 0u, c23 = 0u;
#pragma unroll
        for (int j = 0; j < 16; ++j) { c01 += (key[j][0] >= mid[0] ? 1u : 0u) + (key[j][1] >= mid[1] ? 0x10000u : 0u); c23 += (key[j][2] >= mid[2] ? 1u : 0u) + (key[j][3] >= mid[3] ? 0x10000u : 0u); }
        c01 = rowsum16(c01); c23 = rowsum16(c23);
        LAS unsigned* C = CNT + (it % 3) * 8;
        if (fr == 0) { __hip_atomic_fetch_add(&C[2 * q], c01, __ATOMIC_RELAXED, __HIP_MEMORY_SCOPE_WORKGROUP); __hip_atomic_fetch_add(&C[2 * q + 1], c23, __ATOMIC_RELAXED, __HIP_MEMORY_SCOPE_WORKGROUP); }
        if (tid < 8) CNT[((it + 1) % 3) * 8 + tid] = 0u;
        __syncthreads();
        const unsigned cc01 = C[2 * q], cc23 = C[2 * q + 1];
        const unsigned cnt[4] = {cc01 & 0xFFFFu, cc01 >> 16, cc23 & 0xFFFFu, cc23 >> 16};
#pragma unroll
        for (int e = 0; e < 4; ++e) if (!dn[e]) {
            if (cnt[e] == (unsigned)TOPK) { thr[e] = mid[e]; dn[e] = true; }
            else { if (cnt[e] > (unsigned)TOPK) lo[e] = mid[e]; else hi[e] = mid[e] - 1u; if (lo[e] == hi[e]) { thr[e] = lo[e]; dn[e] = true; } } }
    }
    {
        unsigned c01 = 0u, c23 = 0u;
#pragma unroll
        for (int j = 0; j < 16; ++j) { c01 += (key[j][0] >= thr[0] ? 1u : 0u) + (key[j][1] >= thr[1] ? 0x10000u : 0u); c23 += (key[j][2] >= thr[2] ? 1u : 0u) + (key[j][3] >= thr[3] ? 0x10000u : 0u); }
        c01 = rowsum16(c01); c23 = rowsum16(c23);
        if (fr == 0) { WCNT[wave * 8 + 2 * q] = c01; WCNT[wave * 8 + 2 * q + 1] = c23; }
        __syncthreads();
        unsigned b01 = 0u, b23 = 0u, t01 = 0u, t23 = 0u;
#pragma unroll
        for (int w = 0; w < NWAVES; ++w) { const unsigned x01 = WCNT[w * 8 + 2 * q], x23 = WCNT[w * 8 + 2 * q + 1]; t01 += x01; t23 += x23; if (w < wave) { b01 += x01; b23 += x23; } }
        unsigned base[4] = {b01 & 0xFFFFu, b01 >> 16, b23 & 0xFFFFu, b23 >> 16};
        if (wave == 0 && fr == 0) { const unsigned tot[4] = {t01 & 0xFFFFu, t01 >> 16, t23 & 0xFFFFu, t23 >> 16};
#pragma unroll
            for (int e = 0; e < 4; ++e) CNTQ[4 * q + e] = tot[e] < (unsigned)TOPK ? tot[e] : (unsigned)TOPK; }
        const unsigned ltmask = (1u << fr) - 1u;
#pragma unroll
        for (int j = 0; j < 16; ++j)
#pragma unroll
            for (int e = 0; e < 4; ++e) { const bool sel = key[j][e] >= thr[e];
                const unsigned long long m = __ballot(sel); const unsigned sub = (unsigned)(m >> (16 * q)) & 0xFFFFu;
                const unsigned pos = base[e] + __builtin_popcount(sub & ltmask);
                if (sel && pos < (unsigned)TOPK) IL[(4 * q + e) * TOPK + pos] = (unsigned short)(16 * (wave + 8 * j) + fr);
                base[e] += __builtin_popcount(sub); }
    }
    __syncthreads();
}

__device__ __forceinline__ void attn_query_naive(Frame& F, const Params& P, int row, const LAS unsigned short* il, int cnt) {
    const f16s* proj = (const f16s*)(P.ws + WS_PROJ); const f16s* cn = (const f16s*)(P.ws + WS_CN);
    const f16s* qabs = (const f16s*)(P.ws + WS_QABS); f16s* y = (f16s*)(P.ws + WS_H);
    LAS float* qa = (LAS float*)(F.lds + 40960);
    LAS float* lg = qa + 2048;
    LAS float* os = lg + 2048;
    int tid = F.tid; asm volatile("" : "+v"(tid));
    const int lane = tid & 63, wave = F.wave;
    const int b = row >> 11, t = row & (SEQ - 1);
#pragma unroll
    for (int k = 0; k < 4; ++k) qa[tid + NT * k] = h2f(qabs[(size_t)row * (NH * CL) + tid + NT * k]);
    __syncthreads();
    {   const int j = tid & 255, hh = tid >> 8, s = j < cnt ? (int)il[j] : -1;
        float l[4] = {0.f, 0.f, 0.f, 0.f};
        if (s >= 0) {
            const GAS h8* cr = (const GAS h8*)(cn + ((size_t)b * SEQ + s) * CL);
            for (int c8 = 0; c8 < CL / 8; ++c8) { const h8 v = cr[c8];
#pragma unroll
                for (int e = 0; e < 8; ++e) { const float cv = (float)v[e];
#pragma unroll
                    for (int h = 0; h < 4; ++h) l[h] += qa[(hh * 4 + h) * CL + c8 * 8 + e] * cv; } }
            const int dist = t - s, bk = dist < 128 ? (int)BUCKET[dist] : 31;
#pragma unroll
            for (int h = 0; h < 4; ++h) l[h] = l[h] * 0.08838834764831845f + P.rel_bias[bk * NH + hh * 4 + h];
        } else {
#pragma unroll
            for (int h = 0; h < 4; ++h) l[h] = -INFINITY;
        }
#pragma unroll
        for (int h = 0; h < 4; ++h) lg[(hh * 4 + h) * TOPK + j] = l[h];
    }
    __syncthreads();
    {   float v[4], mx = -INFINITY;
#pragma unroll
        for (int k = 0; k < 4; ++k) { v[k] = lg[wave * TOPK + lane + 64 * k]; mx = fmaxf(mx, v[k]); }
        mx = wave_max(mx);
        float sm = 0.f;
#pragma unroll
        for (int k = 0; k < 4; ++k) { v[k] = expf(v[k] - mx); sm += v[k]; }
        const float inv = 1.f / wave_sum(sm);
#pragma unroll
        for (int k = 0; k < 4; ++k) lg[wave * TOPK + lane + 64 * k] = v[k] * inv;
    }
    __syncthreads();
    {   const int c = tid & 255, hh = tid >> 8;
        float o[4] = {0.f, 0.f, 0.f, 0.f};
        for (int j = 0; j < cnt; ++j) { const int s = il[j];
            const float cv = h2f(cn[((size_t)b * SEQ + s) * CL + c]);
#pragma unroll
            for (int h = 0; h < 4; ++h) o[h] += lg[(hh * 4 + h) * TOPK + j] * cv; }
#pragma unroll
        for (int h = 0; h < 4; ++h) os[(hh * 4 + h) * CL + c] = o[h];
    }
    __syncthreads();
#pragma unroll
    for (int k = 0; k < 2; ++k) { const int h = k * 4 + (tid >> 7), d = tid & 127;
        const float* wv = P.w_uv + (size_t)h * CL * HD + d; float acc = 0.f;
        for (int c = 0; c < CL; ++c) acc += os[h * CL + c] * wv[(size_t)c * HD];
        const float gb = h2f(proj[(size_t)row * NINP + C_GB + h * HD + d]);
        y[(size_t)row * DM + LRU_W + h * HD + d] = __builtin_bit_cast(f16s, (f16)(acc * siluf_(gb))); }
    __syncthreads();
}


__device__ __forceinline__ void p3_d2_query(const Params& P, LAS unsigned char* lds, LAS unsigned char* buf, int lane, int b, int t, int row, int r) {
    const f16s* cn = (const f16s*)(P.ws + WS_CN); const f16s* qabs = (const f16s*)(P.ws + WS_QABS); f16s* obuf = (f16s*)P.out;
    const LAS unsigned short* il = (const LAS unsigned short*)(lds + IL_OFF) + r * TOPK;
    const LAS float* BIAS = (const LAS float*)(lds + BIAS_OFF);
    const int cnt = (int)((const LAS unsigned*)(lds + CNTQ_OFF))[r];
    const int q = lane >> 4, fr = lane & 15;
    h8 qb[8];
    { const f16s* qp = qabs + (size_t)row * (NH * CL) + (fr & 7) * CL + 8 * q;
#pragma unroll
      for (int ks = 0; ks < 8; ++ks) qb[ks] = *(const GAS h8*)(qp + 32 * ks); }
    const int cp = lane & 15;
    const char* cnb = (const char*)(cn + (size_t)b * SEQ * CL);
    auto issue = [&](int c) {
        LAS unsigned char* dst = buf + (c & 1) * 8192;
#pragma unroll
        for (int kq = 0; kq < 4; ++kq) { const int rw = 4 * kq + q; int pos = 16 * c + rw; pos = pos < cnt ? pos : 0;
            const int key = il[pos]; const int fx = ((rw & 3) << 2) | ((rw >> 2) & 3);
            const char* src = cnb + (size_t)key * (CL * 2) + 16 * (cp ^ fx);
            __builtin_amdgcn_global_load_lds((const unsigned*)src, (LAS unsigned*)(dst + kq * 1024), 16, 0, 0);
            __builtin_amdgcn_global_load_lds((const unsigned*)(src + 256), (LAS unsigned*)(dst + 4096 + kq * 1024), 16, 0, 0); }
    };
    int roff[4];
#pragma unroll
    for (int s = 0; s < 4; ++s) roff[s] = 256 * fr + 64 * (s ^ (fr & 3)) + 16 * (q ^ ((fr >> 2) & 3));
    const int qq = fr >> 2, pp = fr & 3;
    const int trb = 256 * (4 * q + qq) + 16 * ((((pp >> 1) ^ (q & 1)) | (q & 2)) ^ (qq << 2)) + 8 * (pp & 1);
    f32x4 Y[16];
    const f32x4 zero4 = {0.f, 0.f, 0.f, 0.f};
#pragma unroll
    for (int ct = 0; ct < 16; ++ct) Y[ct] = zero4;
    float m = -INFINITY, ssum = 0.f;
    issue(0);
    for (int c = 0; c < 16; ++c) {
        if (c + 1 < 16) { issue(c + 1); asm volatile("s_waitcnt vmcnt(8)" ::: "memory"); }
        else asm volatile("s_waitcnt vmcnt(0)" ::: "memory");
        const LAS unsigned char* bb = buf + (c & 1) * 8192;
        f32x4 X = zero4;
#pragma unroll
        for (int s = 0; s < 8; ++s) { const h8 a = *(const LAS h8*)(bb + (s >> 2) * 4096 + roff[s & 3]); X = __builtin_amdgcn_mfma_f32_16x16x32_f16(a, qb[s], X, 0, 0, 0); }
        float l[4];
        { const v4i16 kk = *(const LAS v4i16*)(il + 16 * c + 4 * q);
#pragma unroll
          for (int e = 0; e < 4; ++e) { const int pos = 16 * c + 4 * q + e; int d = t - (int)(unsigned short)kk[e]; d = d < 0 ? 0 : (d > 128 ? 128 : d);
              const float bs = BIAS[d * 8 + (fr & 7)]; l[e] = pos < cnt ? X[e] * 0.08838834764831845f + bs : -INFINITY; } }
        float mx = fmaxf(fmaxf(l[0], l[1]), fmaxf(l[2], l[3]));
        mx = fmaxf(mx, __shfl_xor(mx, 16)); mx = fmaxf(mx, __shfl_xor(mx, 32));
        if (c == 0) m = mx;
        else if (__any(mx > m + 8.f)) { const float mn = fmaxf(m, mx), al = __expf(m - mn);
#pragma unroll
            for (int ct = 0; ct < 16; ++ct) Y[ct] *= al;
            ssum *= al; m = mn; }
        float p[4];
#pragma unroll
        for (int e = 0; e < 4; ++e) { p[e] = __expf(l[e] - m); ssum += p[e]; }
        h8 pb;
#pragma unroll
        for (int e = 0; e < 4; ++e) { pb[e] = (f16)p[e]; pb[4 + e] = (f16)0.f; }
#pragma unroll
        for (int ct = 0; ct < 16; ++ct) {
            const v4i16 tv = __builtin_amdgcn_ds_read_tr16_b64_v4i16((LAS v4i16*)(bb + (ct >> 3) * 4096 + (trb ^ (32 * (ct & 7)))));
            const h4v th = __builtin_bit_cast(h4v, tv);
            const h8 a2 = __builtin_shufflevector(th, th, 0, 1, 2, 3, 0, 1, 2, 3);
            Y[ct] = __builtin_amdgcn_mfma_f32_16x16x32_f16(a2, pb, Y[ct], 0, 0, 0); }
    }
    ssum += __shfl_xor(ssum, 16); ssum += __shfl_xor(ssum, 32);
    const float inv = 1.f / ssum;
    if (fr < 8) { f16s* op = obuf + (size_t)row * (NH * CL) + fr * CL + 4 * q;
#pragma unroll
        for (int ct = 0; ct < 16; ++ct) { v2u o; o.x = pkh(Y[ct][0] * inv, Y[ct][1] * inv); o.y = pkh(Y[ct][2] * inv, Y[ct][3] * inv); *(GAS v2u*)(op + 16 * ct) = o; } }
}

__device__ __forceinline__ void p3_v(const Params& P, int lane, int h, int row0) {
    const f16s* obuf = (const f16s*)P.out; const f16s* wT = (const f16s*)(P.ws + WS_WUVT) + (size_t)h * HD * CL; const f16s* proj = (const f16s*)(P.ws + WS_PROJ); f16s* y = (f16s*)(P.ws + WS_H);
    const int q = lane >> 4, fr = lane & 15;
    h8 ob[8];
    { const f16s* op = obuf + (size_t)(row0 + fr) * (NH * CL) + h * CL + 8 * q;
#pragma unroll
      for (int ks = 0; ks < 8; ++ks) ob[ks] = *(const GAS h8*)(op + 32 * ks); }
    const f32x4 zero4 = {0.f, 0.f, 0.f, 0.f};
#pragma unroll
    for (int nt = 0; nt < 8; ++nt) {
        f32x4 acc = zero4;
        const f16s* wp = wT + (size_t)(16 * nt + fr) * CL + 8 * q;
#pragma unroll
        for (int ks = 0; ks < 8; ++ks) { const h8 a = *(const GAS h8*)(wp + 32 * ks); acc = __builtin_amdgcn_mfma_f32_16x16x32_f16(a, ob[ks], acc, 0, 0, 0); }
        const size_t col = (size_t)h * HD + 16 * nt + 4 * q;
        const h4v g = *(const GAS h4v*)(proj + (size_t)(row0 + fr) * NINP + C_GB + col);
        v2u o; o.x = pkh(acc[0] * siluf_((float)g[0]), acc[1] * siluf_((float)g[1])); o.y = pkh(acc[2] * siluf_((float)g[2]), acc[3] * siluf_((float)g[3]));
        *(GAS v2u*)(y + (size_t)(row0 + fr) * DM + LRU_W + col) = o;
    }
}

__device__ __forceinline__ void p3_items(Frame& F, const Params& P) {
    {
        LAS float* BIAS = (LAS float*)(F.lds + BIAS_OFF);
        for (int e = F.tid; e < 129 * 8; e += NT) { const int d = e >> 3, h = e & 7; BIAS[e] = P.rel_bias[(d < 128 ? (int)BUCKET[d] : 31) * NH + h]; }
    }
    __syncthreads();
    for (int u = F.vcu; u < BATCH * (SEQ / 16); u += F.G) {
        const int up = u & 255, k = u >> 8, b = up >> 6, j = up & 63, i = k ? 127 - j : j;
        p3_d1(F, P, b, i);
        int lane = F.lane; asm volatile("" : "+v"(lane));
        LAS unsigned char* buf = F.lds + F.wave * 16384;
#pragma unroll 1
        for (int rr = 0; rr < 2; ++rr) { const int r = 2 * F.wave + rr; p3_d2_query(P, F.lds, buf, lane, b, 16 * i + r, b * SEQ + 16 * i + r, r); }
        asm volatile("s_waitcnt vmcnt(0)" ::: "memory");
        __syncthreads();
        p3_v(P, lane, F.wave, b * SEQ + 16 * i);
        __syncthreads();
    }
}

__device__ __forceinline__ void p5_final(Frame& F, const Params& P) {
    const int gw = F.vcu * NWAVES + F.wave, NGW = F.G * NWAVES, lane = F.lane;
    for (int m = gw; m < M; m += NGW) {
        GAS f32x4* xr = (GAS f32x4*)(P.out + (size_t)m * DM) + lane; const GAS f32x4* gr = (const GAS f32x4*)P.fin_g + lane;
        f32x4 v[8]; float s = 0.f;
#pragma unroll
        for (int j = 0; j < 8; ++j) { v[j] = xr[64 * j]; s += (v[j].x * v[j].x + v[j].y * v[j].y) + (v[j].z * v[j].z + v[j].w * v[j].w); }
        const float r = rsqrtf(wave_sum(s) * (1.f / DM) + EPS);
#pragma unroll
        for (int j = 0; j < 8; ++j) xr[64 * j] = v[j] * r * gr[64 * j];
    }
}

__global__ void __launch_bounds__(NT, 2) fwd_kernel(Params P) {
    extern __shared__ __attribute__((aligned(16))) unsigned char lds[];
    Frame F;
    F.lds = (LAS unsigned char*)lds;
    F.MISC = (volatile LAS unsigned*)(F.lds + MISC_OFF);
    F.tid = threadIdx.x; F.lane = F.tid & 63; F.wave = __builtin_amdgcn_readfirstlane(F.tid >> 6);
    F.G = gridDim.x; { const int bx = blockIdx.x; F.vcu = (F.G % 8 == 0) ? (bx % 8) * (F.G / 8) + bx / 8 : bx; }
    F.ctl = (gu32*)(P.ws + WS_CTL);
    for (int u = F.tid; u < (LDS_BYTES - LDSCTL_OFF) / 4; u += NT) ((LAS unsigned*)(F.lds + LDSCTL_OFF))[u] = 0u;
    __syncthreads();
    XcdBarrier bar = xcd_barrier_post((unsigned*)(F.ctl + CW_BAR), F.MISC + 8);

    p0_prologue(F, P);
    xcd_barrier(bar);
    {
        pg8::Gemm g{(const pg8::bf16_t*)(P.ws + WS_H), (const pg8::bf16_t*)(P.ws + WS_WIN), M, NINP, DM};
        pg8::StaticOrder S; S.init(M, NINP, F.G, (int)blockIdx.x);
        pg8::EpiF16 E{(pg8::bf16_t*)(P.ws + WS_PROJ), NINP};
        pg8::gemm_phase<pg8::EpiF16, pg8::StaticOrder, true, true>(F.lds + RING_OFF, g, S, E);
    }
    xcd_barrier(bar);
    p2_gates_naive(F, P);
    p2_qabs_naive(F, P);
    p2_norms(F, P);
    xcd_barrier(bar);
    p3_scan_naive(F, P);
    p3_items(F, P);
    xcd_barrier(bar);
    {
        pg8::Gemm g{(const pg8::bf16_t*)(P.ws + WS_H), (const pg8::bf16_t*)(P.ws + WS_WOUT), M, DM, DM};
        pg8::StaticOrder S; S.init(M, DM, F.G, (int)blockIdx.x);
        pg8::EpiResF32 E{P.x, P.out, DM};
        pg8::gemm_phase<pg8::EpiResF32, pg8::StaticOrder, false, true>(F.lds + RING_OFF, g, S, E);
    }
    xcd_barrier(bar);
    p5_final(F, P);
}

extern "C" void kernel_launch(void* const* d_in, const int* in_sizes, int n_in, void* d_out, int out_size, void* d_ws, size_t ws_size, hipStream_t stream) {
    static int grid = 0;
    if (grid == 0) {
        if (n_in != 18 || out_size != M * DM || ws_size < WS_END) { fprintf(stderr, "kernel_launch: unexpected shapes (n_in %d out %d ws %zu)\n", n_in, out_size, ws_size); grid = -1; return; }
        int dev = 0, cus = 0, per_cu = 0;
        if (hipGetDevice(&dev) != hipSuccess || hipDeviceGetAttribute(&cus, hipDeviceAttributeMultiprocessorCount, dev) != hipSuccess) { grid = -1; return; }
        if (hipFuncSetAttribute((const void*)fwd_kernel, hipFuncAttributeMaxDynamicSharedMemorySize, LDS_BYTES) != hipSuccess) { fprintf(stderr, "kernel_launch: hipFuncSetAttribute failed\n"); grid = -1; return; }
        if (hipOccupancyMaxActiveBlocksPerMultiprocessor(&per_cu, (const void*)fwd_kernel, NT, LDS_BYTES) != hipSuccess || per_cu < 1) fprintf(stderr, "kernel_launch: occupancy query says %d\n", per_cu);
        (void)hipGetLastError();
        grid = cus;
    }
    if (grid < 0) return;
    (void)hipMemsetAsync((char*)d_ws + WS_CTL, 0, CTL_ZERO_BYTES, stream);
    Params p{};
    p.x = (const float*)d_in[0]; p.norm_g = (const float*)d_in[1]; p.w_in = (const float*)d_in[2]; p.conv_w = (const float*)d_in[3]; p.conv_b = (const float*)d_in[4];
    p.wa = (const float*)d_in[5]; p.ba = (const float*)d_in[6]; p.wx = (const float*)d_in[7]; p.bx = (const float*)d_in[8]; p.lam = (const float*)d_in[9];
    p.ckv_g = (const float*)d_in[10]; p.ikg = (const float*)d_in[11]; p.ikb = (const float*)d_in[12]; p.w_uk = (const float*)d_in[13]; p.w_uv = (const float*)d_in[14];
    p.w_out = (const float*)d_in[15]; p.rel_bias = (const float*)d_in[16]; p.fin_g = (const float*)d_in[17];
    p.out = (float*)d_out; p.ws = (unsigned char*)d_ws;
    hipLaunchKernelGGL(fwd_kernel, dim3(grid), dim3(NT), LDS_BYTES, stream, p);
}
```

```cpp
#include <hip/hip_runtime.h>
#include <cstdio>
#include <cstdint>
namespace pg8 {
#define PG8_LAS __attribute__((address_space(3)))
typedef unsigned short bf16_t;
typedef _Float16 f16x8 __attribute__((ext_vector_type(8)));
typedef _Float16 f16x2 __attribute__((ext_vector_type(2)));
typedef float f32x2 __attribute__((ext_vector_type(2)));
typedef float f32x4 __attribute__((ext_vector_type(4)));
typedef unsigned u32x4 __attribute__((ext_vector_type(4)));
constexpr int BM = 256, BK = 64, HALF = 128, HTB = HALF * BK * 2  , STAGE_BYTES = 8 * HTB, NXCD = 8, WGM = 8;

__host__ __device__ __forceinline__ int lds_byte(int r, int c) { const int st = (r >> 4) * 2 + (c >> 5), rr = r & 15, cc = c & 31, ob = rr * 64 + cc * 2; return st * 1024 + (ob ^ (((ob >> 9) & 1) << 5)); }
__host__ __device__ __forceinline__ void stage_rc(int b, int& R, int& C) { const int st = b / 1024, sb = b % 1024, swz = sb ^ (((sb >> 9) & 1) << 5); R = (st >> 1) * 16 + swz / 64; C = (st & 1) * 32 + (swz % 64) / 2; }
__host__ __device__ __forceinline__ int perm32(int rho) { const int n = rho >> 4, i = rho & 15; return 8 * (i >> 2) + 4 * n + (i & 3); }

struct Unit { int pm, pn; };
struct Gemm { const bf16_t* A; const bf16_t* Bt; int M, N, K; };

struct StaticOrder {
    int nM, nN, nwg, G, c;
    __host__ __device__ void init(int M, int N, int G_, int c_) { nM = M / BM; nN = N / BM; nwg = nM * nN; G = G_; c = c_; }
    __host__ __device__ bool next(int i, Unit& u) const {
        const long L = (long)i * G + c; if (L >= nwg) return false;
        int wgid = (int)L; { const int q = nwg / NXCD, r = nwg % NXCD, xcd = wgid % NXCD, off = wgid / NXCD; wgid = (xcd < r ? xcd * (q + 1) : r * (q + 1) + (xcd - r) * q) + off; }
        const int nig = WGM * nN, gid = wgid / nig, fm = gid * WGM, gsz = (nM - fm) < WGM ? (nM - fm) : WGM;
        u.pm = fm + ((wgid % nig) % gsz); u.pn = (wgid % nig) / gsz; return true;
    }
    __device__ __forceinline__ void a_ready(const Unit&) const {}
    __device__ __forceinline__ void done(const Unit&) const {}
};

__device__ __forceinline__ unsigned cvt_pk_f16(float lo, float hi) { const f32x2 v = {lo, hi}; return __builtin_bit_cast(unsigned, __builtin_convertvector(v, f16x2)); }
struct EpiF16 {
    static constexpr bool PERM = true, AFTER_DRAIN = false;
    bf16_t* O; int ldc;
    __device__ __forceinline__ void operator()(const f32x4 (&acc)[2][2][4][2], const Unit& u, int wr, int wc, int fr, int fq) const {
        const int row0 = u.pm * BM + wr * 64 + fr, col0 = u.pn * BM + wc * 32 + 8 * fq;
#pragma unroll
        for (int ai = 0; ai < 2; ++ai)
#pragma unroll
            for (int m = 0; m < 4; ++m) { bf16_t* rowp = O + (size_t)(row0 + ai * HALF + m * 16) * ldc + col0;
#pragma unroll
                for (int bj = 0; bj < 2; ++bj) { const f32x4 v0 = acc[ai][bj][m][0], v1 = acc[ai][bj][m][1];
                    u32x4 w; w.x = cvt_pk_f16(v0[0], v0[1]); w.y = cvt_pk_f16(v0[2], v0[3]); w.z = cvt_pk_f16(v1[0], v1[1]); w.w = cvt_pk_f16(v1[2], v1[3]);
                    *(u32x4*)(rowp + bj * HALF) = w; } }
    }
};
struct EpiResF32 {
    static constexpr bool PERM = false, AFTER_DRAIN = false;
    const float* base; float* out; int ldc;
    __device__ __forceinline__ void operator()(const f32x4 (&acc)[2][2][4][2], const Unit& u, int wr, int wc, int fr, int fq) const {
        const int row0 = u.pm * BM + wr * 64 + fr, col0 = u.pn * BM + wc * 32 + 4 * fq;
#pragma unroll
        for (int ai = 0; ai < 2; ++ai)
#pragma unroll
            for (int m = 0; m < 4; ++m) { const size_t off = (size_t)(row0 + ai * HALF + m * 16) * ldc + col0;
#pragma unroll
                for (int bj = 0; bj < 2; ++bj)
#pragma unroll
                    for (int n = 0; n < 2; ++n) *(f32x4*)(out + off + bj * HALF + n * 16) = *(const f32x4*)(base + off + bj * HALF + n * 16) + acc[ai][bj][m][n]; }
    }
};

template <class Epi, class Sched, bool ALIGN_EPI = false, bool SP2 = false>
__device__ __forceinline__ void gemm_phase(PG8_LAS unsigned char* lds, const Gemm g, const Sched& S, const Epi& E) {
    const int tid = threadIdx.x, wid = __builtin_amdgcn_readfirstlane(tid >> 6), lane = tid & 63, wr = wid >> 2, wc = wid & 3, fr = lane & 15, fq = lane >> 4;
    const int K = g.K, nt = K / BK;
    unsigned voffA[2], voffB[2];
#pragma unroll
    for (int i = 0; i < 2; ++i) { int R, C; stage_rc(tid * 16 + i * 8192, R, C); const int Rb = Epi::PERM ? ((R & ~31) + perm32(R & 31)) : R;
        voffA[i] = (unsigned)(R * K + C) * 2u; voffB[i] = (unsigned)(Rb * K + C) * 2u; }
    const size_t kstep = (size_t)(BK * 2);
    const size_t hstep = (size_t)HALF * K * 2;
    const size_t tstep = 2 * hstep;
    const unsigned ldsw = (unsigned)wid * 1024u;
    const int aoff = lds_byte(wr * 64 + fr, fq * 8), boff = lds_byte(wc * 32 + fr, fq * 8);
#define PG8_SA(b, h) (((b) * 2 + (h)) * HTB)
#define PG8_SB(b, h) ((4 + (b) * 2 + (h)) * HTB)
#define PG8_STAGE(bufoff, gbase, voff) do { _Pragma("unroll") for (int _i = 0; _i < 2; ++_i) \
        __builtin_amdgcn_global_load_lds((const unsigned*)((const char*)(gbase) + (voff)[_i]), (PG8_LAS unsigned*)(lds + (bufoff) + ldsw + _i * 8192), 16, 0, 0); } while (0)
#define PG8_LDA(dst, b, h) do { _Pragma("unroll") for (int m = 0; m < 4; ++m) _Pragma("unroll") for (int k = 0; k < 2; ++k) dst[m][k] = *(const PG8_LAS f16x8*)(lds + PG8_SA(b, h) + aoff + m * 2048 + k * 1024); } while (0)
#define PG8_LDB(dst, b, h) do { _Pragma("unroll") for (int n = 0; n < 2; ++n) _Pragma("unroll") for (int k = 0; k < 2; ++k) dst[n][k] = *(const PG8_LAS f16x8*)(lds + PG8_SB(b, h) + boff + n * 2048 + k * 1024); } while (0)
#define PG8_MMA(ai, bj, At, Bt) do { __builtin_amdgcn_s_setprio(1); _Pragma("unroll") for (int m = 0; m < 4; ++m) _Pragma("unroll") for (int n = 0; n < 2; ++n) _Pragma("unroll") for (int k = 0; k < 2; ++k) \
        acc[ai][bj][m][n] = __builtin_amdgcn_mfma_f32_16x16x32_f16(Bt[n][k], At[m][k], acc[ai][bj][m][n], 0, 0, 0); __builtin_amdgcn_s_setprio(0); } while (0)
#define PG8_WAIT_V(n) asm volatile("s_waitcnt vmcnt(" #n ")" ::: "memory")
#define PG8_WAIT_L(n) asm volatile("s_waitcnt lgkmcnt(" #n ")" ::: "memory")
#define PG8_BAR __builtin_amdgcn_s_barrier()
#define PG8_SCHED __builtin_amdgcn_sched_barrier(0)
    Unit cur, nxt; int ui = 0;
    if (!S.next(0, cur)) return;
    f32x4 acc[2][2][4][2];
#pragma unroll
    for (int a = 0; a < 2; ++a)
#pragma unroll
        for (int b = 0; b < 2; ++b)
#pragma unroll
            for (int m = 0; m < 4; ++m)
#pragma unroll
                for (int n = 0; n < 2; ++n) acc[a][b][m][n] = (f32x4){0.f, 0.f, 0.f, 0.f};
    f16x8 At[4][2], B0[2][2], B1[2][2];
    const char* cA = (const char*)g.A + (size_t)cur.pm * tstep; const char* cB = (const char*)g.Bt + (size_t)cur.pn * tstep;
    S.a_ready(cur);
    if constexpr (SP2) {
        PG8_STAGE(PG8_SB(0, 0), cB, voffB); PG8_STAGE(PG8_SB(0, 1), cB + hstep, voffB); PG8_STAGE(PG8_SA(0, 0), cA, voffA); PG8_STAGE(PG8_SA(0, 1), cA + hstep, voffA);
        if (wr == 1) PG8_BAR;
        PG8_WAIT_V(2); PG8_BAR;
        PG8_STAGE(PG8_SB(1, 0), cB + kstep, voffB); PG8_STAGE(PG8_SA(1, 0), cA + kstep, voffA); PG8_STAGE(PG8_SB(1, 1), cB + hstep + kstep, voffB);
        PG8_WAIT_V(6); PG8_BAR;
    } else {
        PG8_STAGE(PG8_SB(0, 0), cB, voffB); PG8_STAGE(PG8_SA(0, 0), cA, voffA); PG8_STAGE(PG8_SB(0, 1), cB + hstep, voffB); PG8_STAGE(PG8_SA(0, 1), cA + hstep, voffA);
        if (wr == 1) PG8_BAR;
        PG8_WAIT_V(4); PG8_BAR;
        PG8_STAGE(PG8_SB(1, 0), cB + kstep, voffB); PG8_STAGE(PG8_SA(1, 0), cA + kstep, voffA); PG8_STAGE(PG8_SB(1, 1), cB + hstep + kstep, voffB);
        PG8_WAIT_V(6); PG8_BAR;
    }
    for (;;) {
        const bool has_next = S.next(ui + 1, nxt);
        const char* nA = has_next ? (const char*)g.A + (size_t)nxt.pm * tstep : cA; const char* nB = has_next ? (const char*)g.Bt + (size_t)nxt.pn * tstep : cB;
        for (int t = 0; t < nt; t += 2) {
            const bool last = (t == nt - 2);
            const char* a1 = cA + (size_t)(t + 1) * kstep;
            const char* a2 = last ? nA : cA + (size_t)(t + 2) * kstep; const char* b2 = last ? nB : cB + (size_t)(t + 2) * kstep;
            const char* a3 = a2 + kstep; const char* b3 = b2 + kstep;
            if (last && has_next) S.a_ready(nxt);
            if constexpr (SP2) {
            PG8_LDB(B0, 0, 0); PG8_LDB(B1, 0, 1); PG8_SCHED; PG8_LDA(At, 0, 0); PG8_STAGE(PG8_SA(1, 1), a1 + hstep, voffA);
            PG8_WAIT_V(8); PG8_WAIT_L(0); PG8_BAR; PG8_MMA(0, 0, At, B0); PG8_MMA(0, 1, At, B1); PG8_BAR; PG8_SCHED;
            PG8_LDA(At, 0, 1); PG8_STAGE(PG8_SB(0, 0), b2, voffB); PG8_STAGE(PG8_SB(0, 1), b2 + hstep, voffB); PG8_STAGE(PG8_SA(0, 0), a2, voffA);
            PG8_WAIT_V(8); PG8_WAIT_L(0); PG8_BAR; PG8_MMA(1, 0, At, B0); PG8_MMA(1, 1, At, B1); PG8_BAR; PG8_SCHED;
            PG8_LDB(B0, 1, 0); PG8_LDB(B1, 1, 1); PG8_SCHED; PG8_LDA(At, 1, 0); PG8_STAGE(PG8_SA(0, 1), a2 + hstep, voffA);
            PG8_WAIT_V(8); PG8_WAIT_L(0); PG8_BAR; PG8_MMA(0, 0, At, B0); PG8_MMA(0, 1, At, B1); PG8_BAR; PG8_SCHED;
            PG8_LDA(At, 1, 1); PG8_STAGE(PG8_SB(1, 0), b3, voffB); PG8_STAGE(PG8_SB(1, 1), b3 + hstep, voffB); PG8_STAGE(PG8_SA(1, 0), a3, voffA);
            PG8_WAIT_V(8); PG8_WAIT_L(0); PG8_BAR; PG8_MMA(1, 0, At, B0); PG8_MMA(1, 1, At, B1); PG8_BAR; PG8_SCHED;
            } else {
            PG8_LDB(B0, 0, 0); PG8_SCHED; PG8_LDA(At, 0, 0); PG8_STAGE(PG8_SA(1, 1), a1 + hstep, voffA);
            PG8_WAIT_L(8); PG8_BAR; PG8_WAIT_L(0); PG8_MMA(0, 0, At, B0); PG8_BAR; PG8_SCHED;
            PG8_LDB(B1, 0, 1); PG8_STAGE(PG8_SB(0, 0), b2, voffB);
            PG8_BAR; PG8_WAIT_L(0); PG8_MMA(0, 1, At, B1); PG8_BAR;
            PG8_LDA(At, 0, 1); PG8_STAGE(PG8_SA(0, 0), a2, voffA);
            PG8_BAR; PG8_WAIT_L(0); PG8_MMA(1, 0, At, B0); PG8_BAR; PG8_SCHED;
            PG8_STAGE(PG8_SB(0, 1), b2 + hstep, voffB);
            PG8_WAIT_V(6); PG8_BAR; PG8_MMA(1, 1, At, B1); PG8_BAR;
            PG8_LDB(B0, 1, 0); PG8_SCHED; PG8_LDA(At, 1, 0); PG8_STAGE(PG8_SA(0, 1), a2 + hstep, voffA);
            PG8_WAIT_L(8); PG8_BAR; PG8_WAIT_L(0); PG8_MMA(0, 0, At, B0); PG8_BAR; PG8_SCHED;
            PG8_LDB(B1, 1, 1); PG8_STAGE(PG8_SB(1, 0), b3, voffB);
            PG8_BAR; PG8_WAIT_L(0); PG8_MMA(0, 1, At, B1); PG8_BAR;
            PG8_LDA(At, 1, 1); PG8_STAGE(PG8_SA(1, 0), a3, voffA);
            PG8_BAR; PG8_WAIT_L(0); PG8_MMA(1, 0, At, B0); PG8_BAR; PG8_SCHED;
            PG8_STAGE(PG8_SB(1, 1), b3 + hstep, voffB);
            PG8_WAIT_V(6); PG8_BAR; PG8_MMA(1, 1, At, B1); PG8_BAR;
            }
        }
        if constexpr (ALIGN_EPI) { if (wr == 0) PG8_BAR; }
        if constexpr (!Epi::AFTER_DRAIN) { E(acc, cur, wr, wc, fr, fq); S.done(cur); }
        if (!has_next) break;
#pragma unroll
        for (int a = 0; a < 2; ++a)
#pragma unroll
            for (int b = 0; b < 2; ++b)
#pragma unroll
                for (int m = 0; m < 4; ++m)
#pragma unroll
                    for (int n = 0; n < 2; ++n) acc[a][b][m][n] = (f32x4){0.f, 0.f, 0.f, 0.f};
        cur = nxt; cA = nA; cB = nB; ++ui;
        if constexpr (ALIGN_EPI) { if (wr == 1) PG8_BAR; }
    }
    PG8_WAIT_V(0);
    if constexpr (!ALIGN_EPI) { if (wr == 0) PG8_BAR; }
    PG8_BAR;
    if constexpr (Epi::AFTER_DRAIN) { E.fused(acc, cur, wr, wc, fr, fq, lds, wid, lane); S.done(cur); }
#undef PG8_SA
#undef PG8_SB
#undef PG8_STAGE
#undef PG8_LDA
#undef PG8_LDB
#undef PG8_MMA
#undef PG8_WAIT_V
#undef PG8_WAIT_L
#undef PG8_BAR
#undef PG8_SCHED
}
}
constexpr int NWAVES = 8, NT = NWAVES * 64;
constexpr int BATCH = 4, SEQ = 2048, DM = 2048, M = BATCH * SEQ;
constexpr int LRU_W = 1024, LRU_BLK = 8, LRU_BD = 128;
constexpr int ATT_W = 1024, NH = 8, HD = 128, CL = 256, IH = 16, ID = 64, TOPK = 256;
constexpr int C_XA = 0, C_GA = 1024, C_Q = 2048, C_CKV = 3072, C_GB = 3328, C_QI = 4352, C_KI = 5376, C_WI = 5440, NIN = 5456, NINP = 5632;
constexpr float EPS = 1e-6f;
__constant__ unsigned char BUCKET[128] = {0, 1, 2, 3, 4, 5, 6, 7, 8, 9, 10, 11, 12, 13, 14, 15, 16, 16, 16, 17, 17, 18, 18, 18, 19, 19, 19, 20, 20, 20, 20, 21, 21, 21, 21, 22, 22, 22, 22, 22, 23, 23, 23, 23, 23, 23, 24, 24, 24, 24, 24, 24, 25, 25, 25, 25, 25, 25, 25, 26, 26, 26, 26, 26, 26, 26, 26, 27, 27, 27, 27, 27, 27, 27, 27, 27, 27, 28, 28, 28, 28, 28, 28, 28, 28, 28, 28, 29, 29, 29, 29, 29, 29, 29, 29, 29, 29, 29, 29, 30, 30, 30, 30, 30, 30, 30, 30, 30, 30, 30, 30, 30, 30, 31, 31, 31, 31, 31, 31, 31, 31, 31, 31, 31, 31, 31, 31, 31};

constexpr size_t MiB = 1u << 20;
constexpr size_t WS_CTL = 0, CTL_ZERO_BYTES = 1 * MiB;
constexpr size_t WS_WIN = 2 * MiB;
constexpr size_t WS_WOUT = 24 * MiB;
constexpr size_t WS_H = 32 * MiB;
constexpr size_t WS_PROJ = 64 * MiB;
constexpr size_t WS_A = 152 * MiB;
constexpr size_t WS_B = 184 * MiB;
constexpr size_t WS_QABS = 216 * MiB;
constexpr size_t WS_CN = 248 * MiB;
constexpr size_t WS_KN = 252 * MiB;
constexpr size_t WS_WUVT = 253 * MiB;
constexpr size_t WS_WUKT = WS_WUVT + 512 * 1024;
constexpr size_t WS_WAT = 254 * MiB;
constexpr size_t WS_WXT = WS_WAT + 256 * 1024;
constexpr size_t WS_AGG = WS_WXT + 256 * 1024;
constexpr size_t WS_END = 256 * MiB;
constexpr int CW_TMO = 0, CW_CODE = 1, CW_BAR = 4096;

constexpr int RING_OFF = 0, RING_BYTES = 131072;
constexpr int LDSCTL_OFF = RING_BYTES, MISC_OFF = LDSCTL_OFF + 320;
constexpr int LDS_BYTES = 163840;

#define GAS __attribute__((address_space(1)))
#define LAS __attribute__((address_space(3)))
typedef unsigned short f16s;
typedef _Float16 f16;
typedef _Float16 h4 __attribute__((ext_vector_type(4)));
typedef _Float16 h8 __attribute__((ext_vector_type(8)));
typedef unsigned v4u __attribute__((ext_vector_type(4)));
typedef unsigned v2u __attribute__((ext_vector_type(2)));
typedef float f32x4 __attribute__((ext_vector_type(4)));
typedef float f32x2 __attribute__((ext_vector_type(2)));
typedef GAS unsigned gu32;
#define RLX_AGENT __ATOMIC_RELAXED, __HIP_MEMORY_SCOPE_AGENT
#define LDS_WAIT() asm volatile("s_waitcnt lgkmcnt(0)" ::: "memory")
#define VM_WAIT() asm volatile("s_waitcnt vmcnt(0)" ::: "memory")
__device__ __forceinline__ unsigned pkh(float lo, float hi) { return pg8::cvt_pk_f16(lo, hi); }
__device__ __forceinline__ float sigmoidf_(float x) { return 1.f / (1.f + __expf(-x)); }
__device__ __forceinline__ float siluf_(float x) { return x / (1.f + __expf(-x)); }
__device__ __forceinline__ float h2f(f16s v) { return (float)__builtin_bit_cast(f16, v); }

#define XB_TMO      128
#define XB_XCNT(j)  (256  + 64 * (j))
#define XB_XSUB(j)  (1280 + 64 * (j))
#define XB_XGEN(j)  (2304 + 64 * (j))
#define XB_TOP      3328
#define XB_TOPGEN   3392
#define XCD_BAR_WORDS 3456
#define XB_SPIN_CAP (1u << 18)

__device__ __forceinline__ unsigned xb_ld(unsigned* p)              { return __hip_atomic_load(p, __ATOMIC_RELAXED, __HIP_MEMORY_SCOPE_AGENT); }
__device__ __forceinline__ unsigned xb_add(unsigned* p, unsigned v) { return __hip_atomic_fetch_add(p, v, __ATOMIC_RELAXED, __HIP_MEMORY_SCOPE_AGENT); }
__device__ __forceinline__ unsigned xb_xcc_id() { return (unsigned)__builtin_amdgcn_s_getreg((3 << 11) | 20) & 0xFu; }
#define XB_SPIN(cond, bar) do { unsigned _sp = 0; while (cond) { __builtin_amdgcn_s_sleep(1); \
    if ((++_sp & 255u) == 0u) { if (xb_ld(&(bar)[XB_TMO])) break; if (_sp > XB_SPIN_CAP) { atomicAdd(&(bar)[XB_TMO], 1u); break; } } } } while (0)

struct XcdBarrier {
    unsigned* bar; unsigned x;
    volatile LAS unsigned* st;
};

__device__ __forceinline__ XcdBarrier xcd_barrier_post(unsigned* bar, volatile LAS unsigned* st) {
    XcdBarrier b; b.bar = bar; b.x = xb_xcc_id(); b.st = st;
    if (threadIdx.x == 0) (void)xb_add(&bar[XB_XCNT(b.x)], 1u);
    return b;
}
__device__ __forceinline__ void xcd_barrier_complete(unsigned* bar, unsigned x, unsigned& nloc, unsigned& nx) {
    const unsigned G = gridDim.x * gridDim.y * gridDim.z;
    unsigned sum, cnt, mine, sp = 0u;
    for (;;) {
        sum = 0u; cnt = 0u; mine = 0u;
#pragma unroll
        for (unsigned j = 0; j < 16; ++j) { const unsigned c = xb_ld(&bar[XB_XCNT(j)]); sum += c; cnt += (c > 0u) ? 1u : 0u; mine = (j == x) ? c : mine; }
        if (sum == G) break;
        __builtin_amdgcn_s_sleep(1);
        if ((++sp & 255u) == 0u) { if (xb_ld(&bar[XB_TMO])) break; if (sp > XB_SPIN_CAP) { atomicAdd(&bar[XB_TMO], 1u); break; } }
    }
    nloc = mine > 0u ? mine : 1u; nx = cnt > 0u ? cnt : 1u;
}

__device__ __forceinline__ void xcd_barrier(const XcdBarrier& b) {
    asm volatile("s_waitcnt vmcnt(0)" ::: "memory");
    __syncthreads();
    if (threadIdx.x == 0) {
        unsigned* bar = b.bar;
        __builtin_amdgcn_s_waitcnt(0);
        unsigned nloc = b.st[0], nx = b.st[1];
        if (nloc == 0u) { xcd_barrier_complete(bar, b.x, nloc, nx); b.st[0] = nloc; b.st[1] = nx; }
        const unsigned old = xb_add(&bar[XB_XSUB(b.x)], 1u);
        const unsigned gen = old / nloc;
        if (old + 1u == (gen + 1u) * nloc) {
            __builtin_amdgcn_fence(__ATOMIC_RELEASE, "agent");
            asm volatile("s_waitcnt vmcnt(0)" ::: "memory");
            const unsigned og = xb_add(&bar[XB_TOP], 1u);
            const unsigned tg = og / nx;
            if (og + 1u == (tg + 1u) * nx) xb_add(&bar[XB_TOPGEN], 1u);
            else XB_SPIN(xb_ld(&bar[XB_TOPGEN]) == tg, bar);
            __builtin_amdgcn_fence(__ATOMIC_ACQUIRE, "agent");
            xb_add(&bar[XB_XGEN(b.x)], 1u);
            asm volatile("s_waitcnt vmcnt(0)" ::: "memory");
        } else {
            XB_SPIN(xb_ld(&bar[XB_XGEN(b.x)]) == gen, bar);
            __builtin_amdgcn_fence(__ATOMIC_ACQUIRE, "agent");
            asm volatile("s_waitcnt vmcnt(0)" ::: "memory");
        }
    }
    __syncthreads();
}
struct Params {
    const float *x, *norm_g, *w_in, *conv_w, *conv_b, *wa, *ba, *wx, *bx, *lam, *ckv_g, *ikg, *ikb, *w_uk, *w_uv, *w_out, *rel_bias, *fin_g;
    float* out; unsigned char* ws;
};
struct Frame {
    LAS unsigned char* lds;
    volatile LAS unsigned* MISC;
    gu32* ctl;
    int tid, lane, wave, vcu, G;
};
__device__ __forceinline__ float wave_sum(float v) {
#pragma unroll
    for (int o = 1; o < 64; o <<= 1) v += __shfl_xor(v, o);
    return v;
}
__device__ __forceinline__ int wave_sum_i(int v) {
#pragma unroll
    for (int o = 1; o < 64; o <<= 1) v += __shfl_xor(v, o);
    return v;
}
__device__ __forceinline__ float wave_max(float v) {
#pragma unroll
    for (int o = 1; o < 64; o <<= 1) v = fmaxf(v, __shfl_xor(v, o));
    return v;
}

__device__ __forceinline__ void p0_transpose_item(const float* W, int K, int N, int nblk, f16s* WT, LAS float* scr, int item, int lane) {
    const int kb = item / nblk, nb = item % nblk, k0 = 64 * kb, n0 = 32 * nb;
    const bool nok = (n0 + (lane & 31)) < N;
#pragma unroll 8
    for (int i = 0; i < 32; ++i) { const int kk = 2 * i + (lane >> 5); scr[kk * 33 + (lane & 31)] = nok ? W[(size_t)(k0 + kk) * N + n0 + (lane & 31)] : 0.f; }
    LDS_WAIT(); asm volatile("" ::: "memory");
    const int c = lane & 7;
#pragma unroll
    for (int j = 0; j < 4; ++j) { const int n = (lane >> 3) + 8 * j; const LAS float* s = scr + (8 * c) * 33 + n;
        v4u o; o.x = pkh(s[0 * 33], s[1 * 33]); o.y = pkh(s[2 * 33], s[3 * 33]); o.z = pkh(s[4 * 33], s[5 * 33]); o.w = pkh(s[6 * 33], s[7 * 33]);
        *(GAS v4u*)(WT + (size_t)(n0 + n) * K + k0 + 8 * c) = o; }
    LDS_WAIT(); asm volatile("" ::: "memory");
}
__device__ __forceinline__ void rms_row_to_f16(const float* xrow, const float* g, f16s* orow, int lane) {
    const GAS f32x4* xr = (const GAS f32x4*)xrow + lane; const GAS f32x4* gr = (const GAS f32x4*)g + lane;
    f32x4 v[8]; float s = 0.f;
#pragma unroll
    for (int j = 0; j < 8; ++j) { v[j] = xr[64 * j]; s += (v[j].x * v[j].x + v[j].y * v[j].y) + (v[j].z * v[j].z + v[j].w * v[j].w); }
    const float r = rsqrtf(wave_sum(s) * (1.f / DM) + EPS);
    GAS v2u* o8 = (GAS v2u*)orow + lane;
#pragma unroll
    for (int j = 0; j < 8; ++j) { const f32x4 gg = gr[64 * j]; v2u o; o.x = pkh(v[j].x * r * gg.x, v[j].y * r * gg.y); o.y = pkh(v[j].z * r * gg.z, v[j].w * r * gg.w); o8[64 * j] = o; }
}
__device__ __forceinline__ void p0_prologue(Frame& F, const Params& P) {
    LAS float* scr = (LAS float*)(F.lds + RING_OFF + F.wave * 16384);
    const int gw = F.vcu * NWAVES + F.wave, NGW = F.G * NWAVES;
    constexpr int NB_IN = NINP / 32, I_IN = (DM / 64) * NB_IN, NB_OUT = DM / 32, I_OUT = (DM / 64) * NB_OUT;
    f16s* WinT = (f16s*)(P.ws + WS_WIN); f16s* WoutT = (f16s*)(P.ws + WS_WOUT); f16s* Hn = (f16s*)(P.ws + WS_H);
    for (int it = gw; it < I_IN + I_OUT; it += NGW) {
        if (it < I_IN) p0_transpose_item(P.w_in, DM, NIN, NB_IN, WinT, scr, it, F.lane);
        else p0_transpose_item(P.w_out, DM, DM, NB_OUT, WoutT, scr, it - I_IN, F.lane);
    }
    for (int it = gw; it < NH * 16; it += NGW) { const int h = it >> 4; p0_transpose_item(P.w_uv + (size_t)h * CL * HD, CL, HD, HD / 32, (f16s*)(P.ws + WS_WUVT) + (size_t)h * HD * CL, scr, it & 15, F.lane); }
    for (int it = gw; it < NH * 16; it += NGW) { const int h = it >> 4; p0_transpose_item(P.w_uk + (size_t)h * HD * CL, HD, CL, CL / 32, (f16s*)(P.ws + WS_WUKT) + (size_t)h * CL * HD, scr, it & 15, F.lane); }
    for (int it = gw; it < LRU_BLK * 16; it += NGW) { const int g = it >> 4, w = (it >> 3) & 1;
        p0_transpose_item((w ? P.wx : P.wa) + (size_t)g * LRU_BD * LRU_BD, LRU_BD, LRU_BD, LRU_BD / 32, (f16s*)(P.ws + (w ? WS_WXT : WS_WAT)) + (size_t)g * LRU_BD * LRU_BD, scr, it & 7, F.lane); }
    for (int m = gw; m < M; m += NGW) rms_row_to_f16(P.x + (size_t)m * DM, P.norm_g, Hn + (size_t)m * DM, F.lane);
}

__device__ __forceinline__ void p2_gates_naive(Frame& F, const Params& P) {
    const f16s* proj = (const f16s*)(P.ws + WS_PROJ); float* abuf = (float*)(P.ws + WS_A); float* bbuf = (float*)(P.ws + WS_B);
    LAS float* xs = (LAS float*)(F.lds + RING_OFF);
    const int tid = F.tid;
    for (int it = F.vcu; it < (M / 16) * LRU_BLK; it += F.G) {
        const int rt = it >> 3, g = it & 7, r0 = rt * 16;
#pragma unroll
        for (int i = 0; i < 4; ++i) { const int e = tid + NT * i, r = e >> 7, c = e & 127, row = r0 + r, t = row & (SEQ - 1), ch = g * 128 + c;
            float v = P.conv_b[ch];
#pragma unroll
            for (int j = 0; j < 4; ++j) { const int tt = t - 3 + j; if (tt >= 0) v += h2f(proj[(size_t)(row - 3 + j) * NINP + C_XA + ch]) * P.conv_w[j * LRU_W + ch]; }
            xs[r * 128 + c] = v; }
        __syncthreads();
        const int j = tid & 127, rh = tid >> 7;
        float ar[4] = {0.f, 0.f, 0.f, 0.f}, ai[4] = {0.f, 0.f, 0.f, 0.f};
        const float* wag = P.wa + (size_t)g * 128 * 128; const float* wxg = P.wx + (size_t)g * 128 * 128;
        for (int i = 0; i < 128; ++i) { const float w1 = wag[i * 128 + j], w2 = wxg[i * 128 + j];
#pragma unroll
            for (int r = 0; r < 4; ++r) { const float xv = xs[(rh * 4 + r) * 128 + i]; ar[r] += xv * w1; ai[r] += xv * w2; } }
        const int ch = g * 128 + j; const float sp = log1pf(expf(-P.lam[ch])), bav = P.ba[ch], bxv = P.bx[ch];
#pragma unroll
        for (int r = 0; r < 4; ++r) { const int row = r0 + rh * 4 + r, t = row & (SEQ - 1);
            const float rg = sigmoidf_(ar[r] + bav), ig = sigmoidf_(ai[r] + bxv), la = -8.f * rg * sp, a = expf(la);
            float mult = sqrtf(-expm1f(2.f * la)); if (t == 0) mult = 1.f;
            abuf[(size_t)row * LRU_W + ch] = a; bbuf[(size_t)row * LRU_W + ch] = mult * (ig * xs[(rh * 4 + r) * 128 + j]); }
        __syncthreads();
    }
}
__device__ __forceinline__ void p2_qabs_naive(Frame& F, const Params& P) {
    const f16s* proj = (const f16s*)(P.ws + WS_PROJ); f16s* qabs = (f16s*)(P.ws + WS_QABS);
    LAS float* qs = (LAS float*)(F.lds + RING_OFF);
    const int tid = F.tid;
    for (int it = F.vcu; it < (M / 16) * NH; it += F.G) {
        const int rt = it >> 3, h = it & 7, r0 = rt * 16;
#pragma unroll
        for (int i = 0; i < 4; ++i) { const int e = tid + NT * i, r = e >> 7, c = e & 127; qs[r * 128 + c] = h2f(proj[(size_t)(r0 + r) * NINP + C_Q + h * HD + c]); }
        __syncthreads();
        const int c = tid & 255, rh = tid >> 8;
        float acc[8];
#pragma unroll
        for (int r = 0; r < 8; ++r) acc[r] = 0.f;
        const float* wk = P.w_uk + (size_t)h * HD * CL + c;
        for (int d = 0; d < HD; ++d) { const float w = wk[(size_t)d * CL];
#pragma unroll
            for (int r = 0; r < 8; ++r) acc[r] += qs[(rh * 8 + r) * 128 + d] * w; }
#pragma unroll
        for (int r = 0; r < 8; ++r) qabs[(size_t)(r0 + rh * 8 + r) * (NH * CL) + h * CL + c] = __builtin_bit_cast(f16s, (f16)acc[r]);
        __syncthreads();
    }
}
__device__ __forceinline__ void p2_qabs_mfma(Frame& F, const Params& P) {
    const f16s* proj = (const f16s*)(P.ws + WS_PROJ); f16s* qabs = (f16s*)(P.ws + WS_QABS);
    int lane = F.lane; asm volatile("" : "+v"(lane));
    const int q = lane >> 4, fr = lane & 15, gw = F.vcu * NWAVES + F.wave, NGW = F.G * NWAVES, role = gw & 15, h = role >> 1, nh = role & 1;
    h8 W[8][4];
    { const f16s* wp = (const f16s*)(P.ws + WS_WUKT) + ((size_t)h * CL + nh * 128 + fr) * HD + 8 * q;
#pragma unroll
      for (int nt = 0; nt < 8; ++nt)
#pragma unroll
          for (int ks = 0; ks < 4; ++ks) W[nt][ks] = *(const GAS h8*)(wp + (size_t)nt * 16 * HD + 32 * ks); }
    const f32x4 zero4 = {0.f, 0.f, 0.f, 0.f};
    for (int rt = gw >> 4; rt < M / 16; rt += NGW >> 4) {
        const int row = rt * 16 + fr;
        h8 B[4];
        { const f16s* qp = proj + (size_t)row * NINP + C_Q + h * HD + 8 * q;
#pragma unroll
          for (int ks = 0; ks < 4; ++ks) B[ks] = *(const GAS h8*)(qp + 32 * ks); }
        f16s* op = qabs + (size_t)row * (NH * CL) + h * CL + nh * 128 + 4 * q;
#pragma unroll
        for (int nt = 0; nt < 8; ++nt) { f32x4 acc = zero4;
#pragma unroll
            for (int ks = 0; ks < 4; ++ks) acc = __builtin_amdgcn_mfma_f32_16x16x32_f16(W[nt][ks], B[ks], acc, 0, 0, 0);
            v2u o; o.x = pkh(acc[0], acc[1]); o.y = pkh(acc[2], acc[3]); *(GAS v2u*)(op + 16 * nt) = o; }
    }
}
__device__ __forceinline__ void p2_gates_mfma(Frame& F, const Params& P) {
    const f16s* proj = (const f16s*)(P.ws + WS_PROJ); float* abuf = (float*)(P.ws + WS_A); float* bbuf = (float*)(P.ws + WS_B);
    LAS float* CW = (LAS float*)(F.lds + RING_OFF);
    LAS float* CB = CW + 4 * LRU_W; LAS float* NSP = CB + LRU_W; LAS float* BA = NSP + LRU_W; LAS float* BX = BA + LRU_W;
    for (int e = F.tid; e < 4 * LRU_W; e += NT) CW[e] = P.conv_w[e];
    for (int e = F.tid; e < LRU_W; e += NT) { CB[e] = P.conv_b[e]; NSP[e] = -8.f * log1pf(expf(-P.lam[e])); BA[e] = P.ba[e]; BX[e] = P.bx[e]; }
    __syncthreads();
    int lane = F.lane; asm volatile("" : "+v"(lane));
    const int q = lane >> 4, fr = lane & 15, gw = F.vcu * NWAVES + F.wave, NGW = F.G * NWAVES, role = gw & 31, g = role >> 2, nq = role & 3;
    h8 WA[2][4], WX[2][4];
    { const size_t wo = ((size_t)g * LRU_BD + nq * 32 + fr) * LRU_BD + 8 * q; const f16s* wap = (const f16s*)(P.ws + WS_WAT) + wo; const f16s* wxp = (const f16s*)(P.ws + WS_WXT) + wo;
#pragma unroll
      for (int nt = 0; nt < 2; ++nt)
#pragma unroll
          for (int ks = 0; ks < 4; ++ks) { WA[nt][ks] = *(const GAS h8*)(wap + (size_t)nt * 16 * LRU_BD + 32 * ks); WX[nt][ks] = *(const GAS h8*)(wxp + (size_t)nt * 16 * LRU_BD + 32 * ks); } }
    const f32x4 zero4 = {0.f, 0.f, 0.f, 0.f};
    for (int rt = gw >> 5; rt < M / 16; rt += NGW >> 5) {
        const int row = rt * 16 + fr, t = row & (SEQ - 1);
        h8 XB[4];
#pragma unroll
        for (int ks = 0; ks < 4; ++ks) { const int c0 = g * 128 + 32 * ks + 8 * q;
            float v[8];
            { const f32x4 b0 = *(const LAS f32x4*)(CB + c0), b1 = *(const LAS f32x4*)(CB + c0 + 4); v[0] = b0[0]; v[1] = b0[1]; v[2] = b0[2]; v[3] = b0[3]; v[4] = b1[0]; v[5] = b1[1]; v[6] = b1[2]; v[7] = b1[3]; }
#pragma unroll
            for (int j = 0; j < 4; ++j) { if (t - 3 + j >= 0) { const h8 xv = *(const GAS h8*)(proj + (size_t)(row - 3 + j) * NINP + C_XA + c0);
                    const f32x4 w0 = *(const LAS f32x4*)(CW + j * LRU_W + c0), w1 = *(const LAS f32x4*)(CW + j * LRU_W + c0 + 4);
#pragma unroll
                    for (int e = 0; e < 4; ++e) { v[e] += (float)xv[e] * w0[e]; v[4 + e] += (float)xv[4 + e] * w1[e]; } } }
#pragma unroll
            for (int e = 0; e < 8; ++e) XB[ks][e] = (f16)v[e];
            asm volatile("" : "+v"(XB[ks])); }
#pragma unroll
        for (int nt = 0; nt < 2; ++nt) { f32x4 ar = zero4, ai = zero4;
#pragma unroll
            for (int ks = 0; ks < 4; ++ks) { ar = __builtin_amdgcn_mfma_f32_16x16x32_f16(WA[nt][ks], XB[ks], ar, 0, 0, 0); ai = __builtin_amdgcn_mfma_f32_16x16x32_f16(WX[nt][ks], XB[ks], ai, 0, 0, 0); }
            const int ch = g * 128 + nq * 32 + 16 * nt + 4 * q;
            f32x4 xc = *(const LAS f32x4*)(CB + ch);
#pragma unroll
            for (int j = 0; j < 4; ++j) { if (t - 3 + j >= 0) { const h4 xv = *(const GAS h4*)(proj + (size_t)(row - 3 + j) * NINP + C_XA + ch); const f32x4 w0 = *(const LAS f32x4*)(CW + j * LRU_W + ch);
#pragma unroll
                    for (int e = 0; e < 4; ++e) xc[e] += (float)xv[e] * w0[e]; } }
            const f32x4 nsp = *(const LAS f32x4*)(NSP + ch), bav = *(const LAS f32x4*)(BA + ch), bxv = *(const LAS f32x4*)(BX + ch);
            f32x4 av, bv;
#pragma unroll
            for (int e = 0; e < 4; ++e) { const float rg = sigmoidf_(ar[e] + bav[e]), ig = sigmoidf_(ai[e] + bxv[e]), a = __expf(rg * nsp[e]);
                float mult = sqrtf(fmaxf(1.f - a * a, 0.f)); if (t == 0) mult = 1.f;
                av[e] = a; bv[e] = mult * (ig * xc[e]); }
            *(GAS f32x4*)(abuf + (size_t)row * LRU_W + ch) = av; *(GAS f32x4*)(bbuf + (size_t)row * LRU_W + ch) = bv; }
    }
    __syncthreads();
}
__device__ __forceinline__ void p2_norms(Frame& F, const Params& P) {
    const f16s* proj = (const f16s*)(P.ws + WS_PROJ); f16s* cn = (f16s*)(P.ws + WS_CN); f16s* kn = (f16s*)(P.ws + WS_KN);
    const int gw = F.vcu * NWAVES + F.wave, NGW = F.G * NWAVES, lane = F.lane;
    for (int row = gw; row < M; row += NGW) {
        const h4 cv = *(const GAS h4*)(proj + (size_t)row * NINP + C_CKV + 4 * lane);
        const float c0 = (float)cv[0], c1 = (float)cv[1], c2 = (float)cv[2], c3 = (float)cv[3];
        const float r = rsqrtf(wave_sum(c0 * c0 + c1 * c1 + c2 * c2 + c3 * c3) * (1.f / CL) + EPS);
        const f32x4 g = *(const GAS f32x4*)(P.ckv_g + 4 * lane);
        v2u o; o.x = pkh(c0 * r * g.x, c1 * r * g.y); o.y = pkh(c2 * r * g.z, c3 * r * g.w);
        *(GAS v2u*)(cn + (size_t)row * CL + 4 * lane) = o;
        const float kv = h2f(proj[(size_t)row * NINP + C_KI + lane]);
        const float mu = wave_sum(kv) * (1.f / ID), d = kv - mu, var = wave_sum(d * d) * (1.f / ID);
        kn[(size_t)row * ID + lane] = __builtin_bit_cast(f16s, (f16)(d * rsqrtf(var + EPS) * P.ikg[lane] + P.ikb[lane]));
    }
}

__device__ __forceinline__ void p3_scanA(Frame& F, const Params& P) {
    const float* abuf = (const float*)(P.ws + WS_A); const float* bbuf = (const float*)(P.ws + WS_B); float* agg = (float*)(P.ws + WS_AGG);
    const int gw = F.vcu * NWAVES + F.wave, NGW = F.G * NWAVES;
    for (int it = gw; it < BATCH * 16 * 32; it += NGW) {
        const int b = it >> 9, cg = (it >> 5) & 15, ck = it & 31, ch = cg * 64 + F.lane; const size_t r0 = (size_t)b * SEQ + ck * 64;
        float A = 1.f, H = 0.f;
#pragma unroll 16
        for (int s = 0; s < 64; ++s) { const float a = abuf[(r0 + s) * LRU_W + ch], bb = bbuf[(r0 + s) * LRU_W + ch]; H = a * H + bb; A *= a; }
        agg[((size_t)(b * 32 + ck) * 2 + 0) * LRU_W + ch] = A; agg[((size_t)(b * 32 + ck) * 2 + 1) * LRU_W + ch] = H;
    }
}
__device__ __forceinline__ void p3_scanB(Frame& F, const Params& P) {
    const float* abuf = (const float*)(P.ws + WS_A); const float* bbuf = (const float*)(P.ws + WS_B); const float* agg = (const float*)(P.ws + WS_AGG);
    const f16s* proj = (const f16s*)(P.ws + WS_PROJ); f16s* y = (f16s*)(P.ws + WS_H);
    const int gw = F.vcu * NWAVES + F.wave, NGW = F.G * NWAVES;
    for (int it = gw; it < BATCH * 16 * 32; it += NGW) {
        const int b = it >> 9, cg = (it >> 5) & 15, ck = it & 31, ch = cg * 64 + F.lane; const size_t r0 = (size_t)b * SEQ + ck * 64;
        float h = 0.f;
        for (int k = 0; k < ck; ++k) h = agg[((size_t)(b * 32 + k) * 2 + 0) * LRU_W + ch] * h + agg[((size_t)(b * 32 + k) * 2 + 1) * LRU_W + ch];
#pragma unroll 16
        for (int s = 0; s < 64; ++s) { h = abuf[(r0 + s) * LRU_W + ch] * h + bbuf[(r0 + s) * LRU_W + ch];
            y[(r0 + s) * DM + ch] = __builtin_bit_cast(f16s, (f16)(h * siluf_(h2f(proj[(r0 + s) * NINP + C_GA + ch])))); }
    }
}
constexpr int AF_OFF = 0;
constexpr int TAB_OFF = RING_BYTES + 1024;
constexpr int IL_OFF = TAB_OFF;
constexpr int SGT_OFF = IL_OFF + 8192;
constexpr int CNT_OFF = SGT_OFF + 1024;
constexpr int WCNT_OFF = CNT_OFF + 128;
constexpr int CNTQ_OFF = WCNT_OFF + 256;
constexpr int BIAS_OFF = CNTQ_OFF + 64;
constexpr int TAB_END = BIAS_OFF + 4224;
static_assert(TAB_END <= LDS_BYTES, "LDS map");
typedef short v4i16 __attribute__((ext_vector_type(4)));
typedef _Float16 h4v __attribute__((ext_vector_type(4)));

__device__ __forceinline__ unsigned fkey(float f) { const unsigned u = __float_as_uint(f); return (u & 0x80000000u) ? ~u : (u | 0x80000000u); }
__device__ __forceinline__ unsigned rowsum16(unsigned v) { v += __shfl_xor(v, 1); v += __shfl_xor(v, 2); v += __shfl_xor(v, 4); v += __shfl_xor(v, 8); return v; }

__device__ __forceinline__ void p3_d1(Frame& F, const Params& P, int b, int i) {
    const f16s* proj = (const f16s*)(P.ws + WS_PROJ); const f16s* kn = (const f16s*)(P.ws + WS_KN);
    int tid = F.tid; asm volatile("" : "+v"(tid));
    const int lane = tid & 63, wave = F.wave, q = lane >> 4, fr = lane & 15;
    const int row0 = b * SEQ + 16 * i, ntile = i + 1;
    LAS unsigned char* AF = F.lds + AF_OFF;
    LAS float* SGT = (LAS float*)(F.lds + SGT_OFF);
    LAS unsigned* CNT = (LAS unsigned*)(F.lds + CNT_OFF);
    LAS unsigned* WCNT = (LAS unsigned*)(F.lds + WCNT_OFF);
    LAS unsigned* CNTQ = (LAS unsigned*)(F.lds + CNTQ_OFF);
    LAS unsigned short* IL = (LAS unsigned short*)(F.lds + IL_OFF);
#pragma unroll
    for (int e = 0; e < 4; ++e) { const int f = tid + NT * e, h = f >> 7, ks = (f >> 6) & 1, ln = f & 63, r = ln & 15, kq = ln >> 4;
        const f16s* rowp = proj + (size_t)(row0 + r) * NINP;
        const h8 v = *(const GAS h8*)(rowp + C_QI + h * 64 + 32 * ks + 8 * kq); const float w = fabsf(h2f(rowp[C_WI + h]));
        h8 o;
#pragma unroll
        for (int j = 0; j < 8; ++j) o[j] = (f16)((float)v[j] * w);
        *(LAS h8*)(AF + (h * 2 + ks) * 1024 + ln * 16) = o; }
    if (tid < 128) { const int ks = tid >> 6, ln = tid & 63, r = ln & 15, kq = ln >> 4; const f16s* rowp = proj + (size_t)(row0 + r) * NINP;
        float acc[8];
#pragma unroll
        for (int j = 0; j < 8; ++j) acc[j] = 0.f;
        for (int h = 0; h < IH; ++h) { const h8 v = *(const GAS h8*)(rowp + C_QI + h * 64 + 32 * ks + 8 * kq); const float w = h2f(rowp[C_WI + h]);
#pragma unroll
            for (int j = 0; j < 8; ++j) acc[j] += (float)v[j] * w; }
        h8 o;
#pragma unroll
        for (int j = 0; j < 8; ++j) o[j] = (f16)acc[j];
        *(LAS h8*)(AF + (32 + ks) * 1024 + ln * 16) = o; }
    if (tid < 256) { const int r = tid >> 4, h = tid & 15; SGT[h * 16 + r] = h2f(proj[(size_t)(row0 + r) * NINP + C_WI + h]) >= 0.f ? 1.f : -1.f; }
    if (tid < 24) CNT[tid] = 0u;
    __syncthreads();
    unsigned key[16][4];
    const f32x4 zero4 = {0.f, 0.f, 0.f, 0.f};
#pragma unroll
    for (int p = 0; p < 4; ++p) {
        f32x4 sc[4] = {zero4, zero4, zero4, zero4};
        if (wave + 32 * p < ntile) {
            h8 bk[4][2];
#pragma unroll
            for (int jj = 0; jj < 4; ++jj) { int kt = wave + 8 * (4 * p + jj); kt = kt < ntile ? kt : ntile - 1;
                const f16s* kr = kn + ((size_t)b * SEQ + 16 * kt + fr) * ID + 8 * q; bk[jj][0] = *(const GAS h8*)kr; bk[jj][1] = *(const GAS h8*)(kr + 32); }
            h8 a0 = *(const LAS h8*)(AF + lane * 16), a1 = *(const LAS h8*)(AF + 1024 + lane * 16);
            f32x4 sg = *(const LAS f32x4*)(SGT + 4 * q);
#pragma unroll
            for (int h = 0; h <= IH; ++h) {
                h8 n0 = a0, n1 = a1; f32x4 ng = sg;
                if (h < IH) { n0 = *(const LAS h8*)(AF + (2 * h + 2) * 1024 + lane * 16); n1 = *(const LAS h8*)(AF + (2 * h + 3) * 1024 + lane * 16); if (h + 1 < IH) ng = *(const LAS f32x4*)(SGT + (h + 1) * 16 + 4 * q); }
#pragma unroll
                for (int jj = 0; jj < 4; ++jj) { f32x4 S = __builtin_amdgcn_mfma_f32_16x16x32_f16(a0, bk[jj][0], zero4, 0, 0, 0); S = __builtin_amdgcn_mfma_f32_16x16x32_f16(a1, bk[jj][1], S, 0, 0, 0);
                    if (h < IH) {
#pragma unroll
                        for (int e = 0; e < 4; ++e) sc[jj][e] = __builtin_fmaf(__builtin_fabsf(S[e]), sg[e], sc[jj][e]);
                    } else sc[jj] += S; }
                asm volatile("" : "+v"(sc[0]), "+v"(sc[1]), "+v"(sc[2]), "+v"(sc[3]));
                __builtin_amdgcn_sched_barrier(0);
                a0 = n0; a1 = n1; sg = ng;
            }
            __builtin_amdgcn_sched_barrier(0);
        }
#pragma unroll
        for (int jj = 0; jj < 4; ++jj) { const int kt = wave + 8 * (4 * p + jj);
#pragma unroll
            for (int e = 0; e < 4; ++e) { const bool valid = (kt < i) || (kt == i && fr <= 4 * q + e); key[4 * p + jj][e] = valid ? fkey(sc[jj][e]) : 0u; } }
        __builtin_amdgcn_sched_barrier(0);
    }
    unsigned lo[4], hi[4], thr[4]; bool dn[4];
#pragma unroll
    for (int e = 0; e < 4; ++e) { dn[e] = (16 * i + 4 * q + e + 1) <= TOPK; thr[e] = 1u; lo[e] = 0u; hi[e] = 0xFFFFFFFFu; }
    for (int it = 0; it < 40; ++it) {
        if (__all(dn[0] && dn[1] && dn[2] && dn[3])) break;
        unsigned mid[4];
#pragma unroll
        for (int e = 0; e < 4; ++e) { const unsigned d = hi[e] - lo[e]; mid[e] = lo[e] + (d >> 1) + (d & 1u); }
        unsigned c01 = 0u, c23 = 0u;
#pragma unroll
        for (int j = 0; j < 16; ++j) { c01 += (key[j][0] >= mid[0] ? 1u : 0u) + (key[j][1] >= mid[1] ? 0x10000u : 0u); c23 += (key[j][2] >= mid[2] ? 1u : 0u) + (key[j][3] >= mid[3] ? 0x10000u : 0u); }
        c01 = rowsum16(c01); c23 = rowsum16(c23);
        LAS unsigned* C = CNT + (it % 3) * 8;
        if (fr == 0) { __hip_atomic_fetch_add(&C[2 * q], c01, __ATOMIC_RELAXED, __HIP_MEMORY_SCOPE_WORKGROUP); __hip_atomic_fetch_add(&C[2 * q + 1], c23, __ATOMIC_RELAXED, __HIP_MEMORY_SCOPE_WORKGROUP); }
        if (tid < 8) CNT[((it + 1) % 3) * 8 + tid] = 0u;
        __syncthreads();
        const unsigned cc01 = C[2 * q], cc23 = C[2 * q + 1];
        const unsigned cnt[4] = {cc01 & 0xFFFFu, cc01 >> 16, cc23 & 0xFFFFu, cc23 >> 16};
#pragma unroll
        for (int e = 0; e < 4; ++e) if (!dn[e]) {
            if (cnt[e] == (unsigned)TOPK) { thr[e] = mid[e]; dn[e] = true; }
            else { if (cnt[e] > (unsigned)TOPK) lo[e] = mid[e]; else hi[e] = mid[e] - 1u; if (lo[e] == hi[e]) { thr[e] = lo[e]; dn[e] = true; } } }
    }
    {
        unsigned c01 = 0u, c23 = 0u;
#pragma unroll
        for (int j = 0; j < 16; ++j) { c01 += (key[j][0] >= thr[0] ? 1u : 0u) + (key[j][1] >= thr[1] ? 0x10000u : 0u); c23 += (key[j][2] >= thr[2] ? 1u : 0u) + (key[j][3] >= thr[3] ? 0x10000u : 0u); }
        c01 = rowsum16(c01); c23 = rowsum16(c23);
        if (fr == 0) { WCNT[wave * 8 + 2 * q] = c01; WCNT[wave * 8 + 2 * q + 1] = c23; }
        __syncthreads();
        unsigned b01 = 0u, b23 = 0u, t01 = 0u, t23 = 0u;
#pragma unroll
        for (int w = 0; w < NWAVES; ++w) { const unsigned x01 = WCNT[w * 8 + 2 * q], x23 = WCNT[w * 8 + 2 * q + 1]; t01 += x01; t23 += x23; if (w < wave) { b01 += x01; b23 += x23; } }
        unsigned base[4] = {b01 & 0xFFFFu, b01 >> 16, b23 & 0xFFFFu, b23 >> 16};
        if (wave == 0 && fr == 0) { const unsigned tot[4] = {t01 & 0xFFFFu, t01 >> 16, t23 & 0xFFFFu, t23 >> 16};
#pragma unroll
            for (int e = 0; e < 4; ++e) CNTQ[4 * q + e] = tot[e] < (unsigned)TOPK ? tot[e] : (unsigned)TOPK; }
        const unsigned ltmask = (1u << fr) - 1u;
#pragma unroll
        for (int j = 0; j < 16; ++j)
#pragma unroll
            for (int e = 0; e < 4; ++e) { const bool sel = key[j][e] >= thr[e];
                const unsigned long long m = __ballot(sel); const unsigned sub = (unsigned)(m >> (16 * q)) & 0xFFFFu;
                const unsigned pos = base[e] + __builtin_popcount(sub & ltmask);
                if (sel && pos < (unsigned)TOPK) IL[(4 * q + e) * TOPK + pos] = (unsigned short)(16 * (wave + 8 * j) + fr);
                base[e] += __builtin_popcount(sub); }
    }
    __syncthreads();
}

__device__ __forceinline__ void attn_query_naive(Frame& F, const Params& P, int row, const LAS unsigned short* il, int cnt) {
    const f16s* proj = (const f16s*)(P.ws + WS_PROJ); const f16s* cn = (const f16s*)(P.ws + WS_CN);
    const f16s* qabs = (const f16s*)(P.ws + WS_QABS); f16s* y = (f16s*)(P.ws + WS_H);
    LAS float* qa = (LAS float*)(F.lds + 40960);
    LAS float* lg = qa + 2048;
    LAS float* os = lg + 2048;
    int tid = F.tid; asm volatile("" : "+v"(tid));
    const int lane = tid & 63, wave = F.wave;
    const int b = row >> 11, t = row & (SEQ - 1);
#pragma unroll
    for (int k = 0; k < 4; ++k) qa[tid + NT * k] = h2f(qabs[(size_t)row * (NH * CL) + tid + NT * k]);
    __syncthreads();
    {   const int j = tid & 255, hh = tid >> 8, s = j < cnt ? (int)il[j] : -1;
        float l[4] = {0.f, 0.f, 0.f, 0.f};
        if (s >= 0) {
            const GAS h8* cr = (const GAS h8*)(cn + ((size_t)b * SEQ + s) * CL);
            for (int c8 = 0; c8 < CL / 8; ++c8) { const h8 v = cr[c8];
#pragma unroll
                for (int e = 0; e < 8; ++e) { const float cv = (float)v[e];
#pragma unroll
                    for (int h = 0; h < 4; ++h) l[h] += qa[(hh * 4 + h) * CL + c8 * 8 + e] * cv; } }
            const int dist = t - s, bk = dist < 128 ? (int)BUCKET[dist] : 31;
#pragma unroll
            for (int h = 0; h < 4; ++h) l[h] = l[h] * 0.08838834764831845f + P.rel_bias[bk * NH + hh * 4 + h];
        } else {
#pragma unroll
            for (int h = 0; h < 4; ++h) l[h] = -INFINITY;
        }
#pragma unroll
        for (int h = 0; h < 4; ++h) lg[(hh * 4 + h) * TOPK + j] = l[h];
    }
    __syncthreads();
    {   float v[4], mx = -INFINITY;
#pragma unroll
        for (int k = 0; k < 4; ++k) { v[k] = lg[wave * TOPK + lane + 64 * k]; mx = fmaxf(mx, v[k]); }
        mx = wave_max(mx);
        float sm = 0.f;
#pragma unroll
        for (int k = 0; k < 4; ++k) { v[k] = expf(v[k] - mx); sm += v[k]; }
        const float inv = 1.f / wave_sum(sm);
#pragma unroll
        for (int k = 0; k < 4; ++k) lg[wave * TOPK + lane + 64 * k] = v[k] * inv;
    }
    __syncthreads();
    {   const int c = tid & 255, hh = tid >> 8;
        float o[4] = {0.f, 0.f, 0.f, 0.f};
        for (int j = 0; j < cnt; ++j) { const int s = il[j];
            const float cv = h2f(cn[((size_t)b * SEQ + s) * CL + c]);
#pragma unroll
            for (int h = 0; h < 4; ++h) o[h] += lg[(hh * 4 + h) * TOPK + j] * cv; }
#pragma unroll
        for (int h = 0; h < 4; ++h) os[(hh * 4 + h) * CL + c] = o[h];
    }
    __syncthreads();
#pragma unroll
    for (int k = 0; k < 2; ++k) { const int h = k * 4 + (tid >> 7), d = tid & 127;
        const float* wv = P.w_uv + (size_t)h * CL * HD + d; float acc = 0.f;
        for (int c = 0; c < CL; ++c) acc += os[h * CL + c] * wv[(size_t)c * HD];
        const float gb = h2f(proj[(size_t)row * NINP + C_GB + h * HD + d]);
        y[(size_t)row * DM + LRU_W + h * HD + d] = __builtin_bit_cast(f16s, (f16)(acc * siluf_(gb))); }
    __syncthreads();
}


__device__ __forceinline__ void p3_d2_query(const Params& P, LAS unsigned char* lds, LAS unsigned char* buf, int lane, int b, int t, int row, int r) {
    const f16s* cn = (const f16s*)(P.ws + WS_CN); const f16s* qabs = (const f16s*)(P.ws + WS_QABS); f16s* obuf = (f16s*)P.out;
    const LAS unsigned short* il = (const LAS unsigned short*)(lds + IL_OFF) + r * TOPK;
    const LAS float* BIAS = (const LAS float*)(lds + BIAS_OFF);
    const int cnt = (int)((const LAS unsigned*)(lds + CNTQ_OFF))[r];
    const int q = lane >> 4, fr = lane & 15;
    h8 qb[8];
    { const f16s* qp = qabs + (size_t)row * (NH * CL) + (fr & 7) * CL + 8 * q;
#pragma unroll
      for (int ks = 0; ks < 8; ++ks) qb[ks] = *(const GAS h8*)(qp + 32 * ks); }
    const int cp = lane & 15;
    const char* cnb = (const char*)(cn + (size_t)b * SEQ * CL);
    auto issue = [&](int c) {
        LAS unsigned char* dst = buf + (c & 1) * 8192;
#pragma unroll
        for (int kq = 0; kq < 4; ++kq) { const int rw = 4 * kq + q; int pos = 16 * c + rw; pos = pos < cnt ? pos : 0;
            const int key = il[pos]; const int fx = ((rw & 3) << 2) | ((rw >> 2) & 3);
            const char* src = cnb + (size_t)key * (CL * 2) + 16 * (cp ^ fx);
            __builtin_amdgcn_global_load_lds((const unsigned*)src, (LAS unsigned*)(dst + kq * 1024), 16, 0, 0);
            __builtin_amdgcn_global_load_lds((const unsigned*)(src + 256), (LAS unsigned*)(dst + 4096 + kq * 1024), 16, 0, 0); }
    };
    int roff[4];
#pragma unroll
    for (int s = 0; s < 4; ++s) roff[s] = 256 * fr + 64 * (s ^ (fr & 3)) + 16 * (q ^ ((fr >> 2) & 3));
    const int qq = fr >> 2, pp = fr & 3;
    const int trb = 256 * (4 * q + qq) + 16 * ((((pp >> 1) ^ (q & 1)) | (q & 2)) ^ (qq << 2)) + 8 * (pp & 1);
    f32x4 Y[16];
    const f32x4 zero4 = {0.f, 0.f, 0.f, 0.f};
#pragma unroll
    for (int ct = 0; ct < 16; ++ct) Y[ct] = zero4;
    float m = -INFINITY, ssum = 0.f;
    issue(0);
    for (int c = 0; c < 16; ++c) {
        if (c + 1 < 16) { issue(c + 1); asm volatile("s_waitcnt vmcnt(8)" ::: "memory"); }
        else asm volatile("s_waitcnt vmcnt(0)" ::: "memory");
        const LAS unsigned char* bb = buf + (c & 1) * 8192;
        f32x4 X = zero4;
#pragma unroll
        for (int s = 0; s < 8; ++s) { const h8 a = *(const LAS h8*)(bb + (s >> 2) * 4096 + roff[s & 3]); X = __builtin_amdgcn_mfma_f32_16x16x32_f16(a, qb[s], X, 0, 0, 0); }
        float l[4];
        { const v4i16 kk = *(const LAS v4i16*)(il + 16 * c + 4 * q);
#pragma unroll
          for (int e = 0; e < 4; ++e) { const int pos = 16 * c + 4 * q + e; int d = t - (int)(unsigned short)kk[e]; d = d < 0 ? 0 : (d > 128 ? 128 : d);
              const float bs = BIAS[d * 8 + (fr & 7)]; l[e] = pos < cnt ? X[e] * 0.08838834764831845f + bs : -INFINITY; } }
        float mx = fmaxf(fmaxf(l[0], l[1]), fmaxf(l[2], l[3]));
        mx = fmaxf(mx, __shfl_xor(mx, 16)); mx = fmaxf(mx, __shfl_xor(mx, 32));
        if (c == 0) m = mx;
        else if (__any(mx > m + 8.f)) { const float mn = fmaxf(m, mx), al = __expf(m - mn);
#pragma unroll
            for (int ct = 0; ct < 16; ++ct) Y[ct] *= al;
            ssum *= al; m = mn; }
        float p[4];
#pragma unroll
        for (int e = 0; e < 4; ++e) { p[e] = __expf(l[e] - m); ssum += p[e]; }
        h8 pb;
#pragma unroll
        for (int e = 0; e < 4; ++e) { pb[e] = (f16)p[e]; pb[4 + e] = (f16)0.f; }
#pragma unroll
        for (int ct = 0; ct < 16; ++ct) {
            const v4i16 tv = __builtin_amdgcn_ds_read_tr16_b64_v4i16((LAS v4i16*)(bb + (ct >> 3) * 4096 + (trb ^ (32 * (ct & 7)))));
            const h4v th = __builtin_bit_cast(h4v, tv);
            const h8 a2 = __builtin_shufflevector(th, th, 0, 1, 2, 3, 0, 1, 2, 3);
            Y[ct] = __builtin_amdgcn_mfma_f32_16x16x32_f16(a2, pb, Y[ct], 0, 0, 0); }
    }
    ssum += __shfl_xor(ssum, 16); ssum += __shfl_xor(ssum, 32);
    const float inv = 1.f / ssum;
    if (fr < 8) { f16s* op = obuf + (size_t)row * (NH * CL) + fr * CL + 4 * q;
#pragma unroll
        for (int ct = 0; ct < 16; ++ct) { v2u o; o.x = pkh(Y[ct][0] * inv, Y[ct][1] * inv); o.y = pkh(Y[ct][2] * inv, Y[ct][3] * inv); *(GAS v2u*)(op + 16 * ct) = o; } }
}

__device__ __forceinline__ void p3_v(const Params& P, int lane, int h, int row0) {
    const f16s* obuf = (const f16s*)P.out; const f16s* wT = (const f16s*)(P.ws + WS_WUVT) + (size_t)h * HD * CL; const f16s* proj = (const f16s*)(P.ws + WS_PROJ); f16s* y = (f16s*)(P.ws + WS_H);
    const int q = lane >> 4, fr = lane & 15;
    h8 ob[8];
    { const f16s* op = obuf + (size_t)(row0 + fr) * (NH * CL) + h * CL + 8 * q;
#pragma unroll
      for (int ks = 0; ks < 8; ++ks) ob[ks] = *(const GAS h8*)(op + 32 * ks); }
    const f32x4 zero4 = {0.f, 0.f, 0.f, 0.f};
#pragma unroll
    for (int nt = 0; nt < 8; ++nt) {
        f32x4 acc = zero4;
        const f16s* wp = wT + (size_t)(16 * nt + fr) * CL + 8 * q;
#pragma unroll
        for (int ks = 0; ks < 8; ++ks) { const h8 a = *(const GAS h8*)(wp + 32 * ks); acc = __builtin_amdgcn_mfma_f32_16x16x32_f16(a, ob[ks], acc, 0, 0, 0); }
        const size_t col = (size_t)h * HD + 16 * nt + 4 * q;
        const h4v g = *(const GAS h4v*)(proj + (size_t)(row0 + fr) * NINP + C_GB + col);
        v2u o; o.x = pkh(acc[0] * siluf_((float)g[0]), acc[1] * siluf_((float)g[1])); o.y = pkh(acc[2] * siluf_((float)g[2]), acc[3] * siluf_((float)g[3]));
        *(GAS v2u*)(y + (size_t)(row0 + fr) * DM + LRU_W + col) = o;
    }
}

__device__ __forceinline__ void p3_items(Frame& F, const Params& P) {
    {
        LAS float* BIAS = (LAS float*)(F.lds + BIAS_OFF);
        for (int e = F.tid; e < 129 * 8; e += NT) { const int d = e >> 3, h = e & 7; BIAS[e] = P.rel_bias[(d < 128 ? (int)BUCKET[d] : 31) * NH + h]; }
    }
    __syncthreads();
    for (int u = F.vcu; u < BATCH * (SEQ / 16); u += F.G) {
        const int up = u & 255, k = u >> 8, b = up >> 6, j = up & 63, i = k ? 127 - j : j;
        p3_d1(F, P, b, i);
        int lane = F.lane; asm volatile("" : "+v"(lane));
        LAS unsigned char* buf = F.lds + F.wave * 16384;
#pragma unroll 1
        for (int rr = 0; rr < 2; ++rr) { const int r = 2 * F.wave + rr; p3_d2_query(P, F.lds, buf, lane, b, 16 * i + r, b * SEQ + 16 * i + r, r); }
        asm volatile("s_waitcnt vmcnt(0)" ::: "memory");
        __syncthreads();
        p3_v(P, lane, F.wave, b * SEQ + 16 * i);
        __syncthreads();
    }
}

__device__ __forceinline__ void p5_final(Frame& F, const Params& P) {
    const int gw = F.vcu * NWAVES + F.wave, NGW = F.G * NWAVES, lane = F.lane;
    for (int m = gw; m < M; m += NGW) {
        GAS f32x4* xr = (GAS f32x4*)(P.out + (size_t)m * DM) + lane; const GAS f32x4* gr = (const GAS f32x4*)P.fin_g + lane;
        f32x4 v[8]; float s = 0.f;
#pragma unroll
        for (int j = 0; j < 8; ++j) { v[j] = xr[64 * j]; s += (v[j].x * v[j].x + v[j].y * v[j].y) + (v[j].z * v[j].z + v[j].w * v[j].w); }
        const float r = rsqrtf(wave_sum(s) * (1.f / DM) + EPS);
#pragma unroll
        for (int j = 0; j < 8; ++j) xr[64 * j] = v[j] * r * gr[64 * j];
    }
}

__global__ void __launch_bounds__(NT, 2) fwd_kernel(Params P) {
    extern __shared__ __attribute__((aligned(16))) unsigned char lds[];
    Frame F;
    F.lds = (LAS unsigned char*)lds;
    F.MISC = (volatile LAS unsigned*)(F.lds + MISC_OFF);
    F.tid = threadIdx.x; F.lane = F.tid & 63; F.wave = __builtin_amdgcn_readfirstlane(F.tid >> 6);
    F.G = gridDim.x; { const int bx = blockIdx.x; F.vcu = (F.G % 8 == 0) ? (bx % 8) * (F.G / 8) + bx / 8 : bx; }
    F.ctl = (gu32*)(P.ws + WS_CTL);
    for (int u = F.tid; u < (LDS_BYTES - LDSCTL_OFF) / 4; u += NT) ((LAS unsigned*)(F.lds + LDSCTL_OFF))[u] = 0u;
    __syncthreads();
    XcdBarrier bar = xcd_barrier_post((unsigned*)(F.ctl + CW_BAR), F.MISC + 8);

    p0_prologue(F, P);
    xcd_barrier(bar);
    {
        pg8::Gemm g{(const pg8::bf16_t*)(P.ws + WS_H), (const pg8::bf16_t*)(P.ws + WS_WIN), M, NINP, DM};
        pg8::StaticOrder S; S.init(M, NINP, F.G, (int)blockIdx.x);
        pg8::EpiF16 E{(pg8::bf16_t*)(P.ws + WS_PROJ), NINP};
        pg8::gemm_phase<pg8::EpiF16, pg8::StaticOrder, true, true>(F.lds + RING_OFF, g, S, E);
    }
    xcd_barrier(bar);
    p2_gates_mfma(F, P);
    p2_qabs_mfma(F, P);
    p2_norms(F, P);
    xcd_barrier(bar);
    p3_scanA(F, P);
    xcd_barrier(bar);
    p3_scanB(F, P);
    p3_items(F, P);
    xcd_barrier(bar);
    {
        pg8::Gemm g{(const pg8::bf16_t*)(P.ws + WS_H), (const pg8::bf16_t*)(P.ws + WS_WOUT), M, DM, DM};
        pg8::StaticOrder S; S.init(M, DM, F.G, (int)blockIdx.x);
        pg8::EpiResF32 E{P.x, P.out, DM};
        pg8::gemm_phase<pg8::EpiResF32, pg8::StaticOrder, false, true>(F.lds + RING_OFF, g, S, E);
    }
    xcd_barrier(bar);
    p5_final(F, P);
}

extern "C" void kernel_launch(void* const* d_in, const int* in_sizes, int n_in, void* d_out, int out_size, void* d_ws, size_t ws_size, hipStream_t stream) {
    static int grid = 0;
    if (grid == 0) {
        if (n_in != 18 || out_size != M * DM || ws_size < WS_END) { fprintf(stderr, "kernel_launch: unexpected shapes (n_in %d out %d ws %zu)\n", n_in, out_size, ws_size); grid = -1; return; }
        int dev = 0, cus = 0, per_cu = 0;
        if (hipGetDevice(&dev) != hipSuccess || hipDeviceGetAttribute(&cus, hipDeviceAttributeMultiprocessorCount, dev) != hipSuccess) { grid = -1; return; }
        if (hipFuncSetAttribute((const void*)fwd_kernel, hipFuncAttributeMaxDynamicSharedMemorySize, LDS_BYTES) != hipSuccess) { fprintf(stderr, "kernel_launch: hipFuncSetAttribute failed\n"); grid = -1; return; }
        if (hipOccupancyMaxActiveBlocksPerMultiprocessor(&per_cu, (const void*)fwd_kernel, NT, LDS_BYTES) != hipSuccess || per_cu < 1) fprintf(stderr, "kernel_launch: occupancy query says %d\n", per_cu);
        (void)hipGetLastError();
        grid = cus;
    }
    if (grid < 0) return;
    (void)hipMemsetAsync((char*)d_ws + WS_CTL, 0, CTL_ZERO_BYTES, stream);
    Params p{};
    p.x = (const float*)d_in[0]; p.norm_g = (const float*)d_in[1]; p.w_in = (const float*)d_in[2]; p.conv_w = (const float*)d_in[3]; p.conv_b = (const float*)d_in[4];
    p.wa = (const float*)d_in[5]; p.ba = (const float*)d_in[6]; p.wx = (const float*)d_in[7]; p.bx = (const float*)d_in[8]; p.lam = (const float*)d_in[9];
    p.ckv_g = (const float*)d_in[10]; p.ikg = (const float*)d_in[11]; p.ikb = (const float*)d_in[12]; p.w_uk = (const float*)d_in[13]; p.w_uv = (const float*)d_in[14];
    p.w_out = (const float*)d_in[15]; p.rel_bias = (const float*)d_in[16]; p.fin_g = (const float*)d_in[17];
    p.out = (float*)d_out; p.ws = (unsigned char*)d_ws;
    hipLaunchKernelGGL(fwd_kernel, dim3(grid), dim3(NT), LDS_BYTES, stream, p);
}
```

```cpp
#define PROBE_REP 0
#include <hip/hip_runtime.h>
#include <cstdio>
#include <cstdint>
#ifndef OPT_DMA_ASM
#define OPT_DMA_ASM 1
#endif
namespace pg8 {
#define PG8_LAS __attribute__((address_space(3)))
typedef unsigned short bf16_t;
typedef _Float16 f16x8 __attribute__((ext_vector_type(8)));
typedef _Float16 f16x2 __attribute__((ext_vector_type(2)));
typedef float f32x2 __attribute__((ext_vector_type(2)));
typedef float f32x4 __attribute__((ext_vector_type(4)));
typedef unsigned u32x4 __attribute__((ext_vector_type(4)));
constexpr int BM = 256, BK = 64, HALF = 128, HTB = HALF * BK * 2  , STAGE_BYTES = 8 * HTB, NXCD = 8, WGM = 8;

__host__ __device__ __forceinline__ int lds_byte(int r, int c) { const int st = (r >> 4) * 2 + (c >> 5), rr = r & 15, cc = c & 31, ob = rr * 64 + cc * 2; return st * 1024 + (ob ^ (((ob >> 9) & 1) << 5)); }
__host__ __device__ __forceinline__ void stage_rc(int b, int& R, int& C) { const int st = b / 1024, sb = b % 1024, swz = sb ^ (((sb >> 9) & 1) << 5); R = (st >> 1) * 16 + swz / 64; C = (st & 1) * 32 + (swz % 64) / 2; }
__host__ __device__ __forceinline__ int perm32(int rho) { const int n = rho >> 4, i = rho & 15; return 8 * (i >> 2) + 4 * n + (i & 3); }

struct Unit { int pm, pn; };
struct Gemm { const bf16_t* A; const bf16_t* Bt; int M, N, K; };

struct StaticOrder {
    int nM, nN, nwg, G, c;
    __host__ __device__ void init(int M, int N, int G_, int c_) { nM = M / BM; nN = N / BM; nwg = nM * nN; G = G_; c = c_; }
    __host__ __device__ bool next(int i, Unit& u) const {
        const long L = (long)i * G + c; if (L >= nwg) return false;
        int wgid = (int)L; { const int q = nwg / NXCD, r = nwg % NXCD, xcd = wgid % NXCD, off = wgid / NXCD; wgid = (xcd < r ? xcd * (q + 1) : r * (q + 1) + (xcd - r) * q) + off; }
        const int nig = WGM * nN, gid = wgid / nig, fm = gid * WGM, gsz = (nM - fm) < WGM ? (nM - fm) : WGM;
        u.pm = fm + ((wgid % nig) % gsz); u.pn = (wgid % nig) / gsz; return true;
    }
    __device__ __forceinline__ void a_ready(const Unit&) const {}
    __device__ __forceinline__ void done(const Unit&) const {}
};

__device__ __forceinline__ unsigned cvt_pk_f16(float lo, float hi) { const f32x2 v = {lo, hi}; return __builtin_bit_cast(unsigned, __builtin_convertvector(v, f16x2)); }
struct EpiF16 {
    static constexpr bool PERM = true, AFTER_DRAIN = false;
    bf16_t* O; int ldc;
    __device__ __forceinline__ void operator()(const f32x4 (&acc)[2][2][4][2], const Unit& u, int wr, int wc, int fr, int fq) const {
        const int row0 = u.pm * BM + wr * 64 + fr, col0 = u.pn * BM + wc * 32 + 8 * fq;
#pragma unroll
        for (int ai = 0; ai < 2; ++ai)
#pragma unroll
            for (int m = 0; m < 4; ++m) { bf16_t* rowp = O + (size_t)(row0 + ai * HALF + m * 16) * ldc + col0;
#pragma unroll
                for (int bj = 0; bj < 2; ++bj) { const f32x4 v0 = acc[ai][bj][m][0], v1 = acc[ai][bj][m][1];
                    u32x4 w; w.x = cvt_pk_f16(v0[0], v0[1]); w.y = cvt_pk_f16(v0[2], v0[3]); w.z = cvt_pk_f16(v1[0], v1[1]); w.w = cvt_pk_f16(v1[2], v1[3]);
                    *(u32x4*)(rowp + bj * HALF) = w; } }
    }
};
struct EpiResF32 {
    static constexpr bool PERM = false, AFTER_DRAIN = false;
    const float* base; float* out; int ldc;
    __device__ __forceinline__ void operator()(const f32x4 (&acc)[2][2][4][2], const Unit& u, int wr, int wc, int fr, int fq) const {
        const int row0 = u.pm * BM + wr * 64 + fr, col0 = u.pn * BM + wc * 32 + 4 * fq;
        const float* __restrict__ bp = base; float* __restrict__ op = out;
        f32x4 r[2][2][2];
#define EPI_LOAD(g) do { const size_t off_ = (size_t)(row0 + ((g) >> 2) * HALF + ((g) & 3) * 16) * ldc + col0; _Pragma("unroll") for (int bj = 0; bj < 2; ++bj) _Pragma("unroll") for (int n = 0; n < 2; ++n) r[(g) & 1][bj][n] = *(const f32x4*)(bp + off_ + bj * HALF + n * 16); } while (0)
        EPI_LOAD(0);
#pragma unroll
        for (int g = 0; g < 8; ++g) { const int ai = g >> 2, m = g & 3;
            if (g + 1 < 8) EPI_LOAD(g + 1);
            const size_t off = (size_t)(row0 + ai * HALF + m * 16) * ldc + col0;
#pragma unroll
            for (int bj = 0; bj < 2; ++bj)
#pragma unroll
                for (int n = 0; n < 2; ++n) *(f32x4*)(op + off + bj * HALF + n * 16) = r[g & 1][bj][n] + acc[ai][bj][m][n]; }
#undef EPI_LOAD
    }
};

template <class Epi, class Sched, bool ALIGN_EPI = false, bool SP2 = false>
__device__ __forceinline__ void gemm_phase(PG8_LAS unsigned char* lds, const Gemm g, const Sched& S, const Epi& E) {
    const int tid = threadIdx.x, wid = __builtin_amdgcn_readfirstlane(tid >> 6), lane = tid & 63, wr = wid >> 2, wc = wid & 3, fr = lane & 15, fq = lane >> 4;
    const int K = g.K, nt = K / BK;
    unsigned voffA[2], voffB[2];
#pragma unroll
    for (int i = 0; i < 2; ++i) { int R, C; stage_rc(tid * 16 + i * 8192, R, C); const int Rb = Epi::PERM ? ((R & ~31) + perm32(R & 31)) : R;
        voffA[i] = (unsigned)(R * K + C) * 2u; voffB[i] = (unsigned)(Rb * K + C) * 2u; }
    const size_t kstep = (size_t)(BK * 2);
    const size_t hstep = (size_t)HALF * K * 2;
    const size_t tstep = 2 * hstep;
    const unsigned ldsw = (unsigned)wid * 1024u;
    const int aoff = lds_byte(wr * 64 + fr, fq * 8), boff = lds_byte(wc * 32 + fr, fq * 8);
#define PG8_SA(b, h) (((b) * 2 + (h)) * HTB)
#define PG8_SB(b, h) ((4 + (b) * 2 + (h)) * HTB)
#define PG8_STAGE(bufoff, gbase, voff) do { _Pragma("unroll") for (int _i = 0; _i < 2; ++_i) \
        __builtin_amdgcn_global_load_lds((const unsigned*)((const char*)(gbase) + (voff)[_i]), (PG8_LAS unsigned*)(lds + (bufoff) + ldsw + _i * 8192), 16, 0, 0); } while (0)
#define PG8_LDA(dst, b, h) do { _Pragma("unroll") for (int m = 0; m < 4; ++m) _Pragma("unroll") for (int k = 0; k < 2; ++k) dst[m][k] = *(const PG8_LAS f16x8*)(lds + PG8_SA(b, h) + aoff + m * 2048 + k * 1024); } while (0)
#define PG8_LDB(dst, b, h) do { _Pragma("unroll") for (int n = 0; n < 2; ++n) _Pragma("unroll") for (int k = 0; k < 2; ++k) dst[n][k] = *(const PG8_LAS f16x8*)(lds + PG8_SB(b, h) + boff + n * 2048 + k * 1024); } while (0)
#define PG8_MMA(ai, bj, At, Bt) do { __builtin_amdgcn_s_setprio(1); _Pragma("unroll") for (int m = 0; m < 4; ++m) _Pragma("unroll") for (int n = 0; n < 2; ++n) _Pragma("unroll") for (int k = 0; k < 2; ++k) \
        acc[ai][bj][m][n] = __builtin_amdgcn_mfma_f32_16x16x32_f16(Bt[n][k], At[m][k], acc[ai][bj][m][n], 0, 0, 0); __builtin_amdgcn_s_setprio(0); } while (0)
#define PG8_WAIT_V(n) asm volatile("s_waitcnt vmcnt(" #n ")" ::: "memory")
#define PG8_WAIT_L(n) asm volatile("s_waitcnt lgkmcnt(" #n ")" ::: "memory")
#define PG8_BAR __builtin_amdgcn_s_barrier()
#define PG8_SCHED __builtin_amdgcn_sched_barrier(0)
    Unit cur, nxt; int ui = 0;
    if (!S.next(0, cur)) return;
    f32x4 acc[2][2][4][2];
#pragma unroll
    for (int a = 0; a < 2; ++a)
#pragma unroll
        for (int b = 0; b < 2; ++b)
#pragma unroll
            for (int m = 0; m < 4; ++m)
#pragma unroll
                for (int n = 0; n < 2; ++n) acc[a][b][m][n] = (f32x4){0.f, 0.f, 0.f, 0.f};
    f16x8 At[4][2], B0[2][2], B1[2][2];
    const char* cA = (const char*)g.A + (size_t)cur.pm * tstep; const char* cB = (const char*)g.Bt + (size_t)cur.pn * tstep;
    S.a_ready(cur);
    if constexpr (SP2) {
        PG8_STAGE(PG8_SB(0, 0), cB, voffB); PG8_STAGE(PG8_SB(0, 1), cB + hstep, voffB); PG8_STAGE(PG8_SA(0, 0), cA, voffA); PG8_STAGE(PG8_SA(0, 1), cA + hstep, voffA);
        if (wr == 1) PG8_BAR;
        PG8_WAIT_V(2); PG8_BAR;
        PG8_STAGE(PG8_SB(1, 0), cB + kstep, voffB); PG8_STAGE(PG8_SA(1, 0), cA + kstep, voffA); PG8_STAGE(PG8_SB(1, 1), cB + hstep + kstep, voffB);
        PG8_WAIT_V(6); PG8_BAR;
    } else {
        PG8_STAGE(PG8_SB(0, 0), cB, voffB); PG8_STAGE(PG8_SA(0, 0), cA, voffA); PG8_STAGE(PG8_SB(0, 1), cB + hstep, voffB); PG8_STAGE(PG8_SA(0, 1), cA + hstep, voffA);
        if (wr == 1) PG8_BAR;
        PG8_WAIT_V(4); PG8_BAR;
        PG8_STAGE(PG8_SB(1, 0), cB + kstep, voffB); PG8_STAGE(PG8_SA(1, 0), cA + kstep, voffA); PG8_STAGE(PG8_SB(1, 1), cB + hstep + kstep, voffB);
        PG8_WAIT_V(6); PG8_BAR;
    }
    for (;;) {
        const bool has_next = S.next(ui + 1, nxt);
        const char* nA = has_next ? (const char*)g.A + (size_t)nxt.pm * tstep : cA; const char* nB = has_next ? (const char*)g.Bt + (size_t)nxt.pn * tstep : cB;
        for (int t = 0; t < nt; t += 2) {
            const bool last = (t == nt - 2);
            const char* a1 = cA + (size_t)(t + 1) * kstep;
            const char* a2 = last ? nA : cA + (size_t)(t + 2) * kstep; const char* b2 = last ? nB : cB + (size_t)(t + 2) * kstep;
            const char* a3 = a2 + kstep; const char* b3 = b2 + kstep;
            if (last && has_next) S.a_ready(nxt);
            if constexpr (SP2) {
            PG8_LDB(B0, 0, 0); PG8_LDB(B1, 0, 1); PG8_SCHED; PG8_LDA(At, 0, 0); PG8_STAGE(PG8_SA(1, 1), a1 + hstep, voffA);
            PG8_WAIT_V(8); PG8_WAIT_L(0); PG8_BAR; PG8_MMA(0, 0, At, B0); PG8_MMA(0, 1, At, B1); PG8_BAR; PG8_SCHED;
            PG8_LDA(At, 0, 1); PG8_STAGE(PG8_SB(0, 0), b2, voffB); PG8_STAGE(PG8_SB(0, 1), b2 + hstep, voffB); PG8_STAGE(PG8_SA(0, 0), a2, voffA);
            PG8_WAIT_V(8); PG8_WAIT_L(0); PG8_BAR; PG8_MMA(1, 0, At, B0); PG8_MMA(1, 1, At, B1); PG8_BAR; PG8_SCHED;
            PG8_LDB(B0, 1, 0); PG8_LDB(B1, 1, 1); PG8_SCHED; PG8_LDA(At, 1, 0); PG8_STAGE(PG8_SA(0, 1), a2 + hstep, voffA);
            PG8_WAIT_V(8); PG8_WAIT_L(0); PG8_BAR; PG8_MMA(0, 0, At, B0); PG8_MMA(0, 1, At, B1); PG8_BAR; PG8_SCHED;
            PG8_LDA(At, 1, 1); PG8_STAGE(PG8_SB(1, 0), b3, voffB); PG8_STAGE(PG8_SB(1, 1), b3 + hstep, voffB); PG8_STAGE(PG8_SA(1, 0), a3, voffA);
            PG8_WAIT_V(8); PG8_WAIT_L(0); PG8_BAR; PG8_MMA(1, 0, At, B0); PG8_MMA(1, 1, At, B1); PG8_BAR; PG8_SCHED;
            } else {
            PG8_LDB(B0, 0, 0); PG8_SCHED; PG8_LDA(At, 0, 0); PG8_STAGE(PG8_SA(1, 1), a1 + hstep, voffA);
            PG8_WAIT_L(8); PG8_BAR; PG8_WAIT_L(0); PG8_MMA(0, 0, At, B0); PG8_BAR; PG8_SCHED;
            PG8_LDB(B1, 0, 1); PG8_STAGE(PG8_SB(0, 0), b2, voffB);
            PG8_BAR; PG8_WAIT_L(0); PG8_MMA(0, 1, At, B1); PG8_BAR;
            PG8_LDA(At, 0, 1); PG8_STAGE(PG8_SA(0, 0), a2, voffA);
            PG8_BAR; PG8_WAIT_L(0); PG8_MMA(1, 0, At, B0); PG8_BAR; PG8_SCHED;
            PG8_STAGE(PG8_SB(0, 1), b2 + hstep, voffB);
            PG8_WAIT_V(6); PG8_BAR; PG8_MMA(1, 1, At, B1); PG8_BAR;
            PG8_LDB(B0, 1, 0); PG8_SCHED; PG8_LDA(At, 1, 0); PG8_STAGE(PG8_SA(0, 1), a2 + hstep, voffA);
            PG8_WAIT_L(8); PG8_BAR; PG8_WAIT_L(0); PG8_MMA(0, 0, At, B0); PG8_BAR; PG8_SCHED;
            PG8_LDB(B1, 1, 1); PG8_STAGE(PG8_SB(1, 0), b3, voffB);
            PG8_BAR; PG8_WAIT_L(0); PG8_MMA(0, 1, At, B1); PG8_BAR;
            PG8_LDA(At, 1, 1); PG8_STAGE(PG8_SA(1, 0), a3, voffA);
            PG8_BAR; PG8_WAIT_L(0); PG8_MMA(1, 0, At, B0); PG8_BAR; PG8_SCHED;
            PG8_STAGE(PG8_SB(1, 1), b3 + hstep, voffB);
            PG8_WAIT_V(6); PG8_BAR; PG8_MMA(1, 1, At, B1); PG8_BAR;
            }
        }
        if constexpr (ALIGN_EPI) { if (wr == 0) PG8_BAR; }
        if constexpr (!Epi::AFTER_DRAIN) { E(acc, cur, wr, wc, fr, fq); S.done(cur); }
        if (!has_next) break;
#pragma unroll
        for (int a = 0; a < 2; ++a)
#pragma unroll
            for (int b = 0; b < 2; ++b)
#pragma unroll
                for (int m = 0; m < 4; ++m)
#pragma unroll
                    for (int n = 0; n < 2; ++n) acc[a][b][m][n] = (f32x4){0.f, 0.f, 0.f, 0.f};
        cur = nxt; cA = nA; cB = nB; ++ui;
        if constexpr (ALIGN_EPI) { if (wr == 1) PG8_BAR; }
    }
    PG8_WAIT_V(0);
    if constexpr (!ALIGN_EPI) { if (wr == 0) PG8_BAR; }
    PG8_BAR;
    if constexpr (Epi::AFTER_DRAIN) { E.fused(acc, cur, wr, wc, fr, fq, lds, wid, lane); S.done(cur); }
#undef PG8_SA
#undef PG8_SB
#undef PG8_STAGE
#undef PG8_LDA
#undef PG8_LDB
#undef PG8_MMA
#undef PG8_WAIT_V
#undef PG8_WAIT_L
#undef PG8_BAR
#undef PG8_SCHED
}
}
constexpr int NWAVES = 8, NT = NWAVES * 64;
constexpr int BATCH = 4, SEQ = 2048, DM = 2048, M = BATCH * SEQ;
constexpr int LRU_W = 1024, LRU_BLK = 8, LRU_BD = 128;
constexpr int ATT_W = 1024, NH = 8, HD = 128, CL = 256, IH = 16, ID = 64, TOPK = 256;
constexpr int C_XA = 0, C_GA = 1024, C_Q = 2048, C_CKV = 3072, C_GB = 3328, C_QI = 4352, C_KI = 5376, C_WI = 5440, NIN = 5456, NINP = 5632;
constexpr float EPS = 1e-6f;
__constant__ unsigned char BUCKET[128] = {0, 1, 2, 3, 4, 5, 6, 7, 8, 9, 10, 11, 12, 13, 14, 15, 16, 16, 16, 17, 17, 18, 18, 18, 19, 19, 19, 20, 20, 20, 20, 21, 21, 21, 21, 22, 22, 22, 22, 22, 23, 23, 23, 23, 23, 23, 24, 24, 24, 24, 24, 24, 25, 25, 25, 25, 25, 25, 25, 26, 26, 26, 26, 26, 26, 26, 26, 27, 27, 27, 27, 27, 27, 27, 27, 27, 27, 28, 28, 28, 28, 28, 28, 28, 28, 28, 28, 29, 29, 29, 29, 29, 29, 29, 29, 29, 29, 29, 29, 30, 30, 30, 30, 30, 30, 30, 30, 30, 30, 30, 30, 30, 30, 31, 31, 31, 31, 31, 31, 31, 31, 31, 31, 31, 31, 31, 31, 31};

constexpr size_t MiB = 1u << 20;
constexpr size_t WS_CTL = 0, CTL_ZERO_BYTES = 1 * MiB;
constexpr size_t WS_WIN = 2 * MiB;
constexpr size_t WS_WOUT = 24 * MiB;
constexpr size_t WS_H = 32 * MiB;
constexpr size_t WS_PROJ = 64 * MiB;
constexpr size_t WS_A = 152 * MiB;
constexpr size_t WS_B = 184 * MiB;
constexpr size_t WS_QABS = 216 * MiB;
constexpr size_t WS_CN = 248 * MiB;
constexpr size_t WS_KN = 252 * MiB;
constexpr size_t WS_WUVT = 253 * MiB;
constexpr size_t WS_WUKT = WS_WUVT + 512 * 1024;
constexpr size_t WS_WAT = 254 * MiB;
constexpr size_t WS_WXT = WS_WAT + 256 * 1024;
constexpr size_t WS_AGG = WS_WXT + 256 * 1024;
constexpr size_t WS_END = 256 * MiB;
constexpr int CW_TMO = 0, CW_CODE = 1, CW_BAR = 4096;

constexpr int RING_OFF = 0, RING_BYTES = 131072;
constexpr int LDSCTL_OFF = RING_BYTES, MISC_OFF = LDSCTL_OFF + 320;
constexpr int LDS_BYTES = 163840;

#define GAS __attribute__((address_space(1)))
#define LAS __attribute__((address_space(3)))
typedef unsigned short f16s;
typedef _Float16 f16;
typedef _Float16 h4 __attribute__((ext_vector_type(4)));
typedef _Float16 h8 __attribute__((ext_vector_type(8)));
typedef unsigned v4u __attribute__((ext_vector_type(4)));
typedef unsigned v2u __attribute__((ext_vector_type(2)));
typedef float f32x4 __attribute__((ext_vector_type(4)));
typedef float f32x2 __attribute__((ext_vector_type(2)));
typedef GAS unsigned gu32;
#define RLX_AGENT __ATOMIC_RELAXED, __HIP_MEMORY_SCOPE_AGENT
#define LDS_WAIT() asm volatile("s_waitcnt lgkmcnt(0)" ::: "memory")
#define VM_WAIT() asm volatile("s_waitcnt vmcnt(0)" ::: "memory")
__device__ __forceinline__ unsigned pkh(float lo, float hi) { return pg8::cvt_pk_f16(lo, hi); }
__device__ __forceinline__ float sigmoidf_(float x) { return __builtin_amdgcn_rcpf(1.f + __expf(-x)); }
__device__ __forceinline__ float siluf_(float x) { return x * __builtin_amdgcn_rcpf(1.f + __expf(-x)); }
__device__ __forceinline__ float h2f(f16s v) { return (float)__builtin_bit_cast(f16, v); }

#define XB_TMO      128
#define XB_XCNT(j)  (256  + 64 * (j))
#define XB_XSUB(j)  (1280 + 64 * (j))
#define XB_XGEN(j)  (2304 + 64 * (j))
#define XB_TOP      3328
#define XB_TOPGEN   3392
#define XCD_BAR_WORDS 3456
#define XB_SPIN_CAP (1u << 18)

__device__ __forceinline__ unsigned xb_ld(unsigned* p)              { return __hip_atomic_load(p, __ATOMIC_RELAXED, __HIP_MEMORY_SCOPE_AGENT); }
__device__ __forceinline__ unsigned xb_add(unsigned* p, unsigned v) { return __hip_atomic_fetch_add(p, v, __ATOMIC_RELAXED, __HIP_MEMORY_SCOPE_AGENT); }
__device__ __forceinline__ unsigned xb_xcc_id() { return (unsigned)__builtin_amdgcn_s_getreg((3 << 11) | 20) & 0xFu; }
#define XB_SPIN(cond, bar) do { unsigned _sp = 0; while (cond) { __builtin_amdgcn_s_sleep(1); \
    if ((++_sp & 255u) == 0u) { if (xb_ld(&(bar)[XB_TMO])) break; if (_sp > XB_SPIN_CAP) { atomicAdd(&(bar)[XB_TMO], 1u); break; } } } } while (0)

struct XcdBarrier {
    unsigned* bar; unsigned x;
    volatile LAS unsigned* st;
};

__device__ __forceinline__ XcdBarrier xcd_barrier_post(unsigned* bar, volatile LAS unsigned* st) {
    XcdBarrier b; b.bar = bar; b.x = xb_xcc_id(); b.st = st;
    if (threadIdx.x == 0) (void)xb_add(&bar[XB_XCNT(b.x)], 1u);
    return b;
}
__device__ __forceinline__ void xcd_barrier_complete(unsigned* bar, unsigned x, unsigned& nloc, unsigned& nx) {
    const unsigned G = gridDim.x * gridDim.y * gridDim.z;
    unsigned sum, cnt, mine, sp = 0u;
    for (;;) {
        sum = 0u; cnt = 0u; mine = 0u;
#pragma unroll
        for (unsigned j = 0; j < 16; ++j) { const unsigned c = xb_ld(&bar[XB_XCNT(j)]); sum += c; cnt += (c > 0u) ? 1u : 0u; mine = (j == x) ? c : mine; }
        if (sum == G) break;
        __builtin_amdgcn_s_sleep(1);
        if ((++sp & 255u) == 0u) { if (xb_ld(&bar[XB_TMO])) break; if (sp > XB_SPIN_CAP) { atomicAdd(&bar[XB_TMO], 1u); break; } }
    }
    nloc = mine > 0u ? mine : 1u; nx = cnt > 0u ? cnt : 1u;
}

__device__ __forceinline__ void xcd_barrier(const XcdBarrier& b) {
    asm volatile("s_waitcnt vmcnt(0)" ::: "memory");
    __syncthreads();
    if (threadIdx.x == 0) {
        unsigned* bar = b.bar;
        __builtin_amdgcn_s_waitcnt(0);
        unsigned nloc = b.st[0], nx = b.st[1];
        if (nloc == 0u) { xcd_barrier_complete(bar, b.x, nloc, nx); b.st[0] = nloc; b.st[1] = nx; }
        const unsigned old = xb_add(&bar[XB_XSUB(b.x)], 1u);
        const unsigned gen = old / nloc;
        if (old + 1u == (gen + 1u) * nloc) {
            __builtin_amdgcn_fence(__ATOMIC_RELEASE, "agent");
            asm volatile("s_waitcnt vmcnt(0)" ::: "memory");
            const unsigned og = xb_add(&bar[XB_TOP], 1u);
            const unsigned tg = og / nx;
            if (og + 1u == (tg + 1u) * nx) xb_add(&bar[XB_TOPGEN], 1u);
            else XB_SPIN(xb_ld(&bar[XB_TOPGEN]) == tg, bar);
            __builtin_amdgcn_fence(__ATOMIC_ACQUIRE, "agent");
            xb_add(&bar[XB_XGEN(b.x)], 1u);
            asm volatile("s_waitcnt vmcnt(0)" ::: "memory");
        } else {
            XB_SPIN(xb_ld(&bar[XB_XGEN(b.x)]) == gen, bar);
            __builtin_amdgcn_fence(__ATOMIC_ACQUIRE, "agent");
            asm volatile("s_waitcnt vmcnt(0)" ::: "memory");
        }
    }
    __syncthreads();
}
struct Params {
    const float *x, *norm_g, *w_in, *conv_w, *conv_b, *wa, *ba, *wx, *bx, *lam, *ckv_g, *ikg, *ikb, *w_uk, *w_uv, *w_out, *rel_bias, *fin_g;
    float* out; unsigned char* ws;
};
struct Frame {
    LAS unsigned char* lds;
    volatile LAS unsigned* MISC;
    gu32* ctl;
    int tid, lane, wave, vcu, G;
#ifdef PROBE_S
    unsigned long long pt_last; unsigned pt_acc[12];
#endif
};
#ifdef PROBE_S
#define PSTAMP(F, k) do { const unsigned long long t_ = __builtin_amdgcn_s_memrealtime(); (F).pt_acc[k] += (unsigned)(t_ - (F).pt_last); (F).pt_last = t_; } while (0)
#else
#define PSTAMP(F, k) do { } while (0)
#endif
__device__ __forceinline__ float wave_sum(float v) {
#pragma unroll
    for (int o = 1; o < 64; o <<= 1) v += __shfl_xor(v, o);
    return v;
}
__device__ __forceinline__ int wave_sum_i(int v) {
#pragma unroll
    for (int o = 1; o < 64; o <<= 1) v += __shfl_xor(v, o);
    return v;
}
__device__ __forceinline__ float wave_max(float v) {
#pragma unroll
    for (int o = 1; o < 64; o <<= 1) v = fmaxf(v, __shfl_xor(v, o));
    return v;
}

struct TrDesc { const float* W; f16s* WT; int K, N, nblk, item; };
__device__ __forceinline__ void tr_load(const TrDesc& d, int lane, f32x4 (&v)[8]) {
    const int kb = d.item / d.nblk, nb = d.item % d.nblk, k0 = 64 * kb, n0 = 32 * nb, n4 = 4 * (lane & 7), kr = lane >> 3;
    const bool nok = (n0 + n4) < d.N;
#pragma unroll
    for (int i = 0; i < 8; ++i) v[i] = nok ? *(const GAS f32x4*)(d.W + (size_t)(k0 + 8 * i + kr) * d.N + n0 + n4) : (f32x4){0.f, 0.f, 0.f, 0.f};
}
__device__ __forceinline__ void tr_store(const TrDesc& d, int lane, const f32x4 (&v)[8], LAS float* scr) {
    const int kb = d.item / d.nblk, nb = d.item % d.nblk, k0 = 64 * kb, n0 = 32 * nb, n4 = 4 * (lane & 7), kr = lane >> 3;
#pragma unroll
    for (int i = 0; i < 8; ++i) { LAS float* p = scr + (8 * i + kr) * 33 + n4; p[0] = v[i][0]; p[1] = v[i][1]; p[2] = v[i][2]; p[3] = v[i][3]; }
    LDS_WAIT(); asm volatile("" ::: "memory");
    const int c = lane & 7;
#pragma unroll
    for (int j = 0; j < 4; ++j) { const int n = (lane >> 3) + 8 * j; const LAS float* s = scr + (8 * c) * 33 + n;
        v4u o; o.x = pkh(s[0 * 33], s[1 * 33]); o.y = pkh(s[2 * 33], s[3 * 33]); o.z = pkh(s[4 * 33], s[5 * 33]); o.w = pkh(s[6 * 33], s[7 * 33]);
        *(GAS v4u*)(d.WT + (size_t)(n0 + n) * d.K + k0 + 8 * c) = o; }
    LDS_WAIT(); asm volatile("" ::: "memory");
}
constexpr int NB_IN = NINP / 32, I_IN = (DM / 64) * NB_IN, I_OUT = (DM / 64) * (DM / 32), I_UV = NH * 16, I_UK = NH * 16, I_G = LRU_BLK * 16, I_ALL = I_IN + I_OUT + I_UV + I_UK + I_G;
__device__ __forceinline__ TrDesc tr_desc(const Params& P, int it) {
    TrDesc d;
    if (it < I_IN) { d.W = P.w_in; d.WT = (f16s*)(P.ws + WS_WIN); d.K = DM; d.N = NIN; d.nblk = NB_IN; d.item = it; return d; } it -= I_IN;
    if (it < I_OUT) { d.W = P.w_out; d.WT = (f16s*)(P.ws + WS_WOUT); d.K = DM; d.N = DM; d.nblk = DM / 32; d.item = it; return d; } it -= I_OUT;
    if (it < I_UV) { const int h = it >> 4; d.W = P.w_uv + (size_t)h * CL * HD; d.WT = (f16s*)(P.ws + WS_WUVT) + (size_t)h * HD * CL; d.K = CL; d.N = HD; d.nblk = HD / 32; d.item = it & 15; return d; } it -= I_UV;
    if (it < I_UK) { const int h = it >> 4; d.W = P.w_uk + (size_t)h * HD * CL; d.WT = (f16s*)(P.ws + WS_WUKT) + (size_t)h * CL * HD; d.K = HD; d.N = CL; d.nblk = CL / 32; d.item = it & 15; return d; } it -= I_UK;
    { const int g = it >> 4, w = (it >> 3) & 1; d.W = (w ? P.wx : P.wa) + (size_t)g * LRU_BD * LRU_BD; d.WT = (f16s*)(P.ws + (w ? WS_WXT : WS_WAT)) + (size_t)g * LRU_BD * LRU_BD; d.K = LRU_BD; d.N = LRU_BD; d.nblk = LRU_BD / 32; d.item = it & 7; return d; }
}
__device__ __forceinline__ void rms_load(const float* xrow, int lane, f32x4 (&v)[8]) {
    const GAS f32x4* xr = (const GAS f32x4*)xrow + lane;
#pragma unroll
    for (int j = 0; j < 8; ++j) v[j] = xr[64 * j];
}
__device__ __forceinline__ void rms_store(const f32x4 (&v)[8], const float* g, f16s* orow, int lane) {
    const GAS f32x4* gr = (const GAS f32x4*)g + lane; float s = 0.f;
#pragma unroll
    for (int j = 0; j < 8; ++j) s += (v[j].x * v[j].x + v[j].y * v[j].y) + (v[j].z * v[j].z + v[j].w * v[j].w);
    const float r = rsqrtf(wave_sum(s) * (1.f / DM) + EPS);
    GAS v2u* o8 = (GAS v2u*)orow + lane;
#pragma unroll
    for (int j = 0; j < 8; ++j) { const f32x4 gg = gr[64 * j]; v2u o; o.x = pkh(v[j].x * r * gg.x, v[j].y * r * gg.y); o.y = pkh(v[j].z * r * gg.z, v[j].w * r * gg.w); o8[64 * j] = o; }
}
__device__ __forceinline__ void p0_prologue(Frame& F, const Params& P) {
    LAS float* scr = (LAS float*)(F.lds + RING_OFF + F.wave * 16384);
    const int gw = F.vcu * NWAVES + F.wave, NGW = F.G * NWAVES, lane = F.lane;
    f16s* Hn = (f16s*)(P.ws + WS_H);
    {   f32x4 va[8], vb[8];
        int it = gw;
        if (it < I_ALL) { TrDesc d = tr_desc(P, it); tr_load(d, lane, va);
            for (;;) { const int nx = it + NGW; TrDesc dn = d; const bool more = nx < I_ALL;
                if (more) { dn = tr_desc(P, nx); tr_load(dn, lane, vb); }
                tr_store(d, lane, va, scr);
                if (!more) break;
#pragma unroll
                for (int i = 0; i < 8; ++i) va[i] = vb[i];
                d = dn; it = nx; } }
    }
    {   f32x4 va[8], vb[8];
        int m = gw;
        if (m < M) { rms_load(P.x + (size_t)m * DM, lane, va);
            for (;;) { const int nx = m + NGW; const bool more = nx < M;
                if (more) rms_load(P.x + (size_t)nx * DM, lane, vb);
                rms_store(va, P.norm_g, Hn + (size_t)m * DM, lane);
                if (!more) break;
#pragma unroll
                for (int i = 0; i < 8; ++i) va[i] = vb[i];
                m = nx; } }
    }
}

__device__ __forceinline__ void p2_gates_naive(Frame& F, const Params& P) {
    const f16s* proj = (const f16s*)(P.ws + WS_PROJ); float* abuf = (float*)(P.ws + WS_A); float* bbuf = (float*)(P.ws + WS_B);
    LAS float* xs = (LAS float*)(F.lds + RING_OFF);
    const int tid = F.tid;
    for (int it = F.vcu; it < (M / 16) * LRU_BLK; it += F.G) {
        const int rt = it >> 3, g = it & 7, r0 = rt * 16;
#pragma unroll
        for (int i = 0; i < 4; ++i) { const int e = tid + NT * i, r = e >> 7, c = e & 127, row = r0 + r, t = row & (SEQ - 1), ch = g * 128 + c;
            float v = P.conv_b[ch];
#pragma unroll
            for (int j = 0; j < 4; ++j) { const int tt = t - 3 + j; if (tt >= 0) v += h2f(proj[(size_t)(row - 3 + j) * NINP + C_XA + ch]) * P.conv_w[j * LRU_W + ch]; }
            xs[r * 128 + c] = v; }
        __syncthreads();
        const int j = tid & 127, rh = tid >> 7;
        float ar[4] = {0.f, 0.f, 0.f, 0.f}, ai[4] = {0.f, 0.f, 0.f, 0.f};
        const float* wag = P.wa + (size_t)g * 128 * 128; const float* wxg = P.wx + (size_t)g * 128 * 128;
        for (int i = 0; i < 128; ++i) { const float w1 = wag[i * 128 + j], w2 = wxg[i * 128 + j];
#pragma unroll
            for (int r = 0; r < 4; ++r) { const float xv = xs[(rh * 4 + r) * 128 + i]; ar[r] += xv * w1; ai[r] += xv * w2; } }
        const int ch = g * 128 + j; const float sp = log1pf(expf(-P.lam[ch])), bav = P.ba[ch], bxv = P.bx[ch];
#pragma unroll
        for (int r = 0; r < 4; ++r) { const int row = r0 + rh * 4 + r, t = row & (SEQ - 1);
            const float rg = sigmoidf_(ar[r] + bav), ig = sigmoidf_(ai[r] + bxv), la = -8.f * rg * sp, a = expf(la);
            float mult = sqrtf(-expm1f(2.f * la)); if (t == 0) mult = 1.f;
            abuf[(size_t)row * LRU_W + ch] = a; bbuf[(size_t)row * LRU_W + ch] = mult * (ig * xs[(rh * 4 + r) * 128 + j]); }
        __syncthreads();
    }
}
__device__ __forceinline__ void p2_qabs_naive(Frame& F, const Params& P) {
    const f16s* proj = (const f16s*)(P.ws + WS_PROJ); f16s* qabs = (f16s*)(P.ws + WS_QABS);
    LAS float* qs = (LAS float*)(F.lds + RING_OFF);
    const int tid = F.tid;
    for (int it = F.vcu; it < (M / 16) * NH; it += F.G) {
        const int rt = it >> 3, h = it & 7, r0 = rt * 16;
#pragma unroll
        for (int i = 0; i < 4; ++i) { const int e = tid + NT * i, r = e >> 7, c = e & 127; qs[r * 128 + c] = h2f(proj[(size_t)(r0 + r) * NINP + C_Q + h * HD + c]); }
        __syncthreads();
        const int c = tid & 255, rh = tid >> 8;
        float acc[8];
#pragma unroll
        for (int r = 0; r < 8; ++r) acc[r] = 0.f;
        const float* wk = P.w_uk + (size_t)h * HD * CL + c;
        for (int d = 0; d < HD; ++d) { const float w = wk[(size_t)d * CL];
#pragma unroll
            for (int r = 0; r < 8; ++r) acc[r] += qs[(rh * 8 + r) * 128 + d] * w; }
#pragma unroll
        for (int r = 0; r < 8; ++r) qabs[(size_t)(r0 + rh * 8 + r) * (NH * CL) + h * CL + c] = __builtin_bit_cast(f16s, (f16)acc[r]);
        __syncthreads();
    }
}
__device__ __forceinline__ void p2_qabs_mfma(Frame& F, const Params& P) {
    const f16s* proj = (const f16s*)(P.ws + WS_PROJ); f16s* qabs = (f16s*)(P.ws + WS_QABS);
    int lane = F.lane; asm volatile("" : "+v"(lane));
    const int q = lane >> 4, fr = lane & 15, gw = F.vcu * NWAVES + F.wave, NGW = F.G * NWAVES, role = gw & 15, h = role >> 1, nh = role & 1;
    h8 W[8][4];
    { const f16s* wp = (const f16s*)(P.ws + WS_WUKT) + ((size_t)h * CL + nh * 128 + fr) * HD + 8 * q;
#pragma unroll
      for (int nt = 0; nt < 8; ++nt)
#pragma unroll
          for (int ks = 0; ks < 4; ++ks) W[nt][ks] = *(const GAS h8*)(wp + (size_t)nt * 16 * HD + 32 * ks); }
    const f32x4 zero4 = {0.f, 0.f, 0.f, 0.f};
    for (int rt = gw >> 4; rt < M / 16; rt += NGW >> 4) {
        const int row = rt * 16 + fr;
        h8 B[4];
        { const f16s* qp = proj + (size_t)row * NINP + C_Q + h * HD + 8 * q;
#pragma unroll
          for (int ks = 0; ks < 4; ++ks) B[ks] = *(const GAS h8*)(qp + 32 * ks); }
        f16s* op = qabs + (size_t)row * (NH * CL) + h * CL + nh * 128 + 4 * q;
#pragma unroll
        for (int nt = 0; nt < 8; ++nt) { f32x4 acc = zero4;
#pragma unroll
            for (int ks = 0; ks < 4; ++ks) acc = __builtin_amdgcn_mfma_f32_16x16x32_f16(W[nt][ks], B[ks], acc, 0, 0, 0);
            v2u o; o.x = pkh(acc[0], acc[1]); o.y = pkh(acc[2], acc[3]); *(GAS v2u*)(op + 16 * nt) = o; }
    }
}
__device__ __forceinline__ void p2_gates_mfma(Frame& F, const Params& P) {
    const f16s* proj = (const f16s*)(P.ws + WS_PROJ); float* abuf = (float*)(P.ws + WS_A); float* bbuf = (float*)(P.ws + WS_B);
    LAS float* CW = (LAS float*)(F.lds + RING_OFF);
    LAS float* CB = CW + 4 * LRU_W; LAS float* NSP = CB + LRU_W; LAS float* BA = NSP + LRU_W; LAS float* BX = BA + LRU_W;
    for (int e = F.tid; e < 4 * LRU_W; e += NT) CW[e] = P.conv_w[e];
    for (int e = F.tid; e < LRU_W; e += NT) { CB[e] = P.conv_b[e]; NSP[e] = -8.f * log1pf(expf(-P.lam[e])); BA[e] = P.ba[e]; BX[e] = P.bx[e]; }
    __syncthreads();
    int lane = F.lane; asm volatile("" : "+v"(lane));
    const int q = lane >> 4, fr = lane & 15, gw = F.vcu * NWAVES + F.wave, NGW = F.G * NWAVES, role = gw & 31, g = role >> 2, nq = role & 3;
    h8 WA[2][4], WX[2][4];
    { const size_t wo = ((size_t)g * LRU_BD + nq * 32 + fr) * LRU_BD + 8 * q; const f16s* wap = (const f16s*)(P.ws + WS_WAT) + wo; const f16s* wxp = (const f16s*)(P.ws + WS_WXT) + wo;
#pragma unroll
      for (int nt = 0; nt < 2; ++nt)
#pragma unroll
          for (int ks = 0; ks < 4; ++ks) { WA[nt][ks] = *(const GAS h8*)(wap + (size_t)nt * 16 * LRU_BD + 32 * ks); WX[nt][ks] = *(const GAS h8*)(wxp + (size_t)nt * 16 * LRU_BD + 32 * ks); } }
    const f32x4 zero4 = {0.f, 0.f, 0.f, 0.f};
    for (int rt = gw >> 5; rt < M / 16; rt += NGW >> 5) {
        const int row = rt * 16 + fr, t = row & (SEQ - 1);
        h8 XB[4];
#pragma unroll
        for (int ks = 0; ks < 4; ++ks) { const int c0 = g * 128 + 32 * ks + 8 * q;
            float v[8];
            { const f32x4 b0 = *(const LAS f32x4*)(CB + c0), b1 = *(const LAS f32x4*)(CB + c0 + 4); v[0] = b0[0]; v[1] = b0[1]; v[2] = b0[2]; v[3] = b0[3]; v[4] = b1[0]; v[5] = b1[1]; v[6] = b1[2]; v[7] = b1[3]; }
#pragma unroll
            for (int j = 0; j < 4; ++j) { if (t - 3 + j >= 0) { const h8 xv = *(const GAS h8*)(proj + (size_t)(row - 3 + j) * NINP + C_XA + c0);
                    const f32x4 w0 = *(const LAS f32x4*)(CW + j * LRU_W + c0), w1 = *(const LAS f32x4*)(CW + j * LRU_W + c0 + 4);
#pragma unroll
                    for (int e = 0; e < 4; ++e) { v[e] += (float)xv[e] * w0[e]; v[4 + e] += (float)xv[4 + e] * w1[e]; } } }
#pragma unroll
            for (int e = 0; e < 8; ++e) XB[ks][e] = (f16)v[e];
            asm volatile("" : "+v"(XB[ks])); }
#pragma unroll
        for (int nt = 0; nt < 2; ++nt) { f32x4 ar = zero4, ai = zero4;
#pragma unroll
            for (int ks = 0; ks < 4; ++ks) { ar = __builtin_amdgcn_mfma_f32_16x16x32_f16(WA[nt][ks], XB[ks], ar, 0, 0, 0); ai = __builtin_amdgcn_mfma_f32_16x16x32_f16(WX[nt][ks], XB[ks], ai, 0, 0, 0); }
            const int ch = g * 128 + nq * 32 + 16 * nt + 4 * q;
            f32x4 xc = *(const LAS f32x4*)(CB + ch);
#pragma unroll
            for (int j = 0; j < 4; ++j) { if (t - 3 + j >= 0) { const h4 xv = *(const GAS h4*)(proj + (size_t)(row - 3 + j) * NINP + C_XA + ch); const f32x4 w0 = *(const LAS f32x4*)(CW + j * LRU_W + ch);
#pragma unroll
                    for (int e = 0; e < 4; ++e) xc[e] += (float)xv[e] * w0[e]; } }
            const f32x4 nsp = *(const LAS f32x4*)(NSP + ch), bav = *(const LAS f32x4*)(BA + ch), bxv = *(const LAS f32x4*)(BX + ch);
            f32x4 av, bv;
#pragma unroll
            for (int e = 0; e < 4; ++e) { const float rg = sigmoidf_(ar[e] + bav[e]), ig = sigmoidf_(ai[e] + bxv[e]), a = __expf(rg * nsp[e]);
                float mult = __builtin_amdgcn_sqrtf(fmaxf(1.f - a * a, 0.f)); if (t == 0) mult = 1.f;
                av[e] = a; bv[e] = mult * (ig * xc[e]); }
            *(GAS f32x4*)(abuf + (size_t)row * LRU_W + ch) = av; *(GAS f32x4*)(bbuf + (size_t)row * LRU_W + ch) = bv; }
    }
    __syncthreads();
}
__device__ __forceinline__ void p2_norms(Frame& F, const Params& P) {
    const f16s* proj = (const f16s*)(P.ws + WS_PROJ); f16s* cn = (f16s*)(P.ws + WS_CN); f16s* kn = (f16s*)(P.ws + WS_KN);
    const int gw = F.vcu * NWAVES + F.wave, NGW = F.G * NWAVES, lane = F.lane;
    for (int row = gw; row < M; row += NGW) {
        const h4 cv = *(const GAS h4*)(proj + (size_t)row * NINP + C_CKV + 4 * lane);
        const float c0 = (float)cv[0], c1 = (float)cv[1], c2 = (float)cv[2], c3 = (float)cv[3];
        const float r = rsqrtf(wave_sum(c0 * c0 + c1 * c1 + c2 * c2 + c3 * c3) * (1.f / CL) + EPS);
        const f32x4 g = *(const GAS f32x4*)(P.ckv_g + 4 * lane);
        v2u o; o.x = pkh(c0 * r * g.x, c1 * r * g.y); o.y = pkh(c2 * r * g.z, c3 * r * g.w);
        *(GAS v2u*)(cn + (size_t)row * CL + 4 * lane) = o;
        const float kv = h2f(proj[(size_t)row * NINP + C_KI + lane]);
        const float mu = wave_sum(kv) * (1.f / ID), d = kv - mu, var = wave_sum(d * d) * (1.f / ID);
        kn[(size_t)row * ID + lane] = __builtin_bit_cast(f16s, (f16)(d * rsqrtf(var + EPS) * P.ikg[lane] + P.ikb[lane]));
    }
}

__device__ __forceinline__ void p3_scanA(Frame& F, const Params& P) {
    const float* abuf = (const float*)(P.ws + WS_A); const float* bbuf = (const float*)(P.ws + WS_B); float* agg = (float*)(P.ws + WS_AGG);
    const int gw = F.vcu * NWAVES + F.wave, NGW = F.G * NWAVES;
    for (int it = gw; it < BATCH * 16 * 32; it += NGW) {
        const int b = it >> 9, cg = (it >> 5) & 15, ck = it & 31, ch = cg * 64 + F.lane; const size_t r0 = (size_t)b * SEQ + ck * 64;
        float A = 1.f, H = 0.f;
#pragma unroll 16
        for (int s = 0; s < 64; ++s) { const float a = abuf[(r0 + s) * LRU_W + ch], bb = bbuf[(r0 + s) * LRU_W + ch]; H = a * H + bb; A *= a; }
        agg[((size_t)(b * 32 + ck) * 2 + 0) * LRU_W + ch] = A; agg[((size_t)(b * 32 + ck) * 2 + 1) * LRU_W + ch] = H;
    }
}
__device__ __forceinline__ void p3_scanB(Frame& F, const Params& P) {
    const float* abuf = (const float*)(P.ws + WS_A); const float* bbuf = (const float*)(P.ws + WS_B); const float* agg = (const float*)(P.ws + WS_AGG);
    const f16s* proj = (const f16s*)(P.ws + WS_PROJ); f16s* y = (f16s*)(P.ws + WS_H);
    const int gw = F.vcu * NWAVES + F.wave, NGW = F.G * NWAVES;
    for (int it = gw; it < BATCH * 16 * 32; it += NGW) {
        const int b = it >> 9, cg = (it >> 5) & 15, ck = it & 31, ch = cg * 64 + F.lane; const size_t r0 = (size_t)b * SEQ + ck * 64;
        float h = 0.f;
        for (int k = 0; k < ck; ++k) h = agg[((size_t)(b * 32 + k) * 2 + 0) * LRU_W + ch] * h + agg[((size_t)(b * 32 + k) * 2 + 1) * LRU_W + ch];
#pragma unroll 16
        for (int s = 0; s < 64; ++s) { h = abuf[(r0 + s) * LRU_W + ch] * h + bbuf[(r0 + s) * LRU_W + ch];
            y[(r0 + s) * DM + ch] = __builtin_bit_cast(f16s, (f16)(h * siluf_(h2f(proj[(r0 + s) * NINP + C_GA + ch])))); }
    }
}
constexpr int AF_OFF = 0;
constexpr int TAB_OFF = RING_BYTES + 1024;
constexpr int IL_OFF = TAB_OFF;
constexpr int SGT_OFF = IL_OFF + 8192;
constexpr int CNT_OFF = SGT_OFF + 1024;
constexpr int WCNT_OFF = CNT_OFF + 128;
constexpr int CNTQ_OFF = WCNT_OFF + 256;
constexpr int BIAS_OFF = CNTQ_OFF + 64;
constexpr int TAB_END = BIAS_OFF + 4224;
static_assert(TAB_END <= LDS_BYTES, "LDS map");
typedef short v4i16 __attribute__((ext_vector_type(4)));
typedef _Float16 h4v __attribute__((ext_vector_type(4)));

__device__ __forceinline__ unsigned fkey(float f) { const unsigned u = __float_as_uint(f); return (u & 0x80000000u) ? ~u : (u | 0x80000000u); }
__device__ __forceinline__ unsigned rowsum16(unsigned v) { v += __shfl_xor(v, 1); v += __shfl_xor(v, 2); v += __shfl_xor(v, 4); v += __shfl_xor(v, 8); return v; }

__device__ __forceinline__ void p3_d1(Frame& F, const Params& P, int b, int i) {
    const f16s* proj = (const f16s*)(P.ws + WS_PROJ); const f16s* kn = (const f16s*)(P.ws + WS_KN);
    int tid = F.tid; asm volatile("" : "+v"(tid));
    const int lane = tid & 63, wave = F.wave, q = lane >> 4, fr = lane & 15;
    const int row0 = b * SEQ + 16 * i, ntile = i + 1;
    LAS unsigned char* AF = F.lds + AF_OFF;
    LAS float* SGT = (LAS float*)(F.lds + SGT_OFF);
    LAS unsigned* CNT = (LAS unsigned*)(F.lds + CNT_OFF);
    LAS unsigned* WCNT = (LAS unsigned*)(F.lds + WCNT_OFF);
    LAS unsigned* CNTQ = (LAS unsigned*)(F.lds + CNTQ_OFF);
    LAS unsigned short* IL = (LAS unsigned short*)(F.lds + IL_OFF);
#pragma unroll
    for (int e = 0; e < 4; ++e) { const int f = tid + NT * e, h = f >> 7, ks = (f >> 6) & 1, ln = f & 63, r = ln & 15, kq = ln >> 4;
        const f16s* rowp = proj + (size_t)(row0 + r) * NINP;
        const h8 v = *(const GAS h8*)(rowp + C_QI + h * 64 + 32 * ks + 8 * kq); const float w = fabsf(h2f(rowp[C_WI + h]));
        h8 o;
#pragma unroll
        for (int j = 0; j < 8; ++j) o[j] = (f16)((float)v[j] * w);
        *(LAS h8*)(AF + (h * 2 + ks) * 1024 + ln * 16) = o; }
    if (tid < 128) { const int ks = tid >> 6, ln = tid & 63, r = ln & 15, kq = ln >> 4; const f16s* rowp = proj + (size_t)(row0 + r) * NINP;
        float acc[8];
#pragma unroll
        for (int j = 0; j < 8; ++j) acc[j] = 0.f;
        for (int h = 0; h < IH; ++h) { const h8 v = *(const GAS h8*)(rowp + C_QI + h * 64 + 32 * ks + 8 * kq); const float w = h2f(rowp[C_WI + h]);
#pragma unroll
            for (int j = 0; j < 8; ++j) acc[j] += (float)v[j] * w; }
        h8 o;
#pragma unroll
        for (int j = 0; j < 8; ++j) o[j] = (f16)acc[j];
        *(LAS h8*)(AF + (32 + ks) * 1024 + ln * 16) = o; }
    if (tid < 256) { const int r = tid >> 4, h = tid & 15; SGT[h * 16 + r] = h2f(proj[(size_t)(row0 + r) * NINP + C_WI + h]) >= 0.f ? 1.f : -1.f; }
    if (tid < 24) CNT[tid] = 0u;
    __syncthreads();
    unsigned key[16][4];
    const f32x4 zero4 = {0.f, 0.f, 0.f, 0.f};
#pragma unroll
    for (int p = 0; p < 4; ++p) {
        f32x4 sc[4] = {zero4, zero4, zero4, zero4};
        if (wave + 32 * p < ntile) {
            h8 bk[4][2];
#pragma unroll
            for (int jj = 0; jj < 4; ++jj) { int kt = wave + 8 * (4 * p + jj); kt = kt < ntile ? kt : ntile - 1;
                const f16s* kr = kn + ((size_t)b * SEQ + 16 * kt + fr) * ID + 8 * q; bk[jj][0] = *(const GAS h8*)kr; bk[jj][1] = *(const GAS h8*)(kr + 32); }
            h8 a0 = *(const LAS h8*)(AF + lane * 16), a1 = *(const LAS h8*)(AF + 1024 + lane * 16);
            f32x4 sg = *(const LAS f32x4*)(SGT + 4 * q);
#pragma unroll
            for (int h = 0; h <= IH; ++h) {
                h8 n0 = a0, n1 = a1; f32x4 ng = sg;
                if (h < IH) { n0 = *(const LAS h8*)(AF + (2 * h + 2) * 1024 + lane * 16); n1 = *(const LAS h8*)(AF + (2 * h + 3) * 1024 + lane * 16); if (h + 1 < IH) ng = *(const LAS f32x4*)(SGT + (h + 1) * 16 + 4 * q); }
#pragma unroll
                for (int jj = 0; jj < 4; ++jj) { f32x4 S = __builtin_amdgcn_mfma_f32_16x16x32_f16(a0, bk[jj][0], zero4, 0, 0, 0); S = __builtin_amdgcn_mfma_f32_16x16x32_f16(a1, bk[jj][1], S, 0, 0, 0);
                    if (h < IH) {
#pragma unroll
                        for (int e = 0; e < 4; ++e) sc[jj][e] = __builtin_fmaf(__builtin_fabsf(S[e]), sg[e], sc[jj][e]);
                    } else sc[jj] += S; }
                asm volatile("" : "+v"(sc[0]), "+v"(sc[1]), "+v"(sc[2]), "+v"(sc[3]));
                __builtin_amdgcn_sched_barrier(0);
                a0 = n0; a1 = n1; sg = ng;
            }
            __builtin_amdgcn_sched_barrier(0);
        }
#pragma unroll
        for (int jj = 0; jj < 4; ++jj) { const int kt = wave + 8 * (4 * p + jj);
#pragma unroll
            for (int e = 0; e < 4; ++e) { const bool valid = (kt < i) || (kt == i && fr <= 4 * q + e); key[4 * p + jj][e] = valid ? fkey(sc[jj][e]) : 0u; } }
        __builtin_amdgcn_sched_barrier(0);
    }
    unsigned lo[4], hi[4], thr[4]; bool dn[4];
#pragma unroll
    for (int e = 0; e < 4; ++e) { dn[e] = (16 * i + 4 * q + e + 1) <= TOPK; thr[e] = 1u; lo[e] = 0u; hi[e] = 0xFFFFFFFFu; }
    for (int it = 0; it < 40; ++it) {
        if (__all(dn[0] && dn[1] && dn[2] && dn[3])) break;
        unsigned mid[4];
#pragma unroll
        for (int e = 0; e < 4; ++e) { const unsigned d = hi[e] - lo[e]; mid[e] = lo[e] + (d >> 1) + (d & 1u); }
        unsigned c01 = 0u, c23 = 0u;
#pragma unroll
        for (int j = 0; j < 16; ++j) { c01 += (key[j][0] >= mid[0] ? 1u : 0u) + (key[j][1] >= mid[1] ? 0x10000u : 0u); c23 += (key[j][2] >= mid[2] ? 1u : 0u) + (key[j][3] >= mid[3] ? 0x10000u : 0u); }
        c01 = rowsum16(c01); c23 = rowsum16(c23);
        LAS unsigned* C = CNT + (it % 3) * 8;
        if (fr == 0) { __hip_atomic_fetch_add(&C[2 * q], c01, __ATOMIC_RELAXED, __HIP_MEMORY_SCOPE_WORKGROUP); __hip_atomic_fetch_add(&C[2 * q + 1], c23, __ATOMIC_RELAXED, __HIP_MEMORY_SCOPE_WORKGROUP); }
        if (tid < 8) CNT[((it + 1) % 3) * 8 + tid] = 0u;
        __syncthreads();
        const unsigned cc01 = C[2 * q], cc23 = C[2 * q + 1];
        const unsigned cnt[4] = {cc01 & 0xFFFFu, cc01 >> 16, cc23 & 0xFFFFu, cc23 >> 16};
#pragma unroll
        for (int e = 0; e < 4; ++e) if (!dn[e]) {
            if (cnt[e] == (unsigned)TOPK) { thr[e] = mid[e]; dn[e] = true; }
            else { if (cnt[e] > (unsigned)TOPK) lo[e] = mid[e]; else hi[e] = mid[e] - 1u; if (lo[e] == hi[e]) { thr[e] = lo[e]; dn[e] = true; } } }
    }
    {
        unsigned c01 = 0u, c23 = 0u;
#pragma unroll
        for (int j = 0; j < 16; ++j) { c01 += (key[j][0] >= thr[0] ? 1u : 0u) + (key[j][1] >= thr[1] ? 0x10000u : 0u); c23 += (key[j][2] >= thr[2] ? 1u : 0u) + (key[j][3] >= thr[3] ? 0x10000u : 0u); }
        c01 = rowsum16(c01); c23 = rowsum16(c23);
        if (fr == 0) { WCNT[wave * 8 + 2 * q] = c01; WCNT[wave * 8 + 2 * q + 1] = c23; }
        __syncthreads();
        unsigned b01 = 0u, b23 = 0u, t01 = 0u, t23 = 0u;
#pragma unroll
        for (int w = 0; w < NWAVES; ++w) { const unsigned x01 = WCNT[w * 8 + 2 * q], x23 = WCNT[w * 8 + 2 * q + 1]; t01 += x01; t23 += x23; if (w < wave) { b01 += x01; b23 += x23; } }
        unsigned base[4] = {b01 & 0xFFFFu, b01 >> 16, b23 & 0xFFFFu, b23 >> 16};
        if (wave == 0 && fr == 0) { const unsigned tot[4] = {t01 & 0xFFFFu, t01 >> 16, t23 & 0xFFFFu, t23 >> 16};
#pragma unroll
            for (int e = 0; e < 4; ++e) CNTQ[4 * q + e] = tot[e] < (unsigned)TOPK ? tot[e] : (unsigned)TOPK; }
        const unsigned ltmask = (1u << fr) - 1u;
#pragma unroll
        for (int j = 0; j < 16; ++j)
#pragma unroll
            for (int e = 0; e < 4; ++e) { const bool sel = key[j][e] >= thr[e];
                const unsigned long long m = __ballot(sel); const unsigned sub = (unsigned)(m >> (16 * q)) & 0xFFFFu;
                const unsigned pos = base[e] + __builtin_popcount(sub & ltmask);
                if (sel && pos < (unsigned)TOPK) IL[(4 * q + e) * TOPK + pos] = (unsigned short)(16 * (wave + 8 * j) + fr);
                base[e] += __builtin_popcount(sub); }
    }
    __syncthreads();
}

__device__ __forceinline__ void attn_query_naive(Frame& F, const Params& P, int row, const LAS unsigned short* il, int cnt) {
    const f16s* proj = (const f16s*)(P.ws + WS_PROJ); const f16s* cn = (const f16s*)(P.ws + WS_CN);
    const f16s* qabs = (const f16s*)(P.ws + WS_QABS); f16s* y = (f16s*)(P.ws + WS_H);
    LAS float* qa = (LAS float*)(F.lds + 40960);
    LAS float* lg = qa + 2048;
    LAS float* os = lg + 2048;
    int tid = F.tid; asm volatile("" : "+v"(tid));
    const int lane = tid & 63, wave = F.wave;
    const int b = row >> 11, t = row & (SEQ - 1);
#pragma unroll
    for (int k = 0; k < 4; ++k) qa[tid + NT * k] = h2f(qabs[(size_t)row * (NH * CL) + tid + NT * k]);
    __syncthreads();
    {   const int j = tid & 255, hh = tid >> 8, s = j < cnt ? (int)il[j] : -1;
        float l[4] = {0.f, 0.f, 0.f, 0.f};
        if (s >= 0) {
            const GAS h8* cr = (const GAS h8*)(cn + ((size_t)b * SEQ + s) * CL);
            for (int c8 = 0; c8 < CL / 8; ++c8) { const h8 v = cr[c8];
#pragma unroll
                for (int e = 0; e < 8; ++e) { const float cv = (float)v[e];
#pragma unroll
                    for (int h = 0; h < 4; ++h) l[h] += qa[(hh * 4 + h) * CL + c8 * 8 + e] * cv; } }
            const int dist = t - s, bk = dist < 128 ? (int)BUCKET[dist] : 31;
#pragma unroll
            for (int h = 0; h < 4; ++h) l[h] = l[h] * 0.08838834764831845f + P.rel_bias[bk * NH + hh * 4 + h];
        } else {
#pragma unroll
            for (int h = 0; h < 4; ++h) l[h] = -INFINITY;
        }
#pragma unroll
        for (int h = 0; h < 4; ++h) lg[(hh * 4 + h) * TOPK + j] = l[h];
    }
    __syncthreads();
    {   float v[4], mx = -INFINITY;
#pragma unroll
        for (int k = 0; k < 4; ++k) { v[k] = lg[wave * TOPK + lane + 64 * k]; mx = fmaxf(mx, v[k]); }
        mx = wave_max(mx);
        float sm = 0.f;
#pragma unroll
        for (int k = 0; k < 4; ++k) { v[k] = expf(v[k] - mx); sm += v[k]; }
        const float inv = 1.f / wave_sum(sm);
#pragma unroll
        for (int k = 0; k < 4; ++k) lg[wave * TOPK + lane + 64 * k] = v[k] * inv;
    }
    __syncthreads();
    {   const int c = tid & 255, hh = tid >> 8;
        float o[4] = {0.f, 0.f, 0.f, 0.f};
        for (int j = 0; j < cnt; ++j) { const int s = il[j];
            const float cv = h2f(cn[((size_t)b * SEQ + s) * CL + c]);
#pragma unroll
            for (int h = 0; h < 4; ++h) o[h] += lg[(hh * 4 + h) * TOPK + j] * cv; }
#pragma unroll
        for (int h = 0; h < 4; ++h) os[(hh * 4 + h) * CL + c] = o[h];
    }
    __syncthreads();
#pragma unroll
    for (int k = 0; k < 2; ++k) { const int h = k * 4 + (tid >> 7), d = tid & 127;
        const float* wv = P.w_uv + (size_t)h * CL * HD + d; float acc = 0.f;
        for (int c = 0; c < CL; ++c) acc += os[h * CL + c] * wv[(size_t)c * HD];
        const float gb = h2f(proj[(size_t)row * NINP + C_GB + h * HD + d]);
        y[(size_t)row * DM + LRU_W + h * HD + d] = __builtin_bit_cast(f16s, (f16)(acc * siluf_(gb))); }
    __syncthreads();
}


__device__ __forceinline__ void glds16(const void* gsrc, unsigned lds_dst) { unsigned keep;
    asm volatile("s_mov_b32 %0, m0\n\ts_mov_b32 m0, %2\n\ts_nop 0\n\tglobal_load_lds_dwordx4 %1, off\n\ts_mov_b32 m0, %0" : "=&s"(keep) : "v"(gsrc), "s"(lds_dst) : "memory"); }
__device__ __forceinline__ void p3_d2_query(const Params& P, LAS unsigned char* lds, LAS unsigned char* buf, int lane, int b, int t, int row, int r) {
    const f16s* cn = (const f16s*)(P.ws + WS_CN); const f16s* qabs = (const f16s*)(P.ws + WS_QABS); f16s* obuf = (f16s*)P.out;
    const LAS unsigned short* il = (const LAS unsigned short*)(lds + IL_OFF) + r * TOPK;
    const LAS float* BIAS = (const LAS float*)(lds + BIAS_OFF);
    const int cnt = (int)((const LAS unsigned*)(lds + CNTQ_OFF))[r];
    const int q = lane >> 4, fr = lane & 15;
    h8 qb[8];
    { const f16s* qp = qabs + (size_t)row * (NH * CL) + (fr & 7) * CL + 8 * q;
#pragma unroll
      for (int ks = 0; ks < 8; ++ks) qb[ks] = *(const GAS h8*)(qp + 32 * ks); }
    asm volatile("" :: "v"(qb[0]), "v"(qb[1]), "v"(qb[2]), "v"(qb[3]), "v"(qb[4]), "v"(qb[5]), "v"(qb[6]), "v"(qb[7]));
    const int cp = lane & 15;
    const char* cnb = (const char*)(cn + (size_t)b * SEQ * CL);
    const unsigned bufaddr = (unsigned)__builtin_amdgcn_readfirstlane((int)(unsigned)(size_t)buf);
    const int sw16 = 16 * (cp ^ (q << 2));
    auto issue = [&](int c) {
        const unsigned dst = bufaddr + (unsigned)(c & 1) * 8192u;
#pragma unroll
        for (int kq = 0; kq < 4; ++kq) { int pos = 16 * c + 4 * kq + q; pos = pos < cnt ? pos : 0;
            const int key = il[pos];
            const char* src = cnb + (size_t)key * (CL * 2) + (sw16 ^ (16 * kq));
#if OPT_DMA_ASM
            glds16(src, dst + kq * 1024); glds16(src + 256, dst + 4096 + kq * 1024); }
#else
            __builtin_amdgcn_global_load_lds((const unsigned*)src, (LAS unsigned*)(buf + (c & 1) * 8192 + kq * 1024), 16, 0, 0);
            __builtin_amdgcn_global_load_lds((const unsigned*)(src + 256), (LAS unsigned*)(buf + (c & 1) * 8192 + 4096 + kq * 1024), 16, 0, 0); }
#endif
    };
    int roff[4];
#pragma unroll
    for (int s = 0; s < 4; ++s) roff[s] = 256 * fr + 64 * (s ^ (fr & 3)) + 16 * (q ^ ((fr >> 2) & 3));
    const int qq = fr >> 2, pp = fr & 3;
    const int trb = 256 * (4 * q + qq) + 16 * ((((pp >> 1) ^ (q & 1)) | (q & 2)) ^ (qq << 2)) + 8 * (pp & 1);
    f32x4 Y[16];
    const f32x4 zero4 = {0.f, 0.f, 0.f, 0.f};
#pragma unroll
    for (int ct = 0; ct < 16; ++ct) Y[ct] = zero4;
    float m = -INFINITY, ssum = 0.f;
    issue(0);
    for (int c = 0; c < 16; ++c) {
        if (c + 1 < 16) { issue(c + 1); asm volatile("s_waitcnt vmcnt(8)" ::: "memory"); }
        else asm volatile("s_waitcnt vmcnt(0)" ::: "memory");
        const LAS unsigned char* bb = buf + (c & 1) * 8192;
        f32x4 X = zero4;
#pragma unroll
        for (int s = 0; s < 8; ++s) { const h8 a = *(const LAS h8*)(bb + (s >> 2) * 4096 + roff[s & 3]); X = __builtin_amdgcn_mfma_f32_16x16x32_f16(a, qb[s], X, 0, 0, 0); }
        float l[4];
        { const v4i16 kk = *(const LAS v4i16*)(il + 16 * c + 4 * q);
#pragma unroll
          for (int e = 0; e < 4; ++e) { const int pos = 16 * c + 4 * q + e; int d = t - (int)(unsigned short)kk[e]; d = d < 0 ? 0 : (d > 128 ? 128 : d);
              const float bs = BIAS[d * 8 + (fr & 7)]; l[e] = pos < cnt ? X[e] * 0.08838834764831845f + bs : -INFINITY; } }
        float mx = fmaxf(fmaxf(l[0], l[1]), fmaxf(l[2], l[3]));
        mx = fmaxf(mx, __shfl_xor(mx, 16)); mx = fmaxf(mx, __shfl_xor(mx, 32));
        if (c == 0) m = mx;
        else if (__any(mx > m + 8.f)) { const float mn = fmaxf(m, mx), al = __expf(m - mn);
#pragma unroll
            for (int ct = 0; ct < 16; ++ct) Y[ct] *= al;
            ssum *= al; m = mn; }
        float p[4];
#pragma unroll
        for (int e = 0; e < 4; ++e) { p[e] = __expf(l[e] - m); ssum += p[e]; }
        h8 pb;
#pragma unroll
        for (int e = 0; e < 4; ++e) { pb[e] = (f16)p[e]; pb[4 + e] = (f16)0.f; }
#pragma unroll
        for (int ct = 0; ct < 16; ++ct) {
            const v4i16 tv = __builtin_amdgcn_ds_read_tr16_b64_v4i16((LAS v4i16*)(bb + (ct >> 3) * 4096 + (trb ^ (32 * (ct & 7)))));
            const h4v th = __builtin_bit_cast(h4v, tv);
            const h8 a2 = __builtin_shufflevector(th, th, 0, 1, 2, 3, 0, 1, 2, 3);
            Y[ct] = __builtin_amdgcn_mfma_f32_16x16x32_f16(a2, pb, Y[ct], 0, 0, 0); }
    }
    ssum += __shfl_xor(ssum, 16); ssum += __shfl_xor(ssum, 32);
    const float inv = 1.f / ssum;
    if (fr < 8) { f16s* op = obuf + (size_t)row * (NH * CL) + fr * CL + 4 * q;
#pragma unroll
        for (int ct = 0; ct < 16; ++ct) { v2u o; o.x = pkh(Y[ct][0] * inv, Y[ct][1] * inv); o.y = pkh(Y[ct][2] * inv, Y[ct][3] * inv); *(GAS v2u*)(op + 16 * ct) = o; } }
}

__device__ __forceinline__ void p3_v_stream(Frame& F, const Params& P) {
    const f16s* obuf = (const f16s*)P.out; const f16s* proj = (const f16s*)(P.ws + WS_PROJ); f16s* y = (f16s*)(P.ws + WS_H);
    int lane = F.lane; asm volatile("" : "+v"(lane));
    const int q = lane >> 4, fr = lane & 15, gw = F.vcu * NWAVES + F.wave, NGW = F.G * NWAVES, role = gw & 15, h = role >> 1, nh = role & 1;
    h8 W[4][8];
    { const f16s* wp = (const f16s*)(P.ws + WS_WUVT) + ((size_t)h * HD + nh * 64 + fr) * CL + 8 * q;
#pragma unroll
      for (int nt = 0; nt < 4; ++nt)
#pragma unroll
          for (int ks = 0; ks < 8; ++ks) W[nt][ks] = *(const GAS h8*)(wp + (size_t)nt * 16 * CL + 32 * ks); }
    const f32x4 zero4 = {0.f, 0.f, 0.f, 0.f};
    h8 ob[8], on[8];
    int rt = gw >> 4; const int step = NGW >> 4;
    if (rt < M / 16) {
        { const f16s* op = obuf + (size_t)(rt * 16 + fr) * (NH * CL) + h * CL + 8 * q;
#pragma unroll
          for (int ks = 0; ks < 8; ++ks) ob[ks] = *(const GAS h8*)(op + 32 * ks); }
        for (;;) {
            const int nx = rt + step; const bool more = nx < M / 16;
            if (more) { const f16s* op = obuf + (size_t)(nx * 16 + fr) * (NH * CL) + h * CL + 8 * q;
#pragma unroll
                for (int ks = 0; ks < 8; ++ks) on[ks] = *(const GAS h8*)(op + 32 * ks); }
            const int row = rt * 16 + fr; const size_t col0 = (size_t)h * HD + nh * 64 + 4 * q;
            h4v g[4];
#pragma unroll
            for (int nt = 0; nt < 4; ++nt) g[nt] = *(const GAS h4v*)(proj + (size_t)row * NINP + C_GB + col0 + 16 * nt);
#pragma unroll
            for (int nt = 0; nt < 4; ++nt) { f32x4 acc = zero4;
#pragma unroll
                for (int ks = 0; ks < 8; ++ks) acc = __builtin_amdgcn_mfma_f32_16x16x32_f16(W[nt][ks], ob[ks], acc, 0, 0, 0);
                v2u o; o.x = pkh(acc[0] * siluf_((float)g[nt][0]), acc[1] * siluf_((float)g[nt][1])); o.y = pkh(acc[2] * siluf_((float)g[nt][2]), acc[3] * siluf_((float)g[nt][3]));
                *(GAS v2u*)(y + (size_t)row * DM + LRU_W + col0 + 16 * nt) = o; }
            if (!more) break;
#pragma unroll
            for (int ks = 0; ks < 8; ++ks) ob[ks] = on[ks];
            rt = nx;
        }
    }
}

__device__ __forceinline__ void p3_items(Frame& F, const Params& P) {
    {
        LAS float* BIAS = (LAS float*)(F.lds + BIAS_OFF);
        for (int e = F.tid; e < 129 * 8; e += NT) { const int d = e >> 3, h = e & 7; BIAS[e] = P.rel_bias[(d < 128 ? (int)BUCKET[d] : 31) * NH + h]; }
    }
    __syncthreads();
#ifndef PROBE_D
#define PROBE_D 0
#endif
    unsigned long long acc_[4] = {0ull, 0ull, 0ull, 0ull};
    for (int u = F.vcu; u < BATCH * (SEQ / 16); u += F.G) {
        const int up = u & 255, k = u >> 8, b = up >> 6, j = up & 63, i = k ? 127 - j : j;
        unsigned long long t0_ = PROBE_D ? __builtin_amdgcn_s_memrealtime() : 0ull;
        p3_d1(F, P, b, i);
        unsigned long long t1_ = PROBE_D ? __builtin_amdgcn_s_memrealtime() : 0ull;
        int lane = F.lane; asm volatile("" : "+v"(lane));
        LAS unsigned char* buf = F.lds + F.wave * 16384;
#pragma unroll 1
        for (int rr = 0; rr < 2; ++rr) { const int r = 2 * F.wave + rr; p3_d2_query(P, F.lds, buf, lane, b, 16 * i + r, b * SEQ + 16 * i + r, r); }
        asm volatile("s_waitcnt vmcnt(0)" ::: "memory");
        __syncthreads();
        unsigned long long t2_ = PROBE_D ? __builtin_amdgcn_s_memrealtime() : 0ull;
        unsigned long long t3_ = PROBE_D ? __builtin_amdgcn_s_memrealtime() : 0ull;
        acc_[1] += t1_ - t0_; acc_[2] += t2_ - t1_; acc_[3] += t3_ - t2_;
    }
    if (PROBE_D && PROBE_D < 4 && blockIdx.x == 0) { const unsigned long long t1 = __builtin_amdgcn_s_memrealtime(); while (__builtin_amdgcn_s_memrealtime() - t1 < acc_[PROBE_D]) __builtin_amdgcn_s_sleep(8); }
    if (PROBE_D >= 4 && F.tid == 0) { const unsigned tot = (unsigned)(acc_[1] + acc_[2] + acc_[3]), d1 = (unsigned)acc_[1], d2 = (unsigned)acc_[2];
        __hip_atomic_fetch_max((unsigned*)(F.ctl + 8), tot, __ATOMIC_RELAXED, __HIP_MEMORY_SCOPE_AGENT); __hip_atomic_fetch_add((unsigned*)(F.ctl + 9), tot, __ATOMIC_RELAXED, __HIP_MEMORY_SCOPE_AGENT);
        __hip_atomic_fetch_max((unsigned*)(F.ctl + 10), d1, __ATOMIC_RELAXED, __HIP_MEMORY_SCOPE_AGENT); __hip_atomic_fetch_max((unsigned*)(F.ctl + 11), d2, __ATOMIC_RELAXED, __HIP_MEMORY_SCOPE_AGENT);
        __hip_atomic_fetch_add((unsigned*)(F.ctl + 12), d1, __ATOMIC_RELAXED, __HIP_MEMORY_SCOPE_AGENT); __hip_atomic_fetch_add((unsigned*)(F.ctl + 13), d2, __ATOMIC_RELAXED, __HIP_MEMORY_SCOPE_AGENT); }
}

__device__ __forceinline__ void p5_final(Frame& F, const Params& P) {
    const int gw = F.vcu * NWAVES + F.wave, NGW = F.G * NWAVES, lane = F.lane;
    for (int m = gw; m < M; m += NGW) {
        GAS f32x4* xr = (GAS f32x4*)(P.out + (size_t)m * DM) + lane; const GAS f32x4* gr = (const GAS f32x4*)P.fin_g + lane;
        f32x4 v[8]; float s = 0.f;
#pragma unroll
        for (int j = 0; j < 8; ++j) { v[j] = xr[64 * j]; s += (v[j].x * v[j].x + v[j].y * v[j].y) + (v[j].z * v[j].z + v[j].w * v[j].w); }
        const float r = rsqrtf(wave_sum(s) * (1.f / DM) + EPS);
#pragma unroll
        for (int j = 0; j < 8; ++j) xr[64 * j] = v[j] * r * gr[64 * j];
    }
}

__global__ void __launch_bounds__(NT, 2) fwd_kernel(Params P) {
    extern __shared__ __attribute__((aligned(16))) unsigned char lds[];
    Frame F;
    F.lds = (LAS unsigned char*)lds;
    F.MISC = (volatile LAS unsigned*)(F.lds + MISC_OFF);
    F.tid = threadIdx.x; F.lane = F.tid & 63; F.wave = __builtin_amdgcn_readfirstlane(F.tid >> 6);
    F.G = gridDim.x; { const int bx = blockIdx.x; F.vcu = (F.G % 8 == 0) ? (bx % 8) * (F.G / 8) + bx / 8 : bx; }
    F.ctl = (gu32*)(P.ws + WS_CTL);
    for (int u = F.tid; u < (LDS_BYTES - LDSCTL_OFF) / 4; u += NT) ((LAS unsigned*)(F.lds + LDSCTL_OFF))[u] = 0u;
    __syncthreads();
    XcdBarrier bar = xcd_barrier_post((unsigned*)(F.ctl + CW_BAR), F.MISC + 8);
#ifdef PROBE_S
    for (int k_ = 0; k_ < 12; ++k_) F.pt_acc[k_] = 0u;
    F.pt_last = __builtin_amdgcn_s_memrealtime();
#endif

#ifndef PROBE_REP
#define PROBE_REP 0
#endif
#ifndef PROBE_T
#define PROBE_T 0
#endif
    unsigned long long ts_[8]; int nst_ = 0;
#define STAMP() do { if (PROBE_T) { ts_[nst_] = __builtin_amdgcn_s_memrealtime(); } ++nst_; } while (0)
    STAMP();
#if PROBE_REP == 0
#define REP(n)
#else
#define REP(n) for (int rep_ = 0; rep_ < ((PROBE_REP == (n)) ? 2 : 1); ++rep_)
#endif
    REP(1) { p0_prologue(F, P); xcd_barrier(bar); }
    STAMP();
#define P1_BLOCK { pg8::Gemm g{(const pg8::bf16_t*)(P.ws + WS_H), (const pg8::bf16_t*)(P.ws + WS_WIN), M, NINP, DM}; \
        pg8::StaticOrder S; S.init(M, NINP, F.G, (int)blockIdx.x); \
        pg8::EpiF16 E{(pg8::bf16_t*)(P.ws + WS_PROJ), NINP}; \
        pg8::gemm_phase<pg8::EpiF16, pg8::StaticOrder, true, true>(F.lds + RING_OFF, g, S, E); \
        xcd_barrier(bar); }
    P1_BLOCK
    STAMP();
#if PROBE_REP == 2
    P1_BLOCK
#endif
    REP(3) { PSTAMP(F, 11); p2_gates_mfma(F, P); PSTAMP(F, 0); p2_qabs_mfma(F, P); PSTAMP(F, 1); p2_norms(F, P); PSTAMP(F, 2); xcd_barrier(bar); PSTAMP(F, 11); }
    STAMP();
    REP(4) { p3_scanA(F, P); xcd_barrier(bar); p3_scanB(F, P); }
    STAMP();
    REP(5) { p3_items(F, P); xcd_barrier(bar); p3_v_stream(F, P); xcd_barrier(bar); }
    STAMP();
    REP(6) { const int rep6_ = 0;
        pg8::Gemm g{(const pg8::bf16_t*)(P.ws + WS_H), (const pg8::bf16_t*)(P.ws + WS_WOUT), M, DM, DM};
        pg8::StaticOrder S; S.init(M, DM, F.G, (int)blockIdx.x);
        pg8::EpiResF32 E{P.x, P.out, DM};
        pg8::gemm_phase<pg8::EpiResF32, pg8::StaticOrder, false, true>(F.lds + RING_OFF, g, S, E);
        xcd_barrier(bar);
        if (rep6_ == 0) STAMP();
        p5_final(F, P);
        if (PROBE_REP == 6) xcd_barrier(bar);
    }
#ifdef PROBE_S
    {   if (F.tid == 0) for (int k_ = 0; k_ < 11; ++k_) { __hip_atomic_fetch_max((unsigned*)(F.ctl + 32 + 2 * k_), F.pt_acc[k_], __ATOMIC_RELAXED, __HIP_MEMORY_SCOPE_AGENT); __hip_atomic_fetch_add((unsigned*)(F.ctl + 33 + 2 * k_), F.pt_acc[k_] >> 8, __ATOMIC_RELAXED, __HIP_MEMORY_SCOPE_AGENT); }
        xcd_barrier(bar);
        if (blockIdx.x == 0) { const unsigned v = __hip_atomic_load((unsigned*)(F.ctl + 32 + PROBE_S), RLX_AGENT);
            const unsigned long long t1 = __builtin_amdgcn_s_memrealtime(); while (__builtin_amdgcn_s_memrealtime() - t1 < (unsigned long long)v) __builtin_amdgcn_s_sleep(8); } }
#endif
#ifdef PROBE_D
    if (PROBE_D >= 4) { xcd_barrier(bar);
        if (blockIdx.x == 0) { unsigned v = __hip_atomic_load((unsigned*)(F.ctl + 8 + (PROBE_D - 4)), RLX_AGENT); if (PROBE_D == 5 || PROBE_D == 8 || PROBE_D == 9) v /= 256u;
            const unsigned long long t1 = __builtin_amdgcn_s_memrealtime(); while (__builtin_amdgcn_s_memrealtime() - t1 < (unsigned long long)v) __builtin_amdgcn_s_sleep(8); } }
#endif
    if (PROBE_T) {
        xcd_barrier(bar);
        const unsigned long long t1 = __builtin_amdgcn_s_memrealtime();
        if (PROBE_T == 7) ts_[7] = t1;
        const unsigned long long dt = ts_[PROBE_T] - ts_[PROBE_T - 1];
        if (blockIdx.x == 0) while (__builtin_amdgcn_s_memrealtime() - t1 < dt) __builtin_amdgcn_s_sleep(8);
    }
}

extern "C" void kernel_launch(void* const* d_in, const int* in_sizes, int n_in, void* d_out, int out_size, void* d_ws, size_t ws_size, hipStream_t stream) {
    static int grid = 0;
    if (grid == 0) {
        if (n_in != 18 || out_size != M * DM || ws_size < WS_END) { fprintf(stderr, "kernel_launch: unexpected shapes (n_in %d out %d ws %zu)\n", n_in, out_size, ws_size); grid = -1; return; }
        int dev = 0, cus = 0, per_cu = 0;
        if (hipGetDevice(&dev) != hipSuccess || hipDeviceGetAttribute(&cus, hipDeviceAttributeMultiprocessorCount, dev) != hipSuccess) { grid = -1; return; }
        if (hipFuncSetAttribute((const void*)fwd_kernel, hipFuncAttributeMaxDynamicSharedMemorySize, LDS_BYTES) != hipSuccess) { fprintf(stderr, "kernel_launch: hipFuncSetAttribute failed\n"); grid = -1; return; }
        if (hipOccupancyMaxActiveBlocksPerMultiprocessor(&per_cu, (const void*)fwd_kernel, NT, LDS_BYTES) != hipSuccess || per_cu < 1) fprintf(stderr, "kernel_launch: occupancy query says %d\n", per_cu);
        (void)hipGetLastError();
        grid = cus;
    }
    if (grid < 0) return;
    (void)hipMemsetAsync((char*)d_ws + WS_CTL, 0, CTL_ZERO_BYTES, stream);
    Params p{};
    p.x = (const float*)d_in[0]; p.norm_g = (const float*)d_in[1]; p.w_in = (const float*)d_in[2]; p.conv_w = (const float*)d_in[3]; p.conv_b = (const float*)d_in[4];
    p.wa = (const float*)d_in[5]; p.ba = (const float*)d_in[6]; p.wx = (const float*)d_in[7]; p.bx = (const float*)d_in[8]; p.lam = (const float*)d_in[9];
    p.ckv_g = (const float*)d_in[10]; p.ikg = (const float*)d_in[11]; p.ikb = (const float*)d_in[12]; p.w_uk = (const float*)d_in[13]; p.w_uv = (const float*)d_in[14];
    p.w_out = (const float*)d_in[15]; p.rel_bias = (const float*)d_in[16]; p.fin_g = (const float*)d_in[17];
    p.out = (float*)d_out; p.ws = (unsigned char*)d_ws;
    hipLaunchKernelGGL(fwd_kernel, dim3(grid), dim3(NT), LDS_BYTES, stream, p);
}
```

```cpp
#define PROBE_REP 0
#include <hip/hip_runtime.h>
#include <cstdio>
#include <cstdint>
#ifndef OPT_DMA_ASM
#define OPT_DMA_ASM 1
#endif
namespace pg8 {
#define PG8_LAS __attribute__((address_space(3)))
typedef unsigned short bf16_t;
typedef _Float16 f16x8 __attribute__((ext_vector_type(8)));
typedef _Float16 f16x2 __attribute__((ext_vector_type(2)));
typedef float f32x2 __attribute__((ext_vector_type(2)));
typedef float f32x4 __attribute__((ext_vector_type(4)));
typedef unsigned u32x4 __attribute__((ext_vector_type(4)));
constexpr int BM = 256, BK = 64, HALF = 128, HTB = HALF * BK * 2  , STAGE_BYTES = 8 * HTB, NXCD = 8, WGM = 8;

__host__ __device__ __forceinline__ int lds_byte(int r, int c) { const int st = (r >> 4) * 2 + (c >> 5), rr = r & 15, cc = c & 31, ob = rr * 64 + cc * 2; return st * 1024 + (ob ^ (((ob >> 9) & 1) << 5)); }
__host__ __device__ __forceinline__ void stage_rc(int b, int& R, int& C) { const int st = b / 1024, sb = b % 1024, swz = sb ^ (((sb >> 9) & 1) << 5); R = (st >> 1) * 16 + swz / 64; C = (st & 1) * 32 + (swz % 64) / 2; }
__host__ __device__ __forceinline__ int perm32(int rho) { const int n = rho >> 4, i = rho & 15; return 8 * (i >> 2) + 4 * n + (i & 3); }

struct Unit { int pm, pn; };
struct Gemm { const bf16_t* A; const bf16_t* Bt; int M, N, K; };

struct StaticOrder {
    int nM, nN, nwg, G, c;
    __host__ __device__ void init(int M, int N, int G_, int c_) { nM = M / BM; nN = N / BM; nwg = nM * nN; G = G_; c = c_; }
    __host__ __device__ bool next(int i, Unit& u) const {
        const long L = (long)i * G + c; if (L >= nwg) return false;
        int wgid = (int)L; { const int q = nwg / NXCD, r = nwg % NXCD, xcd = wgid % NXCD, off = wgid / NXCD; wgid = (xcd < r ? xcd * (q + 1) : r * (q + 1) + (xcd - r) * q) + off; }
        const int nig = WGM * nN, gid = wgid / nig, fm = gid * WGM, gsz = (nM - fm) < WGM ? (nM - fm) : WGM;
        u.pm = fm + ((wgid % nig) % gsz); u.pn = (wgid % nig) / gsz; return true;
    }
    __device__ __forceinline__ void a_ready(const Unit&) const {}
    __device__ __forceinline__ void done(const Unit&) const {}
};

__device__ __forceinline__ unsigned cvt_pk_f16(float lo, float hi) { const f32x2 v = {lo, hi}; return __builtin_bit_cast(unsigned, __builtin_convertvector(v, f16x2)); }
struct EpiF16 {
    static constexpr bool PERM = true, AFTER_DRAIN = false;
    bf16_t* O; int ldc;
    __device__ __forceinline__ void operator()(const f32x4 (&acc)[2][2][4][2], const Unit& u, int wr, int wc, int fr, int fq) const {
        const int row0 = u.pm * BM + wr * 64 + fr, col0 = u.pn * BM + wc * 32 + 8 * fq;
#pragma unroll
        for (int ai = 0; ai < 2; ++ai)
#pragma unroll
            for (int m = 0; m < 4; ++m) { bf16_t* rowp = O + (size_t)(row0 + ai * HALF + m * 16) * ldc + col0;
#pragma unroll
                for (int bj = 0; bj < 2; ++bj) { const f32x4 v0 = acc[ai][bj][m][0], v1 = acc[ai][bj][m][1];
                    u32x4 w; w.x = cvt_pk_f16(v0[0], v0[1]); w.y = cvt_pk_f16(v0[2], v0[3]); w.z = cvt_pk_f16(v1[0], v1[1]); w.w = cvt_pk_f16(v1[2], v1[3]);
                    *(u32x4*)(rowp + bj * HALF) = w; } }
    }
};
struct EpiResF32 {
    static constexpr bool PERM = false, AFTER_DRAIN = false;
    const float* base; float* out; int ldc;
    __device__ __forceinline__ void operator()(const f32x4 (&acc)[2][2][4][2], const Unit& u, int wr, int wc, int fr, int fq) const {
        const int row0 = u.pm * BM + wr * 64 + fr, col0 = u.pn * BM + wc * 32 + 4 * fq;
        const float* __restrict__ bp = base; float* __restrict__ op = out;
        f32x4 r[2][2][2];
#define EPI_LOAD(g) do { const size_t off_ = (size_t)(row0 + ((g) >> 2) * HALF + ((g) & 3) * 16) * ldc + col0; _Pragma("unroll") for (int bj = 0; bj < 2; ++bj) _Pragma("unroll") for (int n = 0; n < 2; ++n) r[(g) & 1][bj][n] = *(const f32x4*)(bp + off_ + bj * HALF + n * 16); } while (0)
        EPI_LOAD(0);
#pragma unroll
        for (int g = 0; g < 8; ++g) { const int ai = g >> 2, m = g & 3;
            if (g + 1 < 8) EPI_LOAD(g + 1);
            const size_t off = (size_t)(row0 + ai * HALF + m * 16) * ldc + col0;
#pragma unroll
            for (int bj = 0; bj < 2; ++bj)
#pragma unroll
                for (int n = 0; n < 2; ++n) *(f32x4*)(op + off + bj * HALF + n * 16) = r[g & 1][bj][n] + acc[ai][bj][m][n]; }
#undef EPI_LOAD
    }
};

template <class Epi, class Sched, bool ALIGN_EPI = false, bool SP2 = false>
__device__ __forceinline__ void gemm_phase(PG8_LAS unsigned char* lds, const Gemm g, const Sched& S, const Epi& E) {
    const int tid = threadIdx.x, wid = __builtin_amdgcn_readfirstlane(tid >> 6), lane = tid & 63, wr = wid >> 2, wc = wid & 3, fr = lane & 15, fq = lane >> 4;
    const int K = g.K, nt = K / BK;
    unsigned voffA[2], voffB[2];
#pragma unroll
    for (int i = 0; i < 2; ++i) { int R, C; stage_rc(tid * 16 + i * 8192, R, C); const int Rb = Epi::PERM ? ((R & ~31) + perm32(R & 31)) : R;
        voffA[i] = (unsigned)(R * K + C) * 2u; voffB[i] = (unsigned)(Rb * K + C) * 2u; }
    const size_t kstep = (size_t)(BK * 2);
    const size_t hstep = (size_t)HALF * K * 2;
    const size_t tstep = 2 * hstep;
    const unsigned ldsw = (unsigned)wid * 1024u;
    const int aoff = lds_byte(wr * 64 + fr, fq * 8), boff = lds_byte(wc * 32 + fr, fq * 8);
#define PG8_SA(b, h) (((b) * 2 + (h)) * HTB)
#define PG8_SB(b, h) ((4 + (b) * 2 + (h)) * HTB)
#define PG8_STAGE(bufoff, gbase, voff) do { _Pragma("unroll") for (int _i = 0; _i < 2; ++_i) \
        __builtin_amdgcn_global_load_lds((const unsigned*)((const char*)(gbase) + (voff)[_i]), (PG8_LAS unsigned*)(lds + (bufoff) + ldsw + _i * 8192), 16, 0, 0); } while (0)
#define PG8_LDA(dst, b, h) do { _Pragma("unroll") for (int m = 0; m < 4; ++m) _Pragma("unroll") for (int k = 0; k < 2; ++k) dst[m][k] = *(const PG8_LAS f16x8*)(lds + PG8_SA(b, h) + aoff + m * 2048 + k * 1024); } while (0)
#define PG8_LDB(dst, b, h) do { _Pragma("unroll") for (int n = 0; n < 2; ++n) _Pragma("unroll") for (int k = 0; k < 2; ++k) dst[n][k] = *(const PG8_LAS f16x8*)(lds + PG8_SB(b, h) + boff + n * 2048 + k * 1024); } while (0)
#define PG8_MMA(ai, bj, At, Bt) do { __builtin_amdgcn_s_setprio(1); _Pragma("unroll") for (int m = 0; m < 4; ++m) _Pragma("unroll") for (int n = 0; n < 2; ++n) _Pragma("unroll") for (int k = 0; k < 2; ++k) \
        acc[ai][bj][m][n] = __builtin_amdgcn_mfma_f32_16x16x32_f16(Bt[n][k], At[m][k], acc[ai][bj][m][n], 0, 0, 0); __builtin_amdgcn_s_setprio(0); } while (0)
#define PG8_WAIT_V(n) asm volatile("s_waitcnt vmcnt(" #n ")" ::: "memory")
#define PG8_WAIT_L(n) asm volatile("s_waitcnt lgkmcnt(" #n ")" ::: "memory")
#define PG8_BAR __builtin_amdgcn_s_barrier()
#define PG8_SCHED __builtin_amdgcn_sched_barrier(0)
    Unit cur, nxt; int ui = 0;
    if (!S.next(0, cur)) return;
    f32x4 acc[2][2][4][2];
#pragma unroll
    for (int a = 0; a < 2; ++a)
#pragma unroll
        for (int b = 0; b < 2; ++b)
#pragma unroll
            for (int m = 0; m < 4; ++m)
#pragma unroll
                for (int n = 0; n < 2; ++n) acc[a][b][m][n] = (f32x4){0.f, 0.f, 0.f, 0.f};
    f16x8 At[4][2], B0[2][2], B1[2][2];
    const char* cA = (const char*)g.A + (size_t)cur.pm * tstep; const char* cB = (const char*)g.Bt + (size_t)cur.pn * tstep;
    S.a_ready(cur);
    if constexpr (SP2) {
        PG8_STAGE(PG8_SB(0, 0), cB, voffB); PG8_STAGE(PG8_SB(0, 1), cB + hstep, voffB); PG8_STAGE(PG8_SA(0, 0), cA, voffA); PG8_STAGE(PG8_SA(0, 1), cA + hstep, voffA);
        if (wr == 1) PG8_BAR;
        PG8_WAIT_V(2); PG8_BAR;
        PG8_STAGE(PG8_SB(1, 0), cB + kstep, voffB); PG8_STAGE(PG8_SA(1, 0), cA + kstep, voffA); PG8_STAGE(PG8_SB(1, 1), cB + hstep + kstep, voffB);
        PG8_WAIT_V(6); PG8_BAR;
    } else {
        PG8_STAGE(PG8_SB(0, 0), cB, voffB); PG8_STAGE(PG8_SA(0, 0), cA, voffA); PG8_STAGE(PG8_SB(0, 1), cB + hstep, voffB); PG8_STAGE(PG8_SA(0, 1), cA + hstep, voffA);
        if (wr == 1) PG8_BAR;
        PG8_WAIT_V(4); PG8_BAR;
        PG8_STAGE(PG8_SB(1, 0), cB + kstep, voffB); PG8_STAGE(PG8_SA(1, 0), cA + kstep, voffA); PG8_STAGE(PG8_SB(1, 1), cB + hstep + kstep, voffB);
        PG8_WAIT_V(6); PG8_BAR;
    }
    for (;;) {
        const bool has_next = S.next(ui + 1, nxt);
        const char* nA = has_next ? (const char*)g.A + (size_t)nxt.pm * tstep : cA; const char* nB = has_next ? (const char*)g.Bt + (size_t)nxt.pn * tstep : cB;
        for (int t = 0; t < nt; t += 2) {
            const bool last = (t == nt - 2);
            const char* a1 = cA + (size_t)(t + 1) * kstep;
            const char* a2 = last ? nA : cA + (size_t)(t + 2) * kstep; const char* b2 = last ? nB : cB + (size_t)(t + 2) * kstep;
            const char* a3 = a2 + kstep; const char* b3 = b2 + kstep;
            if (last && has_next) S.a_ready(nxt);
            if constexpr (SP2) {
            PG8_LDB(B0, 0, 0); PG8_LDB(B1, 0, 1); PG8_SCHED; PG8_LDA(At, 0, 0); PG8_STAGE(PG8_SA(1, 1), a1 + hstep, voffA);
            PG8_WAIT_V(8); PG8_WAIT_L(0); PG8_BAR; PG8_MMA(0, 0, At, B0); PG8_MMA(0, 1, At, B1); PG8_BAR; PG8_SCHED;
            PG8_LDA(At, 0, 1); PG8_STAGE(PG8_SB(0, 0), b2, voffB); PG8_STAGE(PG8_SB(0, 1), b2 + hstep, voffB); PG8_STAGE(PG8_SA(0, 0), a2, voffA);
            PG8_WAIT_V(8); PG8_WAIT_L(0); PG8_BAR; PG8_MMA(1, 0, At, B0); PG8_MMA(1, 1, At, B1); PG8_BAR; PG8_SCHED;
            PG8_LDB(B0, 1, 0); PG8_LDB(B1, 1, 1); PG8_SCHED; PG8_LDA(At, 1, 0); PG8_STAGE(PG8_SA(0, 1), a2 + hstep, voffA);
            PG8_WAIT_V(8); PG8_WAIT_L(0); PG8_BAR; PG8_MMA(0, 0, At, B0); PG8_MMA(0, 1, At, B1); PG8_BAR; PG8_SCHED;
            PG8_LDA(At, 1, 1); PG8_STAGE(PG8_SB(1, 0), b3, voffB); PG8_STAGE(PG8_SB(1, 1), b3 + hstep, voffB); PG8_STAGE(PG8_SA(1, 0), a3, voffA);
            PG8_WAIT_V(8); PG8_WAIT_L(0); PG8_BAR; PG8_MMA(1, 0, At, B0); PG8_MMA(1, 1, At, B1); PG8_BAR; PG8_SCHED;
            } else {
            PG8_LDB(B0, 0, 0); PG8_SCHED; PG8_LDA(At, 0, 0); PG8_STAGE(PG8_SA(1, 1), a1 + hstep, voffA);
            PG8_WAIT_L(8); PG8_BAR; PG8_WAIT_L(0); PG8_MMA(0, 0, At, B0); PG8_BAR; PG8_SCHED;
            PG8_LDB(B1, 0, 1); PG8_STAGE(PG8_SB(0, 0), b2, voffB);
            PG8_BAR; PG8_WAIT_L(0); PG8_MMA(0, 1, At, B1); PG8_BAR;
            PG8_LDA(At, 0, 1); PG8_STAGE(PG8_SA(0, 0), a2, voffA);
            PG8_BAR; PG8_WAIT_L(0); PG8_MMA(1, 0, At, B0); PG8_BAR; PG8_SCHED;
            PG8_STAGE(PG8_SB(0, 1), b2 + hstep, voffB);
            PG8_WAIT_V(6); PG8_BAR; PG8_MMA(1, 1, At, B1); PG8_BAR;
            PG8_LDB(B0, 1, 0); PG8_SCHED; PG8_LDA(At, 1, 0); PG8_STAGE(PG8_SA(0, 1), a2 + hstep, voffA);
            PG8_WAIT_L(8); PG8_BAR; PG8_WAIT_L(0); PG8_MMA(0, 0, At, B0); PG8_BAR; PG8_SCHED;
            PG8_LDB(B1, 1, 1); PG8_STAGE(PG8_SB(1, 0), b3, voffB);
            PG8_BAR; PG8_WAIT_L(0); PG8_MMA(0, 1, At, B1); PG8_BAR;
            PG8_LDA(At, 1, 1); PG8_STAGE(PG8_SA(1, 0), a3, voffA);
            PG8_BAR; PG8_WAIT_L(0); PG8_MMA(1, 0, At, B0); PG8_BAR; PG8_SCHED;
            PG8_STAGE(PG8_SB(1, 1), b3 + hstep, voffB);
            PG8_WAIT_V(6); PG8_BAR; PG8_MMA(1, 1, At, B1); PG8_BAR;
            }
        }
        if constexpr (ALIGN_EPI) { if (wr == 0) PG8_BAR; }
        if constexpr (!Epi::AFTER_DRAIN) { E(acc, cur, wr, wc, fr, fq); S.done(cur); }
        if (!has_next) break;
#pragma unroll
        for (int a = 0; a < 2; ++a)
#pragma unroll
            for (int b = 0; b < 2; ++b)
#pragma unroll
                for (int m = 0; m < 4; ++m)
#pragma unroll
                    for (int n = 0; n < 2; ++n) acc[a][b][m][n] = (f32x4){0.f, 0.f, 0.f, 0.f};
        cur = nxt; cA = nA; cB = nB; ++ui;
        if constexpr (ALIGN_EPI) { if (wr == 1) PG8_BAR; }
    }
    PG8_WAIT_V(0);
    if constexpr (!ALIGN_EPI) { if (wr == 0) PG8_BAR; }
    PG8_BAR;
    if constexpr (Epi::AFTER_DRAIN) { E.fused(acc, cur, wr, wc, fr, fq, lds, wid, lane); S.done(cur); }
#undef PG8_SA
#undef PG8_SB
#undef PG8_STAGE
#undef PG8_LDA
#undef PG8_LDB
#undef PG8_MMA
#undef PG8_WAIT_V
#undef PG8_WAIT_L
#undef PG8_BAR
#undef PG8_SCHED
}
}
constexpr int NWAVES = 8, NT = NWAVES * 64;
constexpr int BATCH = 4, SEQ = 2048, DM = 2048, M = BATCH * SEQ;
constexpr int LRU_W = 1024, LRU_BLK = 8, LRU_BD = 128;
constexpr int ATT_W = 1024, NH = 8, HD = 128, CL = 256, IH = 16, ID = 64, TOPK = 256;
constexpr int C_XA = 0, C_GA = 1024, C_Q = 2048, C_CKV = 3072, C_GB = 3328, C_QI = 4352, C_KI = 5376, C_WI = 5440, NIN = 5456, NINP = 5632;
constexpr float EPS = 1e-6f;
__constant__ unsigned char BUCKET[128] = {0, 1, 2, 3, 4, 5, 6, 7, 8, 9, 10, 11, 12, 13, 14, 15, 16, 16, 16, 17, 17, 18, 18, 18, 19, 19, 19, 20, 20, 20, 20, 21, 21, 21, 21, 22, 22, 22, 22, 22, 23, 23, 23, 23, 23, 23, 24, 24, 24, 24, 24, 24, 25, 25, 25, 25, 25, 25, 25, 26, 26, 26, 26, 26, 26, 26, 26, 27, 27, 27, 27, 27, 27, 27, 27, 27, 27, 28, 28, 28, 28, 28, 28, 28, 28, 28, 28, 29, 29, 29, 29, 29, 29, 29, 29, 29, 29, 29, 29, 30, 30, 30, 30, 30, 30, 30, 30, 30, 30, 30, 30, 30, 30, 31, 31, 31, 31, 31, 31, 31, 31, 31, 31, 31, 31, 31, 31, 31};

constexpr size_t MiB = 1u << 20;
constexpr size_t WS_CTL = 0, CTL_ZERO_BYTES = 1 * MiB;
constexpr size_t WS_WIN = 2 * MiB;
constexpr size_t WS_WOUT = 24 * MiB;
constexpr size_t WS_H = 32 * MiB;
constexpr size_t WS_PROJ = 64 * MiB;
constexpr size_t WS_A = 152 * MiB;
constexpr size_t WS_B = 184 * MiB;
constexpr size_t WS_QABS = 216 * MiB;
constexpr size_t WS_CN = 248 * MiB;
constexpr size_t WS_KN = 252 * MiB;
constexpr size_t WS_WUVT = 253 * MiB;
constexpr size_t WS_WUKT = WS_WUVT + 512 * 1024;
constexpr size_t WS_WAT = 254 * MiB;
constexpr size_t WS_WXT = WS_WAT + 256 * 1024;
constexpr size_t WS_AGG = WS_WXT + 256 * 1024;
constexpr size_t WS_END = 256 * MiB;
constexpr int CW_TMO = 0, CW_CODE = 1, CW_BAR = 4096;

constexpr int RING_OFF = 0, RING_BYTES = 131072;
constexpr int LDSCTL_OFF = RING_BYTES, MISC_OFF = LDSCTL_OFF + 320;
constexpr int LDS_BYTES = 163840;

#define GAS __attribute__((address_space(1)))
#define LAS __attribute__((address_space(3)))
typedef unsigned short f16s;
typedef _Float16 f16;
typedef _Float16 h4 __attribute__((ext_vector_type(4)));
typedef _Float16 h8 __attribute__((ext_vector_type(8)));
typedef unsigned v4u __attribute__((ext_vector_type(4)));
typedef unsigned v2u __attribute__((ext_vector_type(2)));
typedef float f32x4 __attribute__((ext_vector_type(4)));
typedef float f32x2 __attribute__((ext_vector_type(2)));
typedef GAS unsigned gu32;
#define RLX_AGENT __ATOMIC_RELAXED, __HIP_MEMORY_SCOPE_AGENT
#define LDS_WAIT() asm volatile("s_waitcnt lgkmcnt(0)" ::: "memory")
#define VM_WAIT() asm volatile("s_waitcnt vmcnt(0)" ::: "memory")
__device__ __forceinline__ unsigned pkh(float lo, float hi) { return pg8::cvt_pk_f16(lo, hi); }
__device__ __forceinline__ float sigmoidf_(float x) { return __builtin_amdgcn_rcpf(1.f + __expf(-x)); }
__device__ __forceinline__ float siluf_(float x) { return x * __builtin_amdgcn_rcpf(1.f + __expf(-x)); }
__device__ __forceinline__ float h2f(f16s v) { return (float)__builtin_bit_cast(f16, v); }

#define XB_TMO      128
#define XB_XCNT(j)  (256  + 64 * (j))
#define XB_XSUB(j)  (1280 + 64 * (j))
#define XB_XGEN(j)  (2304 + 64 * (j))
#define XB_TOP      3328
#define XB_TOPGEN   3392
#define XCD_BAR_WORDS 3456
#define XB_SPIN_CAP (1u << 18)

__device__ __forceinline__ unsigned xb_ld(unsigned* p)              { return __hip_atomic_load(p, __ATOMIC_RELAXED, __HIP_MEMORY_SCOPE_AGENT); }
__device__ __forceinline__ unsigned xb_add(unsigned* p, unsigned v) { return __hip_atomic_fetch_add(p, v, __ATOMIC_RELAXED, __HIP_MEMORY_SCOPE_AGENT); }
__device__ __forceinline__ unsigned xb_xcc_id() { return (unsigned)__builtin_amdgcn_s_getreg((3 << 11) | 20) & 0xFu; }
#define XB_SPIN(cond, bar) do { unsigned _sp = 0; while (cond) { __builtin_amdgcn_s_sleep(1); \
    if ((++_sp & 255u) == 0u) { if (xb_ld(&(bar)[XB_TMO])) break; if (_sp > XB_SPIN_CAP) { atomicAdd(&(bar)[XB_TMO], 1u); break; } } } } while (0)

struct XcdBarrier {
    unsigned* bar; unsigned x;
    volatile LAS unsigned* st;
};

__device__ __forceinline__ XcdBarrier xcd_barrier_post(unsigned* bar, volatile LAS unsigned* st) {
    XcdBarrier b; b.bar = bar; b.x = xb_xcc_id(); b.st = st;
    if (threadIdx.x == 0) (void)xb_add(&bar[XB_XCNT(b.x)], 1u);
    return b;
}
__device__ __forceinline__ void xcd_barrier_complete(unsigned* bar, unsigned x, unsigned& nloc, unsigned& nx) {
    const unsigned G = gridDim.x * gridDim.y * gridDim.z;
    unsigned sum, cnt, mine, sp = 0u;
    for (;;) {
        sum = 0u; cnt = 0u; mine = 0u;
#pragma unroll
        for (unsigned j = 0; j < 16; ++j) { const unsigned c = xb_ld(&bar[XB_XCNT(j)]); sum += c; cnt += (c > 0u) ? 1u : 0u; mine = (j == x) ? c : mine; }
        if (sum == G) break;
        __builtin_amdgcn_s_sleep(1);
        if ((++sp & 255u) == 0u) { if (xb_ld(&bar[XB_TMO])) break; if (sp > XB_SPIN_CAP) { atomicAdd(&bar[XB_TMO], 1u); break; } }
    }
    nloc = mine > 0u ? mine : 1u; nx = cnt > 0u ? cnt : 1u;
}

__device__ __forceinline__ void xcd_barrier(const XcdBarrier& b) {
    asm volatile("s_waitcnt vmcnt(0)" ::: "memory");
    __syncthreads();
    if (threadIdx.x == 0) {
        unsigned* bar = b.bar;
        __builtin_amdgcn_s_waitcnt(0);
        unsigned nloc = b.st[0], nx = b.st[1];
        if (nloc == 0u) { xcd_barrier_complete(bar, b.x, nloc, nx); b.st[0] = nloc; b.st[1] = nx; }
        const unsigned old = xb_add(&bar[XB_XSUB(b.x)], 1u);
        const unsigned gen = old / nloc;
        if (old + 1u == (gen + 1u) * nloc) {
            __builtin_amdgcn_fence(__ATOMIC_RELEASE, "agent");
            asm volatile("s_waitcnt vmcnt(0)" ::: "memory");
            const unsigned og = xb_add(&bar[XB_TOP], 1u);
            const unsigned tg = og / nx;
            if (og + 1u == (tg + 1u) * nx) xb_add(&bar[XB_TOPGEN], 1u);
            else XB_SPIN(xb_ld(&bar[XB_TOPGEN]) == tg, bar);
            __builtin_amdgcn_fence(__ATOMIC_ACQUIRE, "agent");
            xb_add(&bar[XB_XGEN(b.x)], 1u);
            asm volatile("s_waitcnt vmcnt(0)" ::: "memory");
        } else {
            XB_SPIN(xb_ld(&bar[XB_XGEN(b.x)]) == gen, bar);
            __builtin_amdgcn_fence(__ATOMIC_ACQUIRE, "agent");
            asm volatile("s_waitcnt vmcnt(0)" ::: "memory");
        }
    }
    __syncthreads();
}
struct Params {
    const float *x, *norm_g, *w_in, *conv_w, *conv_b, *wa, *ba, *wx, *bx, *lam, *ckv_g, *ikg, *ikb, *w_uk, *w_uv, *w_out, *rel_bias, *fin_g;
    float* out; unsigned char* ws;
};
struct Frame {
    LAS unsigned char* lds;
    volatile LAS unsigned* MISC;
    gu32* ctl;
    int tid, lane, wave, vcu, G;
#ifdef PROBE_S
    unsigned long long pt_last; unsigned pt_acc[12];
#endif
};
#ifdef PROBE_S
#define PSTAMP(F, k) do { const unsigned long long t_ = __builtin_amdgcn_s_memrealtime(); (F).pt_acc[k] += (unsigned)(t_ - (F).pt_last); (F).pt_last = t_; } while (0)
#else
#define PSTAMP(F, k) do { } while (0)
#endif
__device__ __forceinline__ float wave_sum(float v) {
#pragma unroll
    for (int o = 1; o < 64; o <<= 1) v += __shfl_xor(v, o);
    return v;
}
__device__ __forceinline__ int wave_sum_i(int v) {
#pragma unroll
    for (int o = 1; o < 64; o <<= 1) v += __shfl_xor(v, o);
    return v;
}
__device__ __forceinline__ float wave_max(float v) {
#pragma unroll
    for (int o = 1; o < 64; o <<= 1) v = fmaxf(v, __shfl_xor(v, o));
    return v;
}

struct TrDesc { const float* W; f16s* WT; int K, N, nblk, item; };
__device__ __forceinline__ void tr_load(const TrDesc& d, int lane, f32x4 (&v)[8]) {
    const int kb = d.item / d.nblk, nb = d.item % d.nblk, k0 = 64 * kb, n0 = 32 * nb, n4 = 4 * (lane & 7), kr = lane >> 3;
    const bool nok = (n0 + n4) < d.N;
#pragma unroll
    for (int i = 0; i < 8; ++i) v[i] = nok ? *(const GAS f32x4*)(d.W + (size_t)(k0 + 8 * i + kr) * d.N + n0 + n4) : (f32x4){0.f, 0.f, 0.f, 0.f};
}
__device__ __forceinline__ void tr_store(const TrDesc& d, int lane, const f32x4 (&v)[8], LAS float* scr) {
    const int kb = d.item / d.nblk, nb = d.item % d.nblk, k0 = 64 * kb, n0 = 32 * nb, n4 = 4 * (lane & 7), kr = lane >> 3;
#pragma unroll
    for (int i = 0; i < 8; ++i) { LAS float* p = scr + (8 * i + kr) * 33 + n4; p[0] = v[i][0]; p[1] = v[i][1]; p[2] = v[i][2]; p[3] = v[i][3]; }
    LDS_WAIT(); asm volatile("" ::: "memory");
    const int c = lane & 7;
#pragma unroll
    for (int j = 0; j < 4; ++j) { const int n = (lane >> 3) + 8 * j; const LAS float* s = scr + (8 * c) * 33 + n;
        v4u o; o.x = pkh(s[0 * 33], s[1 * 33]); o.y = pkh(s[2 * 33], s[3 * 33]); o.z = pkh(s[4 * 33], s[5 * 33]); o.w = pkh(s[6 * 33], s[7 * 33]);
        *(GAS v4u*)(d.WT + (size_t)(n0 + n) * d.K + k0 + 8 * c) = o; }
    LDS_WAIT(); asm volatile("" ::: "memory");
}
constexpr int NB_IN = NINP / 32, I_IN = (DM / 64) * NB_IN, I_OUT = (DM / 64) * (DM / 32), I_UV = NH * 16, I_UK = NH * 16, I_G = LRU_BLK * 16, I_ALL = I_IN + I_OUT + I_UV + I_UK + I_G;
__device__ __forceinline__ TrDesc tr_desc(const Params& P, int it) {
    TrDesc d;
    if (it < I_IN) { d.W = P.w_in; d.WT = (f16s*)(P.ws + WS_WIN); d.K = DM; d.N = NIN; d.nblk = NB_IN; d.item = it; return d; } it -= I_IN;
    if (it < I_OUT) { d.W = P.w_out; d.WT = (f16s*)(P.ws + WS_WOUT); d.K = DM; d.N = DM; d.nblk = DM / 32; d.item = it; return d; } it -= I_OUT;
    if (it < I_UV) { const int h = it >> 4; d.W = P.w_uv + (size_t)h * CL * HD; d.WT = (f16s*)(P.ws + WS_WUVT) + (size_t)h * HD * CL; d.K = CL; d.N = HD; d.nblk = HD / 32; d.item = it & 15; return d; } it -= I_UV;
    if (it < I_UK) { const int h = it >> 4; d.W = P.w_uk + (size_t)h * HD * CL; d.WT = (f16s*)(P.ws + WS_WUKT) + (size_t)h * CL * HD; d.K = HD; d.N = CL; d.nblk = CL / 32; d.item = it & 15; return d; } it -= I_UK;
    { const int g = it >> 4, w = (it >> 3) & 1; d.W = (w ? P.wx : P.wa) + (size_t)g * LRU_BD * LRU_BD; d.WT = (f16s*)(P.ws + (w ? WS_WXT : WS_WAT)) + (size_t)g * LRU_BD * LRU_BD; d.K = LRU_BD; d.N = LRU_BD; d.nblk = LRU_BD / 32; d.item = it & 7; return d; }
}
__device__ __forceinline__ void rms_load(const float* xrow, int lane, f32x4 (&v)[8]) {
    const GAS f32x4* xr = (const GAS f32x4*)xrow + lane;
#pragma unroll
    for (int j = 0; j < 8; ++j) v[j] = xr[64 * j];
}
__device__ __forceinline__ void rms_store(const f32x4 (&v)[8], const float* g, f16s* orow, int lane) {
    const GAS f32x4* gr = (const GAS f32x4*)g + lane; float s = 0.f;
#pragma unroll
    for (int j = 0; j < 8; ++j) s += (v[j].x * v[j].x + v[j].y * v[j].y) + (v[j].z * v[j].z + v[j].w * v[j].w);
    const float r = rsqrtf(wave_sum(s) * (1.f / DM) + EPS);
    GAS v2u* o8 = (GAS v2u*)orow + lane;
#pragma unroll
    for (int j = 0; j < 8; ++j) { const f32x4 gg = gr[64 * j]; v2u o; o.x = pkh(v[j].x * r * gg.x, v[j].y * r * gg.y); o.y = pkh(v[j].z * r * gg.z, v[j].w * r * gg.w); o8[64 * j] = o; }
}
__device__ __forceinline__ void p0_prologue(Frame& F, const Params& P) {
    LAS float* scr = (LAS float*)(F.lds + RING_OFF + F.wave * 16384);
    const int gw = F.vcu * NWAVES + F.wave, NGW = F.G * NWAVES, lane = F.lane;
    f16s* Hn = (f16s*)(P.ws + WS_H);
    {   f32x4 va[8], vb[8];
        int it = gw;
        if (it < I_ALL) { TrDesc d = tr_desc(P, it); tr_load(d, lane, va);
            for (;;) { const int nx = it + NGW; TrDesc dn = d; const bool more = nx < I_ALL;
                if (more) { dn = tr_desc(P, nx); tr_load(dn, lane, vb); }
                tr_store(d, lane, va, scr);
                if (!more) break;
#pragma unroll
                for (int i = 0; i < 8; ++i) va[i] = vb[i];
                d = dn; it = nx; } }
    }
    {   f32x4 va[8], vb[8];
        int m = gw;
        if (m < M) { rms_load(P.x + (size_t)m * DM, lane, va);
            for (;;) { const int nx = m + NGW; const bool more = nx < M;
                if (more) rms_load(P.x + (size_t)nx * DM, lane, vb);
                rms_store(va, P.norm_g, Hn + (size_t)m * DM, lane);
                if (!more) break;
#pragma unroll
                for (int i = 0; i < 8; ++i) va[i] = vb[i];
                m = nx; } }
    }
}

__device__ __forceinline__ void p2_gates_naive(Frame& F, const Params& P) {
    const f16s* proj = (const f16s*)(P.ws + WS_PROJ); float* abuf = (float*)(P.ws + WS_A); float* bbuf = (float*)(P.ws + WS_B);
    LAS float* xs = (LAS float*)(F.lds + RING_OFF);
    const int tid = F.tid;
    for (int it = F.vcu; it < (M / 16) * LRU_BLK; it += F.G) {
        const int rt = it >> 3, g = it & 7, r0 = rt * 16;
#pragma unroll
        for (int i = 0; i < 4; ++i) { const int e = tid + NT * i, r = e >> 7, c = e & 127, row = r0 + r, t = row & (SEQ - 1), ch = g * 128 + c;
            float v = P.conv_b[ch];
#pragma unroll
            for (int j = 0; j < 4; ++j) { const int tt = t - 3 + j; if (tt >= 0) v += h2f(proj[(size_t)(row - 3 + j) * NINP + C_XA + ch]) * P.conv_w[j * LRU_W + ch]; }
            xs[r * 128 + c] = v; }
        __syncthreads();
        const int j = tid & 127, rh = tid >> 7;
        float ar[4] = {0.f, 0.f, 0.f, 0.f}, ai[4] = {0.f, 0.f, 0.f, 0.f};
        const float* wag = P.wa + (size_t)g * 128 * 128; const float* wxg = P.wx + (size_t)g * 128 * 128;
        for (int i = 0; i < 128; ++i) { const float w1 = wag[i * 128 + j], w2 = wxg[i * 128 + j];
#pragma unroll
            for (int r = 0; r < 4; ++r) { const float xv = xs[(rh * 4 + r) * 128 + i]; ar[r] += xv * w1; ai[r] += xv * w2; } }
        const int ch = g * 128 + j; const float sp = log1pf(expf(-P.lam[ch])), bav = P.ba[ch], bxv = P.bx[ch];
#pragma unroll
        for (int r = 0; r < 4; ++r) { const int row = r0 + rh * 4 + r, t = row & (SEQ - 1);
            const float rg = sigmoidf_(ar[r] + bav), ig = sigmoidf_(ai[r] + bxv), la = -8.f * rg * sp, a = expf(la);
            float mult = sqrtf(-expm1f(2.f * la)); if (t == 0) mult = 1.f;
            abuf[(size_t)row * LRU_W + ch] = a; bbuf[(size_t)row * LRU_W + ch] = mult * (ig * xs[(rh * 4 + r) * 128 + j]); }
        __syncthreads();
    }
}
__device__ __forceinline__ void p2_qabs_naive(Frame& F, const Params& P) {
    const f16s* proj = (const f16s*)(P.ws + WS_PROJ); f16s* qabs = (f16s*)(P.ws + WS_QABS);
    LAS float* qs = (LAS float*)(F.lds + RING_OFF);
    const int tid = F.tid;
    for (int it = F.vcu; it < (M / 16) * NH; it += F.G) {
        const int rt = it >> 3, h = it & 7, r0 = rt * 16;
#pragma unroll
        for (int i = 0; i < 4; ++i) { const int e = tid + NT * i, r = e >> 7, c = e & 127; qs[r * 128 + c] = h2f(proj[(size_t)(r0 + r) * NINP + C_Q + h * HD + c]); }
        __syncthreads();
        const int c = tid & 255, rh = tid >> 8;
        float acc[8];
#pragma unroll
        for (int r = 0; r < 8; ++r) acc[r] = 0.f;
        const float* wk = P.w_uk + (size_t)h * HD * CL + c;
        for (int d = 0; d < HD; ++d) { const float w = wk[(size_t)d * CL];
#pragma unroll
            for (int r = 0; r < 8; ++r) acc[r] += qs[(rh * 8 + r) * 128 + d] * w; }
#pragma unroll
        for (int r = 0; r < 8; ++r) qabs[(size_t)(r0 + rh * 8 + r) * (NH * CL) + h * CL + c] = __builtin_bit_cast(f16s, (f16)acc[r]);
        __syncthreads();
    }
}
__device__ __forceinline__ void p2_qabs_mfma(Frame& F, const Params& P) {
    const f16s* proj = (const f16s*)(P.ws + WS_PROJ); f16s* qabs = (f16s*)(P.ws + WS_QABS);
    int lane = F.lane; asm volatile("" : "+v"(lane));
    const int q = lane >> 4, fr = lane & 15, gw = F.vcu * NWAVES + F.wave, NGW = F.G * NWAVES, role = gw & 15, h = role >> 1, nh = role & 1;
    h8 W[8][4];
    { const f16s* wp = (const f16s*)(P.ws + WS_WUKT) + ((size_t)h * CL + nh * 128 + fr) * HD + 8 * q;
#pragma unroll
      for (int nt = 0; nt < 8; ++nt)
#pragma unroll
          for (int ks = 0; ks < 4; ++ks) W[nt][ks] = *(const GAS h8*)(wp + (size_t)nt * 16 * HD + 32 * ks); }
    const f32x4 zero4 = {0.f, 0.f, 0.f, 0.f};
    for (int rt = gw >> 4; rt < M / 16; rt += NGW >> 4) {
        const int row = rt * 16 + fr;
        h8 B[4];
        { const f16s* qp = proj + (size_t)row * NINP + C_Q + h * HD + 8 * q;
#pragma unroll
          for (int ks = 0; ks < 4; ++ks) B[ks] = *(const GAS h8*)(qp + 32 * ks); }
        f16s* op = qabs + (size_t)row * (NH * CL) + h * CL + nh * 128 + 4 * q;
#pragma unroll
        for (int nt = 0; nt < 8; ++nt) { f32x4 acc = zero4;
#pragma unroll
            for (int ks = 0; ks < 4; ++ks) acc = __builtin_amdgcn_mfma_f32_16x16x32_f16(W[nt][ks], B[ks], acc, 0, 0, 0);
            v2u o; o.x = pkh(acc[0], acc[1]); o.y = pkh(acc[2], acc[3]); *(GAS v2u*)(op + 16 * nt) = o; }
    }
}
__device__ __forceinline__ void p2_gates_mfma(Frame& F, const Params& P) {
    const f16s* proj = (const f16s*)(P.ws + WS_PROJ); float* abuf = (float*)(P.ws + WS_A); float* bbuf = (float*)(P.ws + WS_B);
    LAS float* CW = (LAS float*)(F.lds + RING_OFF);
    LAS float* CB = CW + 4 * LRU_W; LAS float* NSP = CB + LRU_W; LAS float* BA = NSP + LRU_W; LAS float* BX = BA + LRU_W;
    for (int e = F.tid; e < 4 * LRU_W; e += NT) CW[e] = P.conv_w[e];
    for (int e = F.tid; e < LRU_W; e += NT) { CB[e] = P.conv_b[e]; NSP[e] = -8.f * log1pf(expf(-P.lam[e])); BA[e] = P.ba[e]; BX[e] = P.bx[e]; }
    __syncthreads();
    int lane = F.lane; asm volatile("" : "+v"(lane));
    const int q = lane >> 4, fr = lane & 15, gw = F.vcu * NWAVES + F.wave, NGW = F.G * NWAVES, role = gw & 31, g = role >> 2, nq = role & 3;
    h8 WA[2][4], WX[2][4];
    { const size_t wo = ((size_t)g * LRU_BD + nq * 32 + fr) * LRU_BD + 8 * q; const f16s* wap = (const f16s*)(P.ws + WS_WAT) + wo; const f16s* wxp = (const f16s*)(P.ws + WS_WXT) + wo;
#pragma unroll
      for (int nt = 0; nt < 2; ++nt)
#pragma unroll
          for (int ks = 0; ks < 4; ++ks) { WA[nt][ks] = *(const GAS h8*)(wap + (size_t)nt * 16 * LRU_BD + 32 * ks); WX[nt][ks] = *(const GAS h8*)(wxp + (size_t)nt * 16 * LRU_BD + 32 * ks); } }
    const f32x4 zero4 = {0.f, 0.f, 0.f, 0.f};
    for (int rt = gw >> 5; rt < M / 16; rt += NGW >> 5) {
        const int row = rt * 16 + fr, t = row & (SEQ - 1);
        h8 XB[4];
#pragma unroll
        for (int ks = 0; ks < 4; ++ks) { const int c0 = g * 128 + 32 * ks + 8 * q;
            float v[8];
            { const f32x4 b0 = *(const LAS f32x4*)(CB + c0), b1 = *(const LAS f32x4*)(CB + c0 + 4); v[0] = b0[0]; v[1] = b0[1]; v[2] = b0[2]; v[3] = b0[3]; v[4] = b1[0]; v[5] = b1[1]; v[6] = b1[2]; v[7] = b1[3]; }
#pragma unroll
            for (int j = 0; j < 4; ++j) { if (t - 3 + j >= 0) { const h8 xv = *(const GAS h8*)(proj + (size_t)(row - 3 + j) * NINP + C_XA + c0);
                    const f32x4 w0 = *(const LAS f32x4*)(CW + j * LRU_W + c0), w1 = *(const LAS f32x4*)(CW + j * LRU_W + c0 + 4);
#pragma unroll
                    for (int e = 0; e < 4; ++e) { v[e] += (float)xv[e] * w0[e]; v[4 + e] += (float)xv[4 + e] * w1[e]; } } }
#pragma unroll
            for (int e = 0; e < 8; ++e) XB[ks][e] = (f16)v[e];
            asm volatile("" : "+v"(XB[ks])); }
#pragma unroll
        for (int nt = 0; nt < 2; ++nt) { f32x4 ar = zero4, ai = zero4;
#pragma unroll
            for (int ks = 0; ks < 4; ++ks) { ar = __builtin_amdgcn_mfma_f32_16x16x32_f16(WA[nt][ks], XB[ks], ar, 0, 0, 0); ai = __builtin_amdgcn_mfma_f32_16x16x32_f16(WX[nt][ks], XB[ks], ai, 0, 0, 0); }
            const int ch = g * 128 + nq * 32 + 16 * nt + 4 * q;
            f32x4 xc = *(const LAS f32x4*)(CB + ch);
#pragma unroll
            for (int j = 0; j < 4; ++j) { if (t - 3 + j >= 0) { const h4 xv = *(const GAS h4*)(proj + (size_t)(row - 3 + j) * NINP + C_XA + ch); const f32x4 w0 = *(const LAS f32x4*)(CW + j * LRU_W + ch);
#pragma unroll
                    for (int e = 0; e < 4; ++e) xc[e] += (float)xv[e] * w0[e]; } }
            const f32x4 nsp = *(const LAS f32x4*)(NSP + ch), bav = *(const LAS f32x4*)(BA + ch), bxv = *(const LAS f32x4*)(BX + ch);
            f32x4 av, bv;
#pragma unroll
            for (int e = 0; e < 4; ++e) { const float rg = sigmoidf_(ar[e] + bav[e]), ig = sigmoidf_(ai[e] + bxv[e]), a = __expf(rg * nsp[e]);
                float mult = __builtin_amdgcn_sqrtf(fmaxf(1.f - a * a, 0.f)); if (t == 0) mult = 1.f;
                av[e] = a; bv[e] = mult * (ig * xc[e]); }
            *(GAS f32x4*)(abuf + (size_t)row * LRU_W + ch) = av; *(GAS f32x4*)(bbuf + (size_t)row * LRU_W + ch) = bv; }
    }
    __syncthreads();
}
__device__ __forceinline__ void p2_norms(Frame& F, const Params& P) {
    const f16s* proj = (const f16s*)(P.ws + WS_PROJ); f16s* cn = (f16s*)(P.ws + WS_CN); f16s* kn = (f16s*)(P.ws + WS_KN);
    const int gw = F.vcu * NWAVES + F.wave, NGW = F.G * NWAVES, lane = F.lane;
    for (int row = gw; row < M; row += NGW) {
        const h4 cv = *(const GAS h4*)(proj + (size_t)row * NINP + C_CKV + 4 * lane);
        const float c0 = (float)cv[0], c1 = (float)cv[1], c2 = (float)cv[2], c3 = (float)cv[3];
        const float r = rsqrtf(wave_sum(c0 * c0 + c1 * c1 + c2 * c2 + c3 * c3) * (1.f / CL) + EPS);
        const f32x4 g = *(const GAS f32x4*)(P.ckv_g + 4 * lane);
        v2u o; o.x = pkh(c0 * r * g.x, c1 * r * g.y); o.y = pkh(c2 * r * g.z, c3 * r * g.w);
        *(GAS v2u*)(cn + (size_t)row * CL + 4 * lane) = o;
        const float kv = h2f(proj[(size_t)row * NINP + C_KI + lane]);
        const float mu = wave_sum(kv) * (1.f / ID), d = kv - mu, var = wave_sum(d * d) * (1.f / ID);
        kn[(size_t)row * ID + lane] = __builtin_bit_cast(f16s, (f16)(d * rsqrtf(var + EPS) * P.ikg[lane] + P.ikb[lane]));
    }
}

__device__ __forceinline__ void p3_scanA(Frame& F, const Params& P) {
    const float* abuf = (const float*)(P.ws + WS_A); const float* bbuf = (const float*)(P.ws + WS_B); float* agg = (float*)(P.ws + WS_AGG);
    const int gw = F.vcu * NWAVES + F.wave, NGW = F.G * NWAVES;
    for (int it = gw; it < BATCH * 16 * 32; it += NGW) {
        const int b = it >> 9, cg = (it >> 5) & 15, ck = it & 31, ch = cg * 64 + F.lane; const size_t r0 = (size_t)b * SEQ + ck * 64;
        float A = 1.f, H = 0.f;
#pragma unroll 16
        for (int s = 0; s < 64; ++s) { const float a = abuf[(r0 + s) * LRU_W + ch], bb = bbuf[(r0 + s) * LRU_W + ch]; H = a * H + bb; A *= a; }
        agg[((size_t)(b * 32 + ck) * 2 + 0) * LRU_W + ch] = A; agg[((size_t)(b * 32 + ck) * 2 + 1) * LRU_W + ch] = H;
    }
}
__device__ __forceinline__ void p3_scanB(Frame& F, const Params& P) {
    const float* abuf = (const float*)(P.ws + WS_A); const float* bbuf = (const float*)(P.ws + WS_B); const float* agg = (const float*)(P.ws + WS_AGG);
    const f16s* proj = (const f16s*)(P.ws + WS_PROJ); f16s* y = (f16s*)(P.ws + WS_H);
    const int gw = F.vcu * NWAVES + F.wave, NGW = F.G * NWAVES;
    for (int it = gw; it < BATCH * 16 * 32; it += NGW) {
        const int b = it >> 9, cg = (it >> 5) & 15, ck = it & 31, ch = cg * 64 + F.lane; const size_t r0 = (size_t)b * SEQ + ck * 64;
        float h = 0.f;
        for (int k = 0; k < ck; ++k) h = agg[((size_t)(b * 32 + k) * 2 + 0) * LRU_W + ch] * h + agg[((size_t)(b * 32 + k) * 2 + 1) * LRU_W + ch];
#pragma unroll 16
        for (int s = 0; s < 64; ++s) { h = abuf[(r0 + s) * LRU_W + ch] * h + bbuf[(r0 + s) * LRU_W + ch];
            y[(r0 + s) * DM + ch] = __builtin_bit_cast(f16s, (f16)(h * siluf_(h2f(proj[(r0 + s) * NINP + C_GA + ch])))); }
    }
}
constexpr int AF_OFF = 0;
constexpr int TAB_OFF = RING_BYTES + 1024;
constexpr int IL_OFF = TAB_OFF;
constexpr int SGT_OFF = IL_OFF + 8192;
constexpr int CNT_OFF = SGT_OFF + 1024;
constexpr int WCNT_OFF = CNT_OFF + 128;
constexpr int CNTQ_OFF = WCNT_OFF + 256;
constexpr int BIAS_OFF = CNTQ_OFF + 64;
constexpr int MM_OFF = BIAS_OFF + 4224;
constexpr int NEED_OFF = MM_OFF + 128;
constexpr int SELB_OFF = NEED_OFF + 128;
constexpr int WC2_OFF = SELB_OFF + 64;
constexpr int TAB_END = WC2_OFF + 512;
constexpr int HIST_OFF = 36864;
static_assert(TAB_END <= LDS_BYTES, "LDS map");
typedef short v4i16 __attribute__((ext_vector_type(4)));
typedef _Float16 h4v __attribute__((ext_vector_type(4)));

__device__ __forceinline__ unsigned fkey(float f) { const unsigned u = __float_as_uint(f); return (u & 0x80000000u) ? ~u : (u | 0x80000000u); }
__device__ __forceinline__ float finv(unsigned k) { return __uint_as_float((k & 0x80000000u) ? (k ^ 0x80000000u) : ~k); }
__device__ __forceinline__ unsigned rowsum16(unsigned v) { v += __shfl_xor(v, 1); v += __shfl_xor(v, 2); v += __shfl_xor(v, 4); v += __shfl_xor(v, 8); return v; }

template <int MODE> __device__ __forceinline__ void p3_d1(Frame& F, const Params& P, int b, int i) {
    const f16s* proj = (const f16s*)(P.ws + WS_PROJ); const f16s* kn = (const f16s*)(P.ws + WS_KN);
    int tid = F.tid; asm volatile("" : "+v"(tid));
    const int lane = tid & 63, wave = F.wave, q = lane >> 4, fr = lane & 15;
    const int row0 = b * SEQ + 16 * i, ntile = i + 1;
    LAS unsigned char* AF = F.lds + AF_OFF;
    LAS float* SGT = (LAS float*)(F.lds + SGT_OFF);
    LAS unsigned* CNT = (LAS unsigned*)(F.lds + CNT_OFF);
    LAS unsigned* WCNT = (LAS unsigned*)(F.lds + WCNT_OFF);
    LAS unsigned* CNTQ = (LAS unsigned*)(F.lds + CNTQ_OFF);
    LAS unsigned short* IL = (LAS unsigned short*)(F.lds + IL_OFF);
#pragma unroll
    for (int e = 0; e < 4; ++e) { const int f = tid + NT * e, h = f >> 7, ks = (f >> 6) & 1, ln = f & 63, r = ln & 15, kq = ln >> 4;
        const f16s* rowp = proj + (size_t)(row0 + r) * NINP;
        const h8 v = *(const GAS h8*)(rowp + C_QI + h * 64 + 32 * ks + 8 * kq); const float w = fabsf(h2f(rowp[C_WI + h]));
        h8 o;
#pragma unroll
        for (int j = 0; j < 8; ++j) o[j] = (f16)((float)v[j] * w);
        *(LAS h8*)(AF + (h * 2 + ks) * 1024 + ln * 16) = o; }
    if (tid < 128) { const int ks = tid >> 6, ln = tid & 63, r = ln & 15, kq = ln >> 4; const f16s* rowp = proj + (size_t)(row0 + r) * NINP;
        float acc[8];
#pragma unroll
        for (int j = 0; j < 8; ++j) acc[j] = 0.f;
        h8 vv[IH]; h8 wv0 = *(const GAS h8*)(rowp + C_WI), wv1 = *(const GAS h8*)(rowp + C_WI + 8);
#pragma unroll
        for (int h = 0; h < IH; ++h) vv[h] = *(const GAS h8*)(rowp + C_QI + h * 64 + 32 * ks + 8 * kq);
#pragma unroll
        for (int h = 0; h < IH; ++h) { const float w = (float)(h < 8 ? wv0[h & 7] : wv1[h & 7]);
#pragma unroll
            for (int j = 0; j < 8; ++j) acc[j] += (float)vv[h][j] * w; }
        h8 o;
#pragma unroll
        for (int j = 0; j < 8; ++j) o[j] = (f16)acc[j];
        *(LAS h8*)(AF + (32 + ks) * 1024 + ln * 16) = o; }
    if (tid < 256) { const int r = tid >> 4, h = tid & 15; SGT[h * 16 + r] = h2f(proj[(size_t)(row0 + r) * NINP + C_WI + h]) >= 0.f ? 1.f : -1.f; }
    if (tid < 24) CNT[tid] = 0u;
    if (tid < 32) ((LAS unsigned*)(F.lds + MM_OFF))[tid] = (tid & 1) ? 0u : 0xFFFFFFFFu;
    if (tid < 16) ((LAS unsigned*)(F.lds + NEED_OFF))[tid] = (unsigned)TOPK;
    __syncthreads();
    unsigned key[16][4];
    const f32x4 zero4 = {0.f, 0.f, 0.f, 0.f};
#pragma unroll
    for (int p = 0; p < 4; ++p) {
        f32x4 sc[4] = {zero4, zero4, zero4, zero4};
        if (wave + 32 * p < ntile) {
            h8 bk[4][2];
#pragma unroll
            for (int jj = 0; jj < 4; ++jj) { int kt = wave + 8 * (4 * p + jj); kt = kt < ntile ? kt : ntile - 1;
                const f16s* kr = kn + ((size_t)b * SEQ + 16 * kt + fr) * ID + 8 * q; bk[jj][0] = *(const GAS h8*)kr; bk[jj][1] = *(const GAS h8*)(kr + 32); }
            h8 a0 = *(const LAS h8*)(AF + lane * 16), a1 = *(const LAS h8*)(AF + 1024 + lane * 16);
            f32x4 sg = *(const LAS f32x4*)(SGT + 4 * q);
#pragma unroll
            for (int h = 0; h <= IH; ++h) {
                h8 n0 = a0, n1 = a1; f32x4 ng = sg;
                if (h < IH) { n0 = *(const LAS h8*)(AF + (2 * h + 2) * 1024 + lane * 16); n1 = *(const LAS h8*)(AF + (2 * h + 3) * 1024 + lane * 16); if (h + 1 < IH) ng = *(const LAS f32x4*)(SGT + (h + 1) * 16 + 4 * q); }
#pragma unroll
                for (int jj = 0; jj < 4; ++jj) { f32x4 S = __builtin_amdgcn_mfma_f32_16x16x32_f16(a0, bk[jj][0], zero4, 0, 0, 0); S = __builtin_amdgcn_mfma_f32_16x16x32_f16(a1, bk[jj][1], S, 0, 0, 0);
                    if (h < IH) {
#pragma unroll
                        for (int e = 0; e < 4; ++e) sc[jj][e] = __builtin_fmaf(__builtin_fabsf(S[e]), sg[e], sc[jj][e]);
                    } else sc[jj] += S; }
                asm volatile("" : "+v"(sc[0]), "+v"(sc[1]), "+v"(sc[2]), "+v"(sc[3]));
                __builtin_amdgcn_sched_barrier(0);
                a0 = n0; a1 = n1; sg = ng;
            }
            __builtin_amdgcn_sched_barrier(0);
        }
#pragma unroll
        for (int jj = 0; jj < 4; ++jj) { const int kt = wave + 8 * (4 * p + jj);
#pragma unroll
            for (int e = 0; e < 4; ++e) { const bool valid = (kt < i) || (kt == i && fr <= 4 * q + e); key[4 * p + jj][e] = valid ? fkey(sc[jj][e]) : 0u; } }
        __builtin_amdgcn_sched_barrier(0);
    }
    LAS unsigned* MM = (LAS unsigned*)(F.lds + MM_OFF);
    LAS unsigned* NEED = (LAS unsigned*)(F.lds + NEED_OFF);
    LAS unsigned* SELB = (LAS unsigned*)(F.lds + SELB_OFF);
    LAS unsigned* HIST = (LAS unsigned*)(F.lds + HIST_OFF);
    LAS unsigned* WC2 = (LAS unsigned*)(F.lds + WC2_OFF);
    bool all[4];
#pragma unroll
    for (int e = 0; e < 4; ++e) all[e] = (16 * i + 4 * q + e + 1) <= TOPK;
    {   unsigned kmn[4] = {0xFFFFFFFFu, 0xFFFFFFFFu, 0xFFFFFFFFu, 0xFFFFFFFFu}, kmx[4] = {0u, 0u, 0u, 0u};
#pragma unroll
        for (int j = 0; j < 16; ++j)
#pragma unroll
            for (int e = 0; e < 4; ++e) { const unsigned k = key[j][e]; kmx[e] = k > kmx[e] ? k : kmx[e]; const unsigned k1 = k ? k : 0xFFFFFFFFu; kmn[e] = k1 < kmn[e] ? k1 : kmn[e]; }
#pragma unroll
        for (int e = 0; e < 4; ++e) {
#pragma unroll
            for (int o = 1; o < 16; o <<= 1) { const unsigned a = __shfl_xor(kmn[e], o), bq = __shfl_xor(kmx[e], o); kmn[e] = a < kmn[e] ? a : kmn[e]; kmx[e] = bq > kmx[e] ? bq : kmx[e]; }
            if (fr == 0) { __hip_atomic_fetch_min(&MM[2 * (4 * q + e)], kmn[e], __ATOMIC_RELAXED, __HIP_MEMORY_SCOPE_WORKGROUP); __hip_atomic_fetch_max(&MM[2 * (4 * q + e) + 1], kmx[e], __ATOMIC_RELAXED, __HIP_MEMORY_SCOPE_WORKGROUP); } }
    }
    __syncthreads();
    {   float mnf[4], scl[4];
#pragma unroll
        for (int e = 0; e < 4; ++e) { mnf[e] = finv(MM[2 * (4 * q + e)]); const float rng = finv(MM[2 * (4 * q + e) + 1]) - mnf[e]; scl[e] = rng > 0.f ? 16777215.f / rng : 0.f; }
#pragma unroll
        for (int j = 0; j < 16; ++j)
#pragma unroll
            for (int e = 0; e < 4; ++e) { const unsigned k = key[j][e]; unsigned u = (unsigned)((finv(k) - mnf[e]) * scl[e]); u = u > 16777215u ? 16777215u : u; key[j][e] = k ? u : 0xFFFFFFFFu; }
    }
    unsigned prefix[4] = {0u, 0u, 0u, 0u};
#pragma unroll
    for (int rd = 0; rd < (MODE == 8 ? 0 : 3); ++rd) {
        const int sh = 16 - 8 * rd;
#pragma unroll
        for (int k = 0; k < 8; ++k) HIST[tid + NT * k] = 0u;
        __syncthreads();
#pragma unroll
        for (int j = 0; j < 16; ++j)
#pragma unroll
            for (int e = 0; e < 4; ++e) { const unsigned u = key[j][e]; LAS unsigned* hp = &HIST[(4 * q + e) * 256 + ((u >> sh) & 255u)];
                if (rd == 0) __hip_atomic_fetch_add(hp, u != 0xFFFFFFFFu ? 1u : 0u, __ATOMIC_RELAXED, __HIP_MEMORY_SCOPE_WORKGROUP);
                else { const bool match = (u != 0xFFFFFFFFu) && ((u >> (sh + 8)) == prefix[e]); if (__any(match)) { if (match) __hip_atomic_fetch_add(hp, 1u, __ATOMIC_RELAXED, __HIP_MEMORY_SCOPE_WORKGROUP); } } }
        __syncthreads();
#pragma unroll
        for (int q2 = 0; q2 < 2; ++q2) { const int Q = 2 * wave + q2;
            const v4u h = *(const LAS v4u*)(HIST + Q * 256 + 4 * lane);
            const unsigned s4 = h.x + h.y + h.z + h.w; unsigned T = s4;
#pragma unroll
            for (int o = 1; o < 64; o <<= 1) { const unsigned t_ = __shfl_down(T, o); T += (lane + o < 64) ? t_ : 0u; }
            const unsigned above = T - s4, need = NEED[(rd & 1) * 16 + Q];
            if (above < need && need <= T) { unsigned cum = above, bsel, rem;
                if (need <= cum + h.w) { bsel = 3u; rem = need - cum; } else { cum += h.w;
                    if (need <= cum + h.z) { bsel = 2u; rem = need - cum; } else { cum += h.z;
                        if (need <= cum + h.y) { bsel = 1u; rem = need - cum; } else { cum += h.y; bsel = 0u; rem = need - cum; } } }
                SELB[Q] = 4u * lane + bsel; NEED[((rd + 1) & 1) * 16 + Q] = rem; } }
        __syncthreads();
#pragma unroll
        for (int e = 0; e < 4; ++e) prefix[e] = (prefix[e] << 8) | SELB[4 * q + e];
    }
    {
        unsigned nf[4];
#pragma unroll
        for (int e = 0; e < 4; ++e) nf[e] = NEED[16 + 4 * q + e];
        unsigned g01 = 0u, g23 = 0u, e01 = 0u, e23 = 0u;
#pragma unroll
        for (int j = 0; j < 16; ++j) {
            bool gt[4], eq[4];
#pragma unroll
            for (int e = 0; e < 4; ++e) { const unsigned u = key[j][e]; const bool valid = u != 0xFFFFFFFFu; gt[e] = valid && (all[e] || u > prefix[e]); eq[e] = valid && !all[e] && u == prefix[e]; }
            g01 += (gt[0] ? 1u : 0u) + (gt[1] ? 0x10000u : 0u); g23 += (gt[2] ? 1u : 0u) + (gt[3] ? 0x10000u : 0u);
            e01 += (eq[0] ? 1u : 0u) + (eq[1] ? 0x10000u : 0u); e23 += (eq[2] ? 1u : 0u) + (eq[3] ? 0x10000u : 0u); }
        g01 = rowsum16(g01); g23 = rowsum16(g23); e01 = rowsum16(e01); e23 = rowsum16(e23);
        if (fr == 0) { LAS unsigned* w = WC2 + (wave * 4 + q) * 4; w[0] = g01; w[1] = g23; w[2] = e01; w[3] = e23; }
        __syncthreads();
        unsigned bg01 = 0u, bg23 = 0u, be01 = 0u, be23 = 0u, tg01 = 0u, tg23 = 0u;
#pragma unroll
        for (int w = 0; w < NWAVES; ++w) { const v4u x = *(const LAS v4u*)(WC2 + (w * 4 + q) * 4); tg01 += x.x; tg23 += x.y; if (w < wave) { bg01 += x.x; bg23 += x.y; be01 += x.z; be23 += x.w; } }
        unsigned gbase[4] = {bg01 & 0xFFFFu, bg01 >> 16, bg23 & 0xFFFFu, bg23 >> 16}, ebase[4] = {be01 & 0xFFFFu, be01 >> 16, be23 & 0xFFFFu, be23 >> 16};
        const unsigned gtot[4] = {tg01 & 0xFFFFu, tg01 >> 16, tg23 & 0xFFFFu, tg23 >> 16};
        if (wave == 0 && fr == 0) {
#pragma unroll
            for (int e = 0; e < 4; ++e) CNTQ[4 * q + e] = all[e] ? (gtot[e] < (unsigned)TOPK ? gtot[e] : (unsigned)TOPK) : (unsigned)TOPK; }
        const unsigned ltmask = (1u << fr) - 1u;
#pragma unroll
        for (int j = 0; j < 16; ++j)
#pragma unroll
            for (int e = 0; e < 4; ++e) { const unsigned u = key[j][e]; const bool valid = u != 0xFFFFFFFFu; const bool gt = valid && (all[e] || u > prefix[e]), eq = valid && !all[e] && u == prefix[e];
                const unsigned kidx = 16 * (wave + 8 * j) + fr;
                { const unsigned long long m = __ballot(gt); const unsigned sub = (unsigned)(m >> (16 * q)) & 0xFFFFu; const unsigned pos = gbase[e] + __builtin_popcount(sub & ltmask);
                  if (gt && pos < (unsigned)TOPK) IL[(4 * q + e) * TOPK + pos] = (unsigned short)kidx; gbase[e] += __builtin_popcount(sub); }
                if (__any(eq)) { const unsigned long long m = __ballot(eq); const unsigned sub = (unsigned)(m >> (16 * q)) & 0xFFFFu; const unsigned rk = ebase[e] + __builtin_popcount(sub & ltmask);
                  if (eq && rk < nf[e] && gtot[e] + rk < (unsigned)TOPK) IL[(4 * q + e) * TOPK + gtot[e] + rk] = (unsigned short)kidx; ebase[e] += __builtin_popcount(sub); } }
    }
    __syncthreads();
}

__device__ __forceinline__ void attn_query_naive(Frame& F, const Params& P, int row, const LAS unsigned short* il, int cnt) {
    const f16s* proj = (const f16s*)(P.ws + WS_PROJ); const f16s* cn = (const f16s*)(P.ws + WS_CN);
    const f16s* qabs = (const f16s*)(P.ws + WS_QABS); f16s* y = (f16s*)(P.ws + WS_H);
    LAS float* qa = (LAS float*)(F.lds + 40960);
    LAS float* lg = qa + 2048;
    LAS float* os = lg + 2048;
    int tid = F.tid; asm volatile("" : "+v"(tid));
    const int lane = tid & 63, wave = F.wave;
    const int b = row >> 11, t = row & (SEQ - 1);
#pragma unroll
    for (int k = 0; k < 4; ++k) qa[tid + NT * k] = h2f(qabs[(size_t)row * (NH * CL) + tid + NT * k]);
    __syncthreads();
    {   const int j = tid & 255, hh = tid >> 8, s = j < cnt ? (int)il[j] : -1;
        float l[4] = {0.f, 0.f, 0.f, 0.f};
        if (s >= 0) {
            const GAS h8* cr = (const GAS h8*)(cn + ((size_t)b * SEQ + s) * CL);
            for (int c8 = 0; c8 < CL / 8; ++c8) { const h8 v = cr[c8];
#pragma unroll
                for (int e = 0; e < 8; ++e) { const float cv = (float)v[e];
#pragma unroll
                    for (int h = 0; h < 4; ++h) l[h] += qa[(hh * 4 + h) * CL + c8 * 8 + e] * cv; } }
            const int dist = t - s, bk = dist < 128 ? (int)BUCKET[dist] : 31;
#pragma unroll
            for (int h = 0; h < 4; ++h) l[h] = l[h] * 0.08838834764831845f + P.rel_bias[bk * NH + hh * 4 + h];
        } else {
#pragma unroll
            for (int h = 0; h < 4; ++h) l[h] = -INFINITY;
        }
#pragma unroll
        for (int h = 0; h < 4; ++h) lg[(hh * 4 + h) * TOPK + j] = l[h];
    }
    __syncthreads();
    {   float v[4], mx = -INFINITY;
#pragma unroll
        for (int k = 0; k < 4; ++k) { v[k] = lg[wave * TOPK + lane + 64 * k]; mx = fmaxf(mx, v[k]); }
        mx = wave_max(mx);
        float sm = 0.f;
#pragma unroll
        for (int k = 0; k < 4; ++k) { v[k] = expf(v[k] - mx); sm += v[k]; }
        const float inv = 1.f / wave_sum(sm);
#pragma unroll
        for (int k = 0; k < 4; ++k) lg[wave * TOPK + lane + 64 * k] = v[k] * inv;
    }
    __syncthreads();
    {   const int c = tid & 255, hh = tid >> 8;
        float o[4] = {0.f, 0.f, 0.f, 0.f};
        for (int j = 0; j < cnt; ++j) { const int s = il[j];
            const float cv = h2f(cn[((size_t)b * SEQ + s) * CL + c]);
#pragma unroll
            for (int h = 0; h < 4; ++h) o[h] += lg[(hh * 4 + h) * TOPK + j] * cv; }
#pragma unroll
        for (int h = 0; h < 4; ++h) os[(hh * 4 + h) * CL + c] = o[h];
    }
    __syncthreads();
#pragma unroll
    for (int k = 0; k < 2; ++k) { const int h = k * 4 + (tid >> 7), d = tid & 127;
        const float* wv = P.w_uv + (size_t)h * CL * HD + d; float acc = 0.f;
        for (int c = 0; c < CL; ++c) acc += os[h * CL + c] * wv[(size_t)c * HD];
        const float gb = h2f(proj[(size_t)row * NINP + C_GB + h * HD + d]);
        y[(size_t)row * DM + LRU_W + h * HD + d] = __builtin_bit_cast(f16s, (f16)(acc * siluf_(gb))); }
    __syncthreads();
}


__device__ __forceinline__ void glds16(const void* gsrc, unsigned lds_dst) { unsigned keep;
    asm volatile("s_mov_b32 %0, m0\n\ts_mov_b32 m0, %2\n\ts_nop 0\n\tglobal_load_lds_dwordx4 %1, off\n\ts_mov_b32 m0, %0" : "=&s"(keep) : "v"(gsrc), "s"(lds_dst) : "memory"); }
template <int MODE> __device__ __forceinline__ void p3_d2_query(const Params& P, LAS unsigned char* lds, LAS unsigned char* buf, int lane, int b, int t, int row, int r) {
    const f16s* cn = (const f16s*)(P.ws + WS_CN); const f16s* qabs = (const f16s*)(P.ws + WS_QABS); f16s* obuf = (f16s*)P.out;
    const LAS unsigned short* il = (const LAS unsigned short*)(lds + IL_OFF) + r * TOPK;
    const LAS float* BIAS = (const LAS float*)(lds + BIAS_OFF);
    const int cnt = (int)((const LAS unsigned*)(lds + CNTQ_OFF))[r];
    const int q = lane >> 4, fr = lane & 15;
    h8 qb[8];
    { const f16s* qp = qabs + (size_t)row * (NH * CL) + (fr & 7) * CL + 8 * q;
#pragma unroll
      for (int ks = 0; ks < 8; ++ks) qb[ks] = *(const GAS h8*)(qp + 32 * ks); }
    asm volatile("" :: "v"(qb[0]), "v"(qb[1]), "v"(qb[2]), "v"(qb[3]), "v"(qb[4]), "v"(qb[5]), "v"(qb[6]), "v"(qb[7]));
    const unsigned bufaddr = (unsigned)__builtin_amdgcn_readfirstlane((int)(unsigned)(size_t)buf);
    const char* cnb = (const char*)(cn + (size_t)b * SEQ * CL) + 16 * ((lane & 15) ^ (q << 2));
    auto issue = [&](int c) {
        const unsigned dst = bufaddr + (unsigned)(c & 1) * 8192u;
        if (MODE == 1) return;
#pragma unroll
        for (int kq = 0; kq < 4; ++kq) { int pos = 16 * c + 4 * kq + q; pos = pos < cnt ? pos : 0;
            const char* src = cnb + (size_t)(MODE ? (il[pos] & 2047) : il[pos]) * (CL * 2);
            const char* s2 = (const char*)((size_t)src ^ (size_t)(16 * kq));
            glds16(s2, dst + kq * 1024); glds16(s2 + 256, dst + 4096 + kq * 1024); }
    };
    const int roff0 = 256 * fr + 64 * (fr & 3) + 16 * (q ^ ((fr >> 2) & 3));
    const int qq = fr >> 2, pp = fr & 3;
    const int trb = 256 * (4 * q + qq) + 16 * ((((pp >> 1) ^ (q & 1)) | (q & 2)) ^ (qq << 2)) + 8 * (pp & 1);
    f32x4 Y[16];
    const f32x4 zero4 = {0.f, 0.f, 0.f, 0.f};
#pragma unroll
    for (int ct = 0; ct < 16; ++ct) Y[ct] = zero4;
    float m = -INFINITY, ssum = 0.f;
    issue(0);
#pragma unroll 1
    for (int c = 0; c < 16; ++c) {
        if (c + 1 < 16) { issue(c + 1); asm volatile("s_waitcnt vmcnt(8)" ::: "memory"); }
        else asm volatile("s_waitcnt vmcnt(0)" ::: "memory");
        const LAS unsigned char* bb = buf + (c & 1) * 8192;
        if (MODE == 2 || MODE == 6 || MODE == 7) continue;
        f32x4 X = zero4;
        {   h8 a[8];
#pragma unroll
            for (int s = 0; s < 8; ++s) a[s] = *(const LAS h8*)(bb + (s >> 2) * 4096 + (roff0 ^ (64 * (s & 3))));
            asm volatile("" : "+v"(a[0]), "+v"(a[1]), "+v"(a[2]), "+v"(a[3]), "+v"(a[4]), "+v"(a[5]), "+v"(a[6]), "+v"(a[7]));
#pragma unroll
            for (int s = 0; s < 8; ++s) X = __builtin_amdgcn_mfma_f32_16x16x32_f16(a[s], qb[s], X, 0, 0, 0); }
        float l[4];
        {   const v4i16 kk = *(const LAS v4i16*)(il + 16 * c + 4 * q);
            float bs[4];
#pragma unroll
            for (int e = 0; e < 4; ++e) { int d = t - (int)(unsigned short)kk[e]; d = d < 0 ? 0 : (d > 128 ? 128 : d); bs[e] = BIAS[d * 8 + (fr & 7)]; }
            asm volatile("" : "+v"(bs[0]), "+v"(bs[1]), "+v"(bs[2]), "+v"(bs[3]));
#pragma unroll
            for (int e = 0; e < 4; ++e) { const int pa = 16 * c + 4 * q + e; l[e] = pa < cnt ? X[e] * 0.08838834764831845f + bs[e] : -INFINITY; } }
        float mx = fmaxf(fmaxf(l[0], l[1]), fmaxf(l[2], l[3]));
        if (c == 0) { mx = fmaxf(mx, __shfl_xor(mx, 16)); mx = fmaxf(mx, __shfl_xor(mx, 32)); m = mx; }
        else if (__any(mx > m + 8.f)) {
            mx = fmaxf(mx, __shfl_xor(mx, 16)); mx = fmaxf(mx, __shfl_xor(mx, 32));
            const float mn = fmaxf(m, mx), al = __expf(m - mn);
#pragma unroll
            for (int ct = 0; ct < 16; ++ct) Y[ct] *= al;
            ssum *= al; m = mn; }
        h8 pbl, pbh;
#pragma unroll
        for (int e = 0; e < 4; ++e) { const float p = __expf(l[e] - m); ssum += p; pbl[e] = (f16)p; pbl[4 + e] = (f16)0.f; pbh[e] = (f16)0.f; pbh[4 + e] = (f16)p; }
        if (MODE == 3) continue;
#pragma unroll
        for (int g = 0; g < 2; ++g) {
            v4i16 tv[8];
#pragma unroll
            for (int j = 0; j < 8; ++j) { const int ct = 8 * g + j; tv[j] = __builtin_amdgcn_ds_read_tr16_b64_v4i16((LAS v4i16*)(bb + (ct >> 3) * 4096 + (trb ^ (32 * (ct & 7))))); }
#pragma unroll
            for (int j = 0; j < 8; j += 2) { h8 a2 = __builtin_bit_cast(h8, __builtin_shufflevector(tv[j], tv[j + 1], 0, 1, 2, 3, 4, 5, 6, 7));
                asm volatile("" : "+v"(a2));
                Y[8 * g + j] = __builtin_amdgcn_mfma_f32_16x16x32_f16(a2, pbl, Y[8 * g + j], 0, 0, 0);
                Y[8 * g + j + 1] = __builtin_amdgcn_mfma_f32_16x16x32_f16(a2, pbh, Y[8 * g + j + 1], 0, 0, 0); }
        }
    }
    ssum += __shfl_xor(ssum, 16); ssum += __shfl_xor(ssum, 32);
    const float inv = 1.f / ssum;
    if (fr < 8) { f16s* op = obuf + (size_t)row * (NH * CL) + fr * CL + 4 * q;
#pragma unroll
        for (int ct = 0; ct < 16; ++ct) { v2u o; o.x = pkh(Y[ct][0] * inv, Y[ct][1] * inv); o.y = pkh(Y[ct][2] * inv, Y[ct][3] * inv); *(GAS v2u*)(op + 16 * ct) = o; } }
}

__device__ __forceinline__ void p3_v_stream(Frame& F, const Params& P) {
    const f16s* obuf = (const f16s*)P.out; const f16s* proj = (const f16s*)(P.ws + WS_PROJ); f16s* y = (f16s*)(P.ws + WS_H);
    int lane = F.lane; asm volatile("" : "+v"(lane));
    const int q = lane >> 4, fr = lane & 15, gw = F.vcu * NWAVES + F.wave, NGW = F.G * NWAVES, role = gw & 31, h = role >> 2, nq = role & 3;
    h8 W[2][8];
    { const f16s* wp = (const f16s*)(P.ws + WS_WUVT) + ((size_t)h * HD + nq * 32 + fr) * CL + 8 * q;
#pragma unroll
      for (int nt = 0; nt < 2; ++nt)
#pragma unroll
          for (int ks = 0; ks < 8; ++ks) W[nt][ks] = *(const GAS h8*)(wp + (size_t)nt * 16 * CL + 32 * ks); }
    const f32x4 zero4 = {0.f, 0.f, 0.f, 0.f};
    h8 ob[8], on[8];
    int rt = gw >> 5; const int step = NGW >> 5;
    if (rt < M / 16) {
        { const f16s* op = obuf + (size_t)(rt * 16 + fr) * (NH * CL) + h * CL + 8 * q;
#pragma unroll
          for (int ks = 0; ks < 8; ++ks) ob[ks] = *(const GAS h8*)(op + 32 * ks); }
        for (;;) {
            const int nx = rt + step; const bool more = nx < M / 16;
            if (more) { const f16s* op = obuf + (size_t)(nx * 16 + fr) * (NH * CL) + h * CL + 8 * q;
#pragma unroll
                for (int ks = 0; ks < 8; ++ks) on[ks] = *(const GAS h8*)(op + 32 * ks); }
            const int row = rt * 16 + fr; const size_t col0 = (size_t)h * HD + nq * 32 + 4 * q;
            h4v g[2];
#pragma unroll
            for (int nt = 0; nt < 2; ++nt) g[nt] = *(const GAS h4v*)(proj + (size_t)row * NINP + C_GB + col0 + 16 * nt);
#pragma unroll
            for (int nt = 0; nt < 2; ++nt) { f32x4 acc = zero4;
#pragma unroll
                for (int ks = 0; ks < 8; ++ks) acc = __builtin_amdgcn_mfma_f32_16x16x32_f16(W[nt][ks], ob[ks], acc, 0, 0, 0);
                v2u o; o.x = pkh(acc[0] * siluf_((float)g[nt][0]), acc[1] * siluf_((float)g[nt][1])); o.y = pkh(acc[2] * siluf_((float)g[nt][2]), acc[3] * siluf_((float)g[nt][3]));
                *(GAS v2u*)(y + (size_t)row * DM + LRU_W + col0 + 16 * nt) = o; }
            if (!more) break;
#pragma unroll
            for (int ks = 0; ks < 8; ++ks) ob[ks] = on[ks];
            rt = nx;
        }
    }
}

template <int MODE> __device__ __forceinline__ void p3_items(Frame& F, const Params& P) {
    {
        LAS float* BIAS = (LAS float*)(F.lds + BIAS_OFF);
        for (int e = F.tid; e < 129 * 8; e += NT) { const int d = e >> 3, h = e & 7; BIAS[e] = P.rel_bias[(d < 128 ? (int)BUCKET[d] : 31) * NH + h]; }
    }
    __syncthreads();
#ifndef PROBE_D
#define PROBE_D 0
#endif
    unsigned long long acc_[4] = {0ull, 0ull, 0ull, 0ull};
    for (int u = F.vcu; u < BATCH * (SEQ / 16); u += F.G) {
        const int up = u & 255, k = u >> 8, b = up >> 6, j = up & 63, i = k ? 127 - j : j;
        unsigned long long t0_ = PROBE_D ? __builtin_amdgcn_s_memrealtime() : 0ull;
        if (MODE != 5) p3_d1<MODE>(F, P, b, i);
        unsigned long long t1_ = PROBE_D ? __builtin_amdgcn_s_memrealtime() : 0ull;
        int lane = F.lane; asm volatile("" : "+v"(lane));
        LAS unsigned char* buf = F.lds + F.wave * 16384;
        if (MODE != 4 && MODE != 8)
#pragma unroll 1
        for (int rr = 0; rr < 2; ++rr) { const int r = 2 * F.wave + rr; p3_d2_query<MODE>(P, F.lds, buf, lane, b, 16 * i + r, b * SEQ + 16 * i + r, r); }
        asm volatile("s_waitcnt vmcnt(0)" ::: "memory");
        __syncthreads();
        unsigned long long t2_ = PROBE_D ? __builtin_amdgcn_s_memrealtime() : 0ull;
        unsigned long long t3_ = PROBE_D ? __builtin_amdgcn_s_memrealtime() : 0ull;
        acc_[1] += t1_ - t0_; acc_[2] += t2_ - t1_; acc_[3] += t3_ - t2_;
    }
    if (PROBE_D && PROBE_D < 4 && blockIdx.x == 0) { const unsigned long long t1 = __builtin_amdgcn_s_memrealtime(); while (__builtin_amdgcn_s_memrealtime() - t1 < acc_[PROBE_D]) __builtin_amdgcn_s_sleep(8); }
    if (PROBE_D >= 4 && F.tid == 0) { const unsigned tot = (unsigned)(acc_[1] + acc_[2] + acc_[3]), d1 = (unsigned)acc_[1], d2 = (unsigned)acc_[2];
        __hip_atomic_fetch_max((unsigned*)(F.ctl + 8), tot, __ATOMIC_RELAXED, __HIP_MEMORY_SCOPE_AGENT); __hip_atomic_fetch_add((unsigned*)(F.ctl + 9), tot, __ATOMIC_RELAXED, __HIP_MEMORY_SCOPE_AGENT);
        __hip_atomic_fetch_max((unsigned*)(F.ctl + 10), d1, __ATOMIC_RELAXED, __HIP_MEMORY_SCOPE_AGENT); __hip_atomic_fetch_max((unsigned*)(F.ctl + 11), d2, __ATOMIC_RELAXED, __HIP_MEMORY_SCOPE_AGENT);
        __hip_atomic_fetch_add((unsigned*)(F.ctl + 12), d1, __ATOMIC_RELAXED, __HIP_MEMORY_SCOPE_AGENT); __hip_atomic_fetch_add((unsigned*)(F.ctl + 13), d2, __ATOMIC_RELAXED, __HIP_MEMORY_SCOPE_AGENT); }
}

__device__ __forceinline__ void p5_final(Frame& F, const Params& P) {
    const int gw = F.vcu * NWAVES + F.wave, NGW = F.G * NWAVES, lane = F.lane;
    for (int m = gw; m < M; m += NGW) {
        GAS f32x4* xr = (GAS f32x4*)(P.out + (size_t)m * DM) + lane; const GAS f32x4* gr = (const GAS f32x4*)P.fin_g + lane;
        f32x4 v[8]; float s = 0.f;
#pragma unroll
        for (int j = 0; j < 8; ++j) { v[j] = xr[64 * j]; s += (v[j].x * v[j].x + v[j].y * v[j].y) + (v[j].z * v[j].z + v[j].w * v[j].w); }
        const float r = rsqrtf(wave_sum(s) * (1.f / DM) + EPS);
#pragma unroll
        for (int j = 0; j < 8; ++j) xr[64 * j] = v[j] * r * gr[64 * j];
    }
}

__global__ void __launch_bounds__(NT, 2) fwd_kernel(Params P) {
    extern __shared__ __attribute__((aligned(16))) unsigned char lds[];
    Frame F;
    F.lds = (LAS unsigned char*)lds;
    F.MISC = (volatile LAS unsigned*)(F.lds + MISC_OFF);
    F.tid = threadIdx.x; F.lane = F.tid & 63; F.wave = __builtin_amdgcn_readfirstlane(F.tid >> 6);
    F.G = gridDim.x; { const int bx = blockIdx.x; F.vcu = (F.G % 8 == 0) ? (bx % 8) * (F.G / 8) + bx / 8 : bx; }
    F.ctl = (gu32*)(P.ws + WS_CTL);
    for (int u = F.tid; u < (LDS_BYTES - LDSCTL_OFF) / 4; u += NT) ((LAS unsigned*)(F.lds + LDSCTL_OFF))[u] = 0u;
    __syncthreads();
    XcdBarrier bar = xcd_barrier_post((unsigned*)(F.ctl + CW_BAR), F.MISC + 8);
#ifdef PROBE_S
    for (int k_ = 0; k_ < 12; ++k_) F.pt_acc[k_] = 0u;
    F.pt_last = __builtin_amdgcn_s_memrealtime();
#endif

#ifndef PROBE_REP
#define PROBE_REP 0
#endif
#ifndef PROBE_T
#define PROBE_T 0
#endif
    unsigned long long ts_[8]; int nst_ = 0;
#define STAMP() do { if (PROBE_T) { ts_[nst_] = __builtin_amdgcn_s_memrealtime(); } ++nst_; } while (0)
    STAMP();
#if PROBE_REP == 0
#define REP(n)
#else
#define REP(n) for (int rep_ = 0; rep_ < ((PROBE_REP == (n)) ? 2 : 1); ++rep_)
#endif
    REP(1) { p0_prologue(F, P); xcd_barrier(bar); }
    STAMP();
#define P1_BLOCK { pg8::Gemm g{(const pg8::bf16_t*)(P.ws + WS_H), (const pg8::bf16_t*)(P.ws + WS_WIN), M, NINP, DM}; \
        pg8::StaticOrder S; S.init(M, NINP, F.G, (int)blockIdx.x); \
        pg8::EpiF16 E{(pg8::bf16_t*)(P.ws + WS_PROJ), NINP}; \
        pg8::gemm_phase<pg8::EpiF16, pg8::StaticOrder, true, true>(F.lds + RING_OFF, g, S, E); \
        xcd_barrier(bar); }
    P1_BLOCK
    STAMP();
#if PROBE_REP == 2
    P1_BLOCK
#endif
    REP(3) { PSTAMP(F, 11); p2_gates_mfma(F, P); PSTAMP(F, 0); p2_qabs_mfma(F, P); PSTAMP(F, 1); p2_norms(F, P); PSTAMP(F, 2); xcd_barrier(bar); PSTAMP(F, 11); }
    STAMP();
    REP(4) { p3_scanA(F, P); xcd_barrier(bar); p3_scanB(F, P); }
    STAMP();
#ifdef PROBE_M
    p3_items<PROBE_M>(F, P); xcd_barrier(bar);
#endif
    REP(5) { p3_items<0>(F, P); xcd_barrier(bar); p3_v_stream(F, P); xcd_barrier(bar); }
    STAMP();
    REP(6) { const int rep6_ = 0;
        pg8::Gemm g{(const pg8::bf16_t*)(P.ws + WS_H), (const pg8::bf16_t*)(P.ws + WS_WOUT), M, DM, DM};
        pg8::StaticOrder S; S.init(M, DM, F.G, (int)blockIdx.x);
        pg8::EpiResF32 E{P.x, P.out, DM};
        pg8::gemm_phase<pg8::EpiResF32, pg8::StaticOrder, false, true>(F.lds + RING_OFF, g, S, E);
        xcd_barrier(bar);
        if (rep6_ == 0) STAMP();
        p5_final(F, P);
        if (PROBE_REP == 6) xcd_barrier(bar);
    }
#ifdef PROBE_S
    {   if (F.tid == 0) for (int k_ = 0; k_ < 11; ++k_) { __hip_atomic_fetch_max((unsigned*)(F.ctl + 32 + 2 * k_), F.pt_acc[k_], __ATOMIC_RELAXED, __HIP_MEMORY_SCOPE_AGENT); __hip_atomic_fetch_add((unsigned*)(F.ctl + 33 + 2 * k_), F.pt_acc[k_] >> 8, __ATOMIC_RELAXED, __HIP_MEMORY_SCOPE_AGENT); }
        xcd_barrier(bar);
        if (blockIdx.x == 0) { const unsigned v = __hip_atomic_load((unsigned*)(F.ctl + 32 + PROBE_S), RLX_AGENT);
            const unsigned long long t1 = __builtin_amdgcn_s_memrealtime(); while (__builtin_amdgcn_s_memrealtime() - t1 < (unsigned long long)v) __builtin_amdgcn_s_sleep(8); } }
#endif
#ifdef PROBE_D
    if (PROBE_D >= 4) { xcd_barrier(bar);
        if (blockIdx.x == 0) { unsigned v = __hip_atomic_load((unsigned*)(F.ctl + 8 + (PROBE_D - 4)), RLX_AGENT); if (PROBE_D == 5 || PROBE_D == 8 || PROBE_D == 9) v /= 256u;
            const unsigned long long t1 = __builtin_amdgcn_s_memrealtime(); while (__builtin_amdgcn_s_memrealtime() - t1 < (unsigned long long)v) __builtin_amdgcn_s_sleep(8); } }
#endif
    if (PROBE_T) {
        xcd_barrier(bar);
        const unsigned long long t1 = __builtin_amdgcn_s_memrealtime();
        if (PROBE_T == 7) ts_[7] = t1;
        const unsigned long long dt = ts_[PROBE_T] - ts_[PROBE_T - 1];
        if (blockIdx.x == 0) while (__builtin_amdgcn_s_memrealtime() - t1 < dt) __builtin_amdgcn_s_sleep(8);
    }
}

extern "C" void kernel_launch(void* const* d_in, const int* in_sizes, int n_in, void* d_out, int out_size, void* d_ws, size_t ws_size, hipStream_t stream) {
    static int grid = 0;
    if (grid == 0) {
        if (n_in != 18 || out_size != M * DM || ws_size < WS_END) { fprintf(stderr, "kernel_launch: unexpected shapes (n_in %d out %d ws %zu)\n", n_in, out_size, ws_size); grid = -1; return; }
        int dev = 0, cus = 0, per_cu = 0;
        if (hipGetDevice(&dev) != hipSuccess || hipDeviceGetAttribute(&cus, hipDeviceAttributeMultiprocessorCount, dev) != hipSuccess) { grid = -1; return; }
        if (hipFuncSetAttribute((const void*)fwd_kernel, hipFuncAttributeMaxDynamicSharedMemorySize, LDS_BYTES) != hipSuccess) { fprintf(stderr, "kernel_launch: hipFuncSetAttribute failed\n"); grid = -1; return; }
        if (hipOccupancyMaxActiveBlocksPerMultiprocessor(&per_cu, (const void*)fwd_kernel, NT, LDS_BYTES) != hipSuccess || per_cu < 1) fprintf(stderr, "kernel_launch: occupancy query says %d\n", per_cu);
        (void)hipGetLastError();
        grid = cus;
    }
    if (grid < 0) return;
    (void)hipMemsetAsync((char*)d_ws + WS_CTL, 0, CTL_ZERO_BYTES, stream);
    Params p{};
    p.x = (const float*)d_in[0]; p.norm_g = (const float*)d_in[1]; p.w_in = (const float*)d_in[2]; p.conv_w = (const float*)d_in[3]; p.conv_b = (const float*)d_in[4];
    p.wa = (const float*)d_in[5]; p.ba = (const float*)d_in[6]; p.wx = (const float*)d_in[7]; p.bx = (const float*)d_in[8]; p.lam = (const float*)d_in[9];
    p.ckv_g = (const float*)d_in[10]; p.ikg = (const float*)d_in[11]; p.ikb = (const float*)d_in[12]; p.w_uk = (const float*)d_in[13]; p.w_uv = (const float*)d_in[14];
    p.w_out = (const float*)d_in[15]; p.rel_bias = (const float*)d_in[16]; p.fin_g = (const float*)d_in[17];
    p.out = (float*)d_out; p.ws = (unsigned char*)d_ws;
    hipLaunchKernelGGL(fwd_kernel, dim3(grid), dim3(NT), LDS_BYTES, stream, p);
}
```

```cpp
#define PROBE_REP 0
#include <hip/hip_runtime.h>
#include <cstdio>
#include <cstdint>
#ifndef OPT_DMA_ASM
#define OPT_DMA_ASM 1
#endif
namespace pg8 {
#define PG8_LAS __attribute__((address_space(3)))
typedef unsigned short bf16_t;
typedef _Float16 f16x8 __attribute__((ext_vector_type(8)));
typedef _Float16 f16x2 __attribute__((ext_vector_type(2)));
typedef float f32x2 __attribute__((ext_vector_type(2)));
typedef float f32x4 __attribute__((ext_vector_type(4)));
typedef unsigned u32x4 __attribute__((ext_vector_type(4)));
constexpr int BM = 256, BK = 64, HALF = 128, HTB = HALF * BK * 2  , STAGE_BYTES = 8 * HTB, NXCD = 8, WGM = 8;

__host__ __device__ __forceinline__ int lds_byte(int r, int c) { const int st = (r >> 4) * 2 + (c >> 5), rr = r & 15, cc = c & 31, ob = rr * 64 + cc * 2; return st * 1024 + (ob ^ (((ob >> 9) & 1) << 5)); }
__host__ __device__ __forceinline__ void stage_rc(int b, int& R, int& C) { const int st = b / 1024, sb = b % 1024, swz = sb ^ (((sb >> 9) & 1) << 5); R = (st >> 1) * 16 + swz / 64; C = (st & 1) * 32 + (swz % 64) / 2; }
__host__ __device__ __forceinline__ int perm32(int rho) { const int n = rho >> 4, i = rho & 15; return 8 * (i >> 2) + 4 * n + (i & 3); }

struct Unit { int pm, pn; };
struct Gemm { const bf16_t* A; const bf16_t* Bt; int M, N, K; };

struct StaticOrder {
    int nM, nN, nwg, G, c;
    __host__ __device__ void init(int M, int N, int G_, int c_) { nM = M / BM; nN = N / BM; nwg = nM * nN; G = G_; c = c_; }
    __host__ __device__ bool next(int i, Unit& u) const {
        const long L = (long)i * G + c; if (L >= nwg) return false;
        int wgid = (int)L; { const int q = nwg / NXCD, r = nwg % NXCD, xcd = wgid % NXCD, off = wgid / NXCD; wgid = (xcd < r ? xcd * (q + 1) : r * (q + 1) + (xcd - r) * q) + off; }
        const int nig = WGM * nN, gid = wgid / nig, fm = gid * WGM, gsz = (nM - fm) < WGM ? (nM - fm) : WGM;
        u.pm = fm + ((wgid % nig) % gsz); u.pn = (wgid % nig) / gsz; return true;
    }
    __device__ __forceinline__ void a_ready(const Unit&) const {}
    __device__ __forceinline__ void done(const Unit&) const {}
};

__device__ __forceinline__ unsigned cvt_pk_f16(float lo, float hi) { const f32x2 v = {lo, hi}; return __builtin_bit_cast(unsigned, __builtin_convertvector(v, f16x2)); }
struct EpiF16 {
    static constexpr bool PERM = true, AFTER_DRAIN = false;
    bf16_t* O; int ldc;
    __device__ __forceinline__ void operator()(const f32x4 (&acc)[2][2][4][2], const Unit& u, int wr, int wc, int fr, int fq) const {
        const int row0 = u.pm * BM + wr * 64 + fr, col0 = u.pn * BM + wc * 32 + 8 * fq;
#pragma unroll
        for (int ai = 0; ai < 2; ++ai)
#pragma unroll
            for (int m = 0; m < 4; ++m) { bf16_t* rowp = O + (size_t)(row0 + ai * HALF + m * 16) * ldc + col0;
#pragma unroll
                for (int bj = 0; bj < 2; ++bj) { const f32x4 v0 = acc[ai][bj][m][0], v1 = acc[ai][bj][m][1];
                    u32x4 w; w.x = cvt_pk_f16(v0[0], v0[1]); w.y = cvt_pk_f16(v0[2], v0[3]); w.z = cvt_pk_f16(v1[0], v1[1]); w.w = cvt_pk_f16(v1[2], v1[3]);
                    *(u32x4*)(rowp + bj * HALF) = w; } }
    }
};
struct EpiResF32 {
    static constexpr bool PERM = false, AFTER_DRAIN = false;
    const float* base; float* out; int ldc;
    __device__ __forceinline__ void operator()(const f32x4 (&acc)[2][2][4][2], const Unit& u, int wr, int wc, int fr, int fq) const {
        const int row0 = u.pm * BM + wr * 64 + fr, col0 = u.pn * BM + wc * 32 + 4 * fq;
        const float* __restrict__ bp = base; float* __restrict__ op = out;
        f32x4 r[2][2][2];
#define EPI_LOAD(g) do { const size_t off_ = (size_t)(row0 + ((g) >> 2) * HALF + ((g) & 3) * 16) * ldc + col0; _Pragma("unroll") for (int bj = 0; bj < 2; ++bj) _Pragma("unroll") for (int n = 0; n < 2; ++n) r[(g) & 1][bj][n] = *(const f32x4*)(bp + off_ + bj * HALF + n * 16); } while (0)
        EPI_LOAD(0);
#pragma unroll
        for (int g = 0; g < 8; ++g) { const int ai = g >> 2, m = g & 3;
            if (g + 1 < 8) EPI_LOAD(g + 1);
            const size_t off = (size_t)(row0 + ai * HALF + m * 16) * ldc + col0;
#pragma unroll
            for (int bj = 0; bj < 2; ++bj)
#pragma unroll
                for (int n = 0; n < 2; ++n) *(f32x4*)(op + off + bj * HALF + n * 16) = r[g & 1][bj][n] + acc[ai][bj][m][n]; }
#undef EPI_LOAD
    }
};

template <class Epi, class Sched, bool ALIGN_EPI = false, bool SP2 = false>
__device__ __forceinline__ void gemm_phase(PG8_LAS unsigned char* lds, const Gemm g, const Sched& S, const Epi& E) {
    int tid = threadIdx.x; asm volatile("" : "+v"(tid));
    const int wid = __builtin_amdgcn_readfirstlane(tid >> 6), lane = tid & 63, wr = wid >> 2, wc = wid & 3, fr = lane & 15, fq = lane >> 4;
    const int K = g.K, nt = K / BK;
    unsigned voffA[2], voffB[2];
#pragma unroll
    for (int i = 0; i < 2; ++i) { int R, C; stage_rc(tid * 16 + i * 8192, R, C); const int Rb = Epi::PERM ? ((R & ~31) + perm32(R & 31)) : R;
        voffA[i] = (unsigned)(R * K + C) * 2u; voffB[i] = (unsigned)(Rb * K + C) * 2u; }
    const size_t kstep = (size_t)(BK * 2);
    const size_t hstep = (size_t)HALF * K * 2;
    const size_t tstep = 2 * hstep;
    const unsigned ldsw = (unsigned)wid * 1024u;
    const int aoff = lds_byte(wr * 64 + fr, fq * 8), boff = lds_byte(wc * 32 + fr, fq * 8);
#define PG8_SA(b, h) (((b) * 2 + (h)) * HTB)
#define PG8_SB(b, h) ((4 + (b) * 2 + (h)) * HTB)
#define PG8_STAGE(bufoff, gbase, voff) do { _Pragma("unroll") for (int _i = 0; _i < 2; ++_i) \
        __builtin_amdgcn_global_load_lds((const unsigned*)((const char*)(gbase) + (voff)[_i]), (PG8_LAS unsigned*)(lds + (bufoff) + ldsw + _i * 8192), 16, 0, 0); } while (0)
#define PG8_LDA(dst, b, h) do { _Pragma("unroll") for (int m = 0; m < 4; ++m) _Pragma("unroll") for (int k = 0; k < 2; ++k) dst[m][k] = *(const PG8_LAS f16x8*)(lds + PG8_SA(b, h) + aoff + m * 2048 + k * 1024); } while (0)
#define PG8_LDB(dst, b, h) do { _Pragma("unroll") for (int n = 0; n < 2; ++n) _Pragma("unroll") for (int k = 0; k < 2; ++k) dst[n][k] = *(const PG8_LAS f16x8*)(lds + PG8_SB(b, h) + boff + n * 2048 + k * 1024); } while (0)
#define PG8_MMA(ai, bj, At, Bt) do { __builtin_amdgcn_s_setprio(1); _Pragma("unroll") for (int m = 0; m < 4; ++m) _Pragma("unroll") for (int n = 0; n < 2; ++n) _Pragma("unroll") for (int k = 0; k < 2; ++k) \
        acc[ai][bj][m][n] = __builtin_amdgcn_mfma_f32_16x16x32_f16(Bt[n][k], At[m][k], acc[ai][bj][m][n], 0, 0, 0); __builtin_amdgcn_s_setprio(0); } while (0)
#define PG8_WAIT_V(n) asm volatile("s_waitcnt vmcnt(" #n ")" ::: "memory")
#define PG8_WAIT_L(n) asm volatile("s_waitcnt lgkmcnt(" #n ")" ::: "memory")
#define PG8_BAR __builtin_amdgcn_s_barrier()
#define PG8_SCHED __builtin_amdgcn_sched_barrier(0)
    Unit cur, nxt; int ui = 0;
    if (!S.next(0, cur)) return;
    f32x4 acc[2][2][4][2];
#pragma unroll
    for (int a = 0; a < 2; ++a)
#pragma unroll
        for (int b = 0; b < 2; ++b)
#pragma unroll
            for (int m = 0; m < 4; ++m)
#pragma unroll
                for (int n = 0; n < 2; ++n) acc[a][b][m][n] = (f32x4){0.f, 0.f, 0.f, 0.f};
    f16x8 At[4][2], B0[2][2], B1[2][2];
    const char* cA = (const char*)g.A + (size_t)cur.pm * tstep; const char* cB = (const char*)g.Bt + (size_t)cur.pn * tstep;
    S.a_ready(cur);
    if constexpr (SP2) {
        PG8_STAGE(PG8_SB(0, 0), cB, voffB); PG8_STAGE(PG8_SB(0, 1), cB + hstep, voffB); PG8_STAGE(PG8_SA(0, 0), cA, voffA); PG8_STAGE(PG8_SA(0, 1), cA + hstep, voffA);
        if (wr == 1) PG8_BAR;
        PG8_WAIT_V(2); PG8_BAR;
        PG8_STAGE(PG8_SB(1, 0), cB + kstep, voffB); PG8_STAGE(PG8_SA(1, 0), cA + kstep, voffA); PG8_STAGE(PG8_SB(1, 1), cB + hstep + kstep, voffB);
        PG8_WAIT_V(6); PG8_BAR;
    } else {
        PG8_STAGE(PG8_SB(0, 0), cB, voffB); PG8_STAGE(PG8_SA(0, 0), cA, voffA); PG8_STAGE(PG8_SB(0, 1), cB + hstep, voffB); PG8_STAGE(PG8_SA(0, 1), cA + hstep, voffA);
        if (wr == 1) PG8_BAR;
        PG8_WAIT_V(4); PG8_BAR;
        PG8_STAGE(PG8_SB(1, 0), cB + kstep, voffB); PG8_STAGE(PG8_SA(1, 0), cA + kstep, voffA); PG8_STAGE(PG8_SB(1, 1), cB + hstep + kstep, voffB);
        PG8_WAIT_V(6); PG8_BAR;
    }
    for (;;) {
        const bool has_next = S.next(ui + 1, nxt);
        const char* nA = has_next ? (const char*)g.A + (size_t)nxt.pm * tstep : cA; const char* nB = has_next ? (const char*)g.Bt + (size_t)nxt.pn * tstep : cB;
        for (int t = 0; t < nt; t += 2) {
            const bool last = (t == nt - 2);
            const char* a1 = cA + (size_t)(t + 1) * kstep;
            const char* a2 = last ? nA : cA + (size_t)(t + 2) * kstep; const char* b2 = last ? nB : cB + (size_t)(t + 2) * kstep;
            const char* a3 = a2 + kstep; const char* b3 = b2 + kstep;
            if (last && has_next) S.a_ready(nxt);
            if constexpr (SP2) {
            PG8_LDB(B0, 0, 0); PG8_LDB(B1, 0, 1); PG8_SCHED; PG8_LDA(At, 0, 0); PG8_STAGE(PG8_SA(1, 1), a1 + hstep, voffA);
            PG8_WAIT_V(8); PG8_WAIT_L(0); PG8_BAR; PG8_MMA(0, 0, At, B0); PG8_MMA(0, 1, At, B1); PG8_BAR; PG8_SCHED;
            PG8_LDA(At, 0, 1); PG8_STAGE(PG8_SB(0, 0), b2, voffB); PG8_STAGE(PG8_SB(0, 1), b2 + hstep, voffB); PG8_STAGE(PG8_SA(0, 0), a2, voffA);
            PG8_WAIT_V(8); PG8_WAIT_L(0); PG8_BAR; PG8_MMA(1, 0, At, B0); PG8_MMA(1, 1, At, B1); PG8_BAR; PG8_SCHED;
            PG8_LDB(B0, 1, 0); PG8_LDB(B1, 1, 1); PG8_SCHED; PG8_LDA(At, 1, 0); PG8_STAGE(PG8_SA(0, 1), a2 + hstep, voffA);
            PG8_WAIT_V(8); PG8_WAIT_L(0); PG8_BAR; PG8_MMA(0, 0, At, B0); PG8_MMA(0, 1, At, B1); PG8_BAR; PG8_SCHED;
            PG8_LDA(At, 1, 1); PG8_STAGE(PG8_SB(1, 0), b3, voffB); PG8_STAGE(PG8_SB(1, 1), b3 + hstep, voffB); PG8_STAGE(PG8_SA(1, 0), a3, voffA);
            PG8_WAIT_V(8); PG8_WAIT_L(0); PG8_BAR; PG8_MMA(1, 0, At, B0); PG8_MMA(1, 1, At, B1); PG8_BAR; PG8_SCHED;
            } else {
            PG8_LDB(B0, 0, 0); PG8_SCHED; PG8_LDA(At, 0, 0); PG8_STAGE(PG8_SA(1, 1), a1 + hstep, voffA);
            PG8_WAIT_L(8); PG8_BAR; PG8_WAIT_L(0); PG8_MMA(0, 0, At, B0); PG8_BAR; PG8_SCHED;
            PG8_LDB(B1, 0, 1); PG8_STAGE(PG8_SB(0, 0), b2, voffB);
            PG8_BAR; PG8_WAIT_L(0); PG8_MMA(0, 1, At, B1); PG8_BAR;
            PG8_LDA(At, 0, 1); PG8_STAGE(PG8_SA(0, 0), a2, voffA);
            PG8_BAR; PG8_WAIT_L(0); PG8_MMA(1, 0, At, B0); PG8_BAR; PG8_SCHED;
            PG8_STAGE(PG8_SB(0, 1), b2 + hstep, voffB);
            PG8_WAIT_V(6); PG8_BAR; PG8_MMA(1, 1, At, B1); PG8_BAR;
            PG8_LDB(B0, 1, 0); PG8_SCHED; PG8_LDA(At, 1, 0); PG8_STAGE(PG8_SA(0, 1), a2 + hstep, voffA);
            PG8_WAIT_L(8); PG8_BAR; PG8_WAIT_L(0); PG8_MMA(0, 0, At, B0); PG8_BAR; PG8_SCHED;
            PG8_LDB(B1, 1, 1); PG8_STAGE(PG8_SB(1, 0), b3, voffB);
            PG8_BAR; PG8_WAIT_L(0); PG8_MMA(0, 1, At, B1); PG8_BAR;
            PG8_LDA(At, 1, 1); PG8_STAGE(PG8_SA(1, 0), a3, voffA);
            PG8_BAR; PG8_WAIT_L(0); PG8_MMA(1, 0, At, B0); PG8_BAR; PG8_SCHED;
            PG8_STAGE(PG8_SB(1, 1), b3 + hstep, voffB);
            PG8_WAIT_V(6); PG8_BAR; PG8_MMA(1, 1, At, B1); PG8_BAR;
            }
        }
        if constexpr (ALIGN_EPI) { if (wr == 0) PG8_BAR; }
        if constexpr (!Epi::AFTER_DRAIN) { E(acc, cur, wr, wc, fr, fq); S.done(cur); }
        if (!has_next) break;
#pragma unroll
        for (int a = 0; a < 2; ++a)
#pragma unroll
            for (int b = 0; b < 2; ++b)
#pragma unroll
                for (int m = 0; m < 4; ++m)
#pragma unroll
                    for (int n = 0; n < 2; ++n) acc[a][b][m][n] = (f32x4){0.f, 0.f, 0.f, 0.f};
        cur = nxt; cA = nA; cB = nB; ++ui;
        if constexpr (ALIGN_EPI) { if (wr == 1) PG8_BAR; }
    }
    PG8_WAIT_V(0);
    if constexpr (!ALIGN_EPI) { if (wr == 0) PG8_BAR; }
    PG8_BAR;
    if constexpr (Epi::AFTER_DRAIN) { E.fused(acc, cur, wr, wc, fr, fq, lds, wid, lane); S.done(cur); }
#undef PG8_SA
#undef PG8_SB
#undef PG8_STAGE
#undef PG8_LDA
#undef PG8_LDB
#undef PG8_MMA
#undef PG8_WAIT_V
#undef PG8_WAIT_L
#undef PG8_BAR
#undef PG8_SCHED
}
}
constexpr int NWAVES = 8, NT = NWAVES * 64;
constexpr int BATCH = 4, SEQ = 2048, DM = 2048, M = BATCH * SEQ;
constexpr int LRU_W = 1024, LRU_BLK = 8, LRU_BD = 128;
constexpr int ATT_W = 1024, NH = 8, HD = 128, CL = 256, IH = 16, ID = 64, TOPK = 256;
constexpr int C_XA = 0, C_GA = 1024, C_Q = 2048, C_CKV = 3072, C_GB = 3328, C_QI = 4352, C_KI = 5376, C_WI = 5440, NIN = 5456, NINP = 5632;
constexpr float EPS = 1e-6f;
__constant__ unsigned char BUCKET[128] = {0, 1, 2, 3, 4, 5, 6, 7, 8, 9, 10, 11, 12, 13, 14, 15, 16, 16, 16, 17, 17, 18, 18, 18, 19, 19, 19, 20, 20, 20, 20, 21, 21, 21, 21, 22, 22, 22, 22, 22, 23, 23, 23, 23, 23, 23, 24, 24, 24, 24, 24, 24, 25, 25, 25, 25, 25, 25, 25, 26, 26, 26, 26, 26, 26, 26, 26, 27, 27, 27, 27, 27, 27, 27, 27, 27, 27, 28, 28, 28, 28, 28, 28, 28, 28, 28, 28, 29, 29, 29, 29, 29, 29, 29, 29, 29, 29, 29, 29, 30, 30, 30, 30, 30, 30, 30, 30, 30, 30, 30, 30, 30, 30, 31, 31, 31, 31, 31, 31, 31, 31, 31, 31, 31, 31, 31, 31, 31};

constexpr size_t MiB = 1u << 20;
constexpr size_t WS_CTL = 0, CTL_ZERO_BYTES = 1 * MiB;
constexpr size_t WS_WIN = 2 * MiB;
constexpr size_t WS_WOUT = 24 * MiB;
constexpr size_t WS_H = 32 * MiB;
constexpr size_t WS_PROJ = 64 * MiB;
constexpr size_t WS_A = 152 * MiB;
constexpr size_t WS_B = 184 * MiB;
constexpr size_t WS_QABS = 216 * MiB;
constexpr size_t WS_CN = 248 * MiB;
constexpr size_t WS_KN = 252 * MiB;
constexpr size_t WS_WUVT = 253 * MiB;
constexpr size_t WS_WUKT = WS_WUVT + 512 * 1024;
constexpr size_t WS_WAT = 254 * MiB;
constexpr size_t WS_WXT = WS_WAT + 256 * 1024;
constexpr size_t WS_AGG = WS_WXT + 256 * 1024;
constexpr size_t WS_END = 256 * MiB;
constexpr int CW_TMO = 0, CW_CODE = 1, CW_BAR = 4096;

constexpr int RING_OFF = 0, RING_BYTES = 131072;
constexpr int LDSCTL_OFF = RING_BYTES, MISC_OFF = LDSCTL_OFF + 320;
constexpr int LDS_BYTES = 163840;

#define GAS __attribute__((address_space(1)))
#define LAS __attribute__((address_space(3)))
typedef unsigned short f16s;
typedef _Float16 f16;
typedef _Float16 h4 __attribute__((ext_vector_type(4)));
typedef _Float16 h8 __attribute__((ext_vector_type(8)));
typedef unsigned v4u __attribute__((ext_vector_type(4)));
typedef unsigned v2u __attribute__((ext_vector_type(2)));
typedef float f32x4 __attribute__((ext_vector_type(4)));
typedef float f32x2 __attribute__((ext_vector_type(2)));
typedef GAS unsigned gu32;
#define RLX_AGENT __ATOMIC_RELAXED, __HIP_MEMORY_SCOPE_AGENT
#define LDS_WAIT() asm volatile("s_waitcnt lgkmcnt(0)" ::: "memory")
#define VM_WAIT() asm volatile("s_waitcnt vmcnt(0)" ::: "memory")
__device__ __forceinline__ unsigned pkh(float lo, float hi) { return pg8::cvt_pk_f16(lo, hi); }
__device__ __forceinline__ float sigmoidf_(float x) { return __builtin_amdgcn_rcpf(1.f + __expf(-x)); }
__device__ __forceinline__ float siluf_(float x) { return x * __builtin_amdgcn_rcpf(1.f + __expf(-x)); }
__device__ __forceinline__ float h2f(f16s v) { return (float)__builtin_bit_cast(f16, v); }

#define XB_TMO      128
#define XB_XCNT(j)  (256  + 64 * (j))
#define XB_XSUB(j)  (1280 + 64 * (j))
#define XB_XGEN(j)  (2304 + 64 * (j))
#define XB_TOP      3328
#define XB_TOPGEN   3392
#define XCD_BAR_WORDS 3456
#define XB_SPIN_CAP (1u << 18)

__device__ __forceinline__ unsigned xb_ld(unsigned* p)              { return __hip_atomic_load(p, __ATOMIC_RELAXED, __HIP_MEMORY_SCOPE_AGENT); }
__device__ __forceinline__ unsigned xb_add(unsigned* p, unsigned v) { return __hip_atomic_fetch_add(p, v, __ATOMIC_RELAXED, __HIP_MEMORY_SCOPE_AGENT); }
__device__ __forceinline__ unsigned xb_xcc_id() { return (unsigned)__builtin_amdgcn_s_getreg((3 << 11) | 20) & 0xFu; }
#define XB_SPIN(cond, bar) do { unsigned _sp = 0; while (cond) { __builtin_amdgcn_s_sleep(1); \
    if ((++_sp & 255u) == 0u) { if (xb_ld(&(bar)[XB_TMO])) break; if (_sp > XB_SPIN_CAP) { atomicAdd(&(bar)[XB_TMO], 1u); break; } } } } while (0)

struct XcdBarrier {
    unsigned* bar; unsigned x;
    volatile LAS unsigned* st;
};

__device__ __forceinline__ XcdBarrier xcd_barrier_post(unsigned* bar, volatile LAS unsigned* st) {
    XcdBarrier b; b.bar = bar; b.x = xb_xcc_id(); b.st = st;
    if (threadIdx.x == 0) (void)xb_add(&bar[XB_XCNT(b.x)], 1u);
    return b;
}
__device__ __forceinline__ void xcd_barrier_complete(unsigned* bar, unsigned x, unsigned& nloc, unsigned& nx) {
    const unsigned G = gridDim.x * gridDim.y * gridDim.z;
    unsigned sum, cnt, mine, sp = 0u;
    for (;;) {
        sum = 0u; cnt = 0u; mine = 0u;
#pragma unroll
        for (unsigned j = 0; j < 16; ++j) { const unsigned c = xb_ld(&bar[XB_XCNT(j)]); sum += c; cnt += (c > 0u) ? 1u : 0u; mine = (j == x) ? c : mine; }
        if (sum == G) break;
        __builtin_amdgcn_s_sleep(1);
        if ((++sp & 255u) == 0u) { if (xb_ld(&bar[XB_TMO])) break; if (sp > XB_SPIN_CAP) { atomicAdd(&bar[XB_TMO], 1u); break; } }
    }
    nloc = mine > 0u ? mine : 1u; nx = cnt > 0u ? cnt : 1u;
}

__device__ __forceinline__ void xcd_barrier(const XcdBarrier& b) {
    asm volatile("s_waitcnt vmcnt(0)" ::: "memory");
    __syncthreads();
    if (threadIdx.x == 0) {
        unsigned* bar = b.bar;
        __builtin_amdgcn_s_waitcnt(0);
        unsigned nloc = b.st[0], nx = b.st[1];
        if (nloc == 0u) { xcd_barrier_complete(bar, b.x, nloc, nx); b.st[0] = nloc; b.st[1] = nx; }
        const unsigned old = xb_add(&bar[XB_XSUB(b.x)], 1u);
        const unsigned gen = old / nloc;
        if (old + 1u == (gen + 1u) * nloc) {
            __builtin_amdgcn_fence(__ATOMIC_RELEASE, "agent");
            asm volatile("s_waitcnt vmcnt(0)" ::: "memory");
            const unsigned og = xb_add(&bar[XB_TOP], 1u);
            const unsigned tg = og / nx;
            if (og + 1u == (tg + 1u) * nx) xb_add(&bar[XB_TOPGEN], 1u);
            else XB_SPIN(xb_ld(&bar[XB_TOPGEN]) == tg, bar);
            __builtin_amdgcn_fence(__ATOMIC_ACQUIRE, "agent");
            xb_add(&bar[XB_XGEN(b.x)], 1u);
            asm volatile("s_waitcnt vmcnt(0)" ::: "memory");
        } else {
            XB_SPIN(xb_ld(&bar[XB_XGEN(b.x)]) == gen, bar);
            __builtin_amdgcn_fence(__ATOMIC_ACQUIRE, "agent");
            asm volatile("s_waitcnt vmcnt(0)" ::: "memory");
        }
    }
    __syncthreads();
}
struct Params {
    const float *x, *norm_g, *w_in, *conv_w, *conv_b, *wa, *ba, *wx, *bx, *lam, *ckv_g, *ikg, *ikb, *w_uk, *w_uv, *w_out, *rel_bias, *fin_g;
    float* out; unsigned char* ws;
};
struct Frame {
    LAS unsigned char* lds;
    volatile LAS unsigned* MISC;
    gu32* ctl;
    int tid, lane, wave, vcu, G;
#ifdef PROBE_S
    unsigned long long pt_last; unsigned pt_acc[12];
#endif
};
#ifdef PROBE_S
#define PSTAMP(F, k) do { const unsigned long long t_ = __builtin_amdgcn_s_memrealtime(); (F).pt_acc[k] += (unsigned)(t_ - (F).pt_last); (F).pt_last = t_; } while (0)
#else
#define PSTAMP(F, k) do { } while (0)
#endif
__device__ __forceinline__ float wave_sum(float v) {
#pragma unroll
    for (int o = 1; o < 64; o <<= 1) v += __shfl_xor(v, o);
    return v;
}
__device__ __forceinline__ int wave_sum_i(int v) {
#pragma unroll
    for (int o = 1; o < 64; o <<= 1) v += __shfl_xor(v, o);
    return v;
}
__device__ __forceinline__ float wave_max(float v) {
#pragma unroll
    for (int o = 1; o < 64; o <<= 1) v = fmaxf(v, __shfl_xor(v, o));
    return v;
}

struct TrDesc { const float* W; f16s* WT; int K, N, nblk, item; };
__device__ __forceinline__ void tr_load(const TrDesc& d, int lane, f32x4 (&v)[8]) {
    const int kb = d.item / d.nblk, nb = d.item % d.nblk, k0 = 64 * kb, n0 = 32 * nb, n4 = 4 * (lane & 7), kr = lane >> 3;
    const bool nok = (n0 + n4) < d.N;
#pragma unroll
    for (int i = 0; i < 8; ++i) v[i] = nok ? *(const GAS f32x4*)(d.W + (size_t)(k0 + 8 * i + kr) * d.N + n0 + n4) : (f32x4){0.f, 0.f, 0.f, 0.f};
}
__device__ __forceinline__ void tr_store(const TrDesc& d, int lane, const f32x4 (&v)[8], LAS float* scr) {
    const int kb = d.item / d.nblk, nb = d.item % d.nblk, k0 = 64 * kb, n0 = 32 * nb, n4 = 4 * (lane & 7), kr = lane >> 3;
#pragma unroll
    for (int i = 0; i < 8; ++i) { LAS float* p = scr + (8 * i + kr) * 33 + n4; p[0] = v[i][0]; p[1] = v[i][1]; p[2] = v[i][2]; p[3] = v[i][3]; }
    LDS_WAIT(); asm volatile("" ::: "memory");
    const int c = lane & 7;
#pragma unroll
    for (int j = 0; j < 4; ++j) { const int n = (lane >> 3) + 8 * j; const LAS float* s = scr + (8 * c) * 33 + n;
        v4u o; o.x = pkh(s[0 * 33], s[1 * 33]); o.y = pkh(s[2 * 33], s[3 * 33]); o.z = pkh(s[4 * 33], s[5 * 33]); o.w = pkh(s[6 * 33], s[7 * 33]);
        *(GAS v4u*)(d.WT + (size_t)(n0 + n) * d.K + k0 + 8 * c) = o; }
    LDS_WAIT(); asm volatile("" ::: "memory");
}
constexpr int NB_IN = NINP / 32, I_IN = (DM / 64) * NB_IN, I_OUT = (DM / 64) * (DM / 32), I_UV = NH * 16, I_UK = NH * 16, I_G = LRU_BLK * 16, I_ALL = I_IN + I_OUT + I_UV + I_UK + I_G;
__device__ __forceinline__ TrDesc tr_desc(const Params& P, int it) {
    TrDesc d;
    if (it < I_IN) { d.W = P.w_in; d.WT = (f16s*)(P.ws + WS_WIN); d.K = DM; d.N = NIN; d.nblk = NB_IN; d.item = it; return d; } it -= I_IN;
    if (it < I_OUT) { d.W = P.w_out; d.WT = (f16s*)(P.ws + WS_WOUT); d.K = DM; d.N = DM; d.nblk = DM / 32; d.item = it; return d; } it -= I_OUT;
    if (it < I_UV) { const int h = it >> 4; d.W = P.w_uv + (size_t)h * CL * HD; d.WT = (f16s*)(P.ws + WS_WUVT) + (size_t)h * HD * CL; d.K = CL; d.N = HD; d.nblk = HD / 32; d.item = it & 15; return d; } it -= I_UV;
    if (it < I_UK) { const int h = it >> 4; d.W = P.w_uk + (size_t)h * HD * CL; d.WT = (f16s*)(P.ws + WS_WUKT) + (size_t)h * CL * HD; d.K = HD; d.N = CL; d.nblk = CL / 32; d.item = it & 15; return d; } it -= I_UK;
    { const int g = it >> 4, w = (it >> 3) & 1; d.W = (w ? P.wx : P.wa) + (size_t)g * LRU_BD * LRU_BD; d.WT = (f16s*)(P.ws + (w ? WS_WXT : WS_WAT)) + (size_t)g * LRU_BD * LRU_BD; d.K = LRU_BD; d.N = LRU_BD; d.nblk = LRU_BD / 32; d.item = it & 7; return d; }
}
__device__ __forceinline__ void rms_load(const float* xrow, int lane, f32x4 (&v)[8]) {
    const GAS f32x4* xr = (const GAS f32x4*)xrow + lane;
#pragma unroll
    for (int j = 0; j < 8; ++j) v[j] = xr[64 * j];
}
__device__ __forceinline__ void rms_store(const f32x4 (&v)[8], const float* g, f16s* orow, int lane) {
    const GAS f32x4* gr = (const GAS f32x4*)g + lane; float s = 0.f;
#pragma unroll
    for (int j = 0; j < 8; ++j) s += (v[j].x * v[j].x + v[j].y * v[j].y) + (v[j].z * v[j].z + v[j].w * v[j].w);
    const float r = rsqrtf(wave_sum(s) * (1.f / DM) + EPS);
    GAS v2u* o8 = (GAS v2u*)orow + lane;
#pragma unroll
    for (int j = 0; j < 8; ++j) { const f32x4 gg = gr[64 * j]; v2u o; o.x = pkh(v[j].x * r * gg.x, v[j].y * r * gg.y); o.y = pkh(v[j].z * r * gg.z, v[j].w * r * gg.w); o8[64 * j] = o; }
}
__device__ __forceinline__ void p0_prologue(Frame& F, const Params& P) {
    LAS float* scr = (LAS float*)(F.lds + RING_OFF + F.wave * 16384);
    const int gw = F.vcu * NWAVES + F.wave, NGW = F.G * NWAVES, lane = F.lane;
    f16s* Hn = (f16s*)(P.ws + WS_H);
    {   f32x4 va[8], vb[8];
        int it = gw;
        if (it < I_ALL) { TrDesc d = tr_desc(P, it); tr_load(d, lane, va);
            for (;;) { const int nx = it + NGW; TrDesc dn = d; const bool more = nx < I_ALL;
                if (more) { dn = tr_desc(P, nx); tr_load(dn, lane, vb); }
                tr_store(d, lane, va, scr);
                if (!more) break;
#pragma unroll
                for (int i = 0; i < 8; ++i) va[i] = vb[i];
                d = dn; it = nx; } }
    }
    {   f32x4 va[8], vb[8];
        int m = gw;
        if (m < M) { rms_load(P.x + (size_t)m * DM, lane, va);
            for (;;) { const int nx = m + NGW; const bool more = nx < M;
                if (more) rms_load(P.x + (size_t)nx * DM, lane, vb);
                rms_store(va, P.norm_g, Hn + (size_t)m * DM, lane);
                if (!more) break;
#pragma unroll
                for (int i = 0; i < 8; ++i) va[i] = vb[i];
                m = nx; } }
    }
}

__device__ __forceinline__ void p2_gates_naive(Frame& F, const Params& P) {
    const f16s* proj = (const f16s*)(P.ws + WS_PROJ); float* abuf = (float*)(P.ws + WS_A); float* bbuf = (float*)(P.ws + WS_B);
    LAS float* xs = (LAS float*)(F.lds + RING_OFF);
    const int tid = F.tid;
    for (int it = F.vcu; it < (M / 16) * LRU_BLK; it += F.G) {
        const int rt = it >> 3, g = it & 7, r0 = rt * 16;
#pragma unroll
        for (int i = 0; i < 4; ++i) { const int e = tid + NT * i, r = e >> 7, c = e & 127, row = r0 + r, t = row & (SEQ - 1), ch = g * 128 + c;
            float v = P.conv_b[ch];
#pragma unroll
            for (int j = 0; j < 4; ++j) { const int tt = t - 3 + j; if (tt >= 0) v += h2f(proj[(size_t)(row - 3 + j) * NINP + C_XA + ch]) * P.conv_w[j * LRU_W + ch]; }
            xs[r * 128 + c] = v; }
        __syncthreads();
        const int j = tid & 127, rh = tid >> 7;
        float ar[4] = {0.f, 0.f, 0.f, 0.f}, ai[4] = {0.f, 0.f, 0.f, 0.f};
        const float* wag = P.wa + (size_t)g * 128 * 128; const float* wxg = P.wx + (size_t)g * 128 * 128;
        for (int i = 0; i < 128; ++i) { const float w1 = wag[i * 128 + j], w2 = wxg[i * 128 + j];
#pragma unroll
            for (int r = 0; r < 4; ++r) { const float xv = xs[(rh * 4 + r) * 128 + i]; ar[r] += xv * w1; ai[r] += xv * w2; } }
        const int ch = g * 128 + j; const float sp = log1pf(expf(-P.lam[ch])), bav = P.ba[ch], bxv = P.bx[ch];
#pragma unroll
        for (int r = 0; r < 4; ++r) { const int row = r0 + rh * 4 + r, t = row & (SEQ - 1);
            const float rg = sigmoidf_(ar[r] + bav), ig = sigmoidf_(ai[r] + bxv), la = -8.f * rg * sp, a = expf(la);
            float mult = sqrtf(-expm1f(2.f * la)); if (t == 0) mult = 1.f;
            abuf[(size_t)row * LRU_W + ch] = a; bbuf[(size_t)row * LRU_W + ch] = mult * (ig * xs[(rh * 4 + r) * 128 + j]); }
        __syncthreads();
    }
}
__device__ __forceinline__ void p2_qabs_naive(Frame& F, const Params& P) {
    const f16s* proj = (const f16s*)(P.ws + WS_PROJ); f16s* qabs = (f16s*)(P.ws + WS_QABS);
    LAS float* qs = (LAS float*)(F.lds + RING_OFF);
    const int tid = F.tid;
    for (int it = F.vcu; it < (M / 16) * NH; it += F.G) {
        const int rt = it >> 3, h = it & 7, r0 = rt * 16;
#pragma unroll
        for (int i = 0; i < 4; ++i) { const int e = tid + NT * i, r = e >> 7, c = e & 127; qs[r * 128 + c] = h2f(proj[(size_t)(r0 + r) * NINP + C_Q + h * HD + c]); }
        __syncthreads();
        const int c = tid & 255, rh = tid >> 8;
        float acc[8];
#pragma unroll
        for (int r = 0; r < 8; ++r) acc[r] = 0.f;
        const float* wk = P.w_uk + (size_t)h * HD * CL + c;
        for (int d = 0; d < HD; ++d) { const float w = wk[(size_t)d * CL];
#pragma unroll
            for (int r = 0; r < 8; ++r) acc[r] += qs[(rh * 8 + r) * 128 + d] * w; }
#pragma unroll
        for (int r = 0; r < 8; ++r) qabs[(size_t)(r0 + rh * 8 + r) * (NH * CL) + h * CL + c] = __builtin_bit_cast(f16s, (f16)acc[r]);
        __syncthreads();
    }
}
__device__ __forceinline__ void p2_qabs_mfma(Frame& F, const Params& P) {
    const f16s* proj = (const f16s*)(P.ws + WS_PROJ); f16s* qabs = (f16s*)(P.ws + WS_QABS);
    int lane = F.lane; asm volatile("" : "+v"(lane));
    const int q = lane >> 4, fr = lane & 15, gw = F.vcu * NWAVES + F.wave, NGW = F.G * NWAVES, role = gw & 15, h = role >> 1, nh = role & 1;
    h8 W[8][4];
    { const f16s* wp = (const f16s*)(P.ws + WS_WUKT) + ((size_t)h * CL + nh * 128 + fr) * HD + 8 * q;
#pragma unroll
      for (int nt = 0; nt < 8; ++nt)
#pragma unroll
          for (int ks = 0; ks < 4; ++ks) W[nt][ks] = *(const GAS h8*)(wp + (size_t)nt * 16 * HD + 32 * ks); }
    const f32x4 zero4 = {0.f, 0.f, 0.f, 0.f};
    for (int rt = gw >> 4; rt < M / 16; rt += NGW >> 4) {
        const int row = rt * 16 + fr;
        h8 B[4];
        { const f16s* qp = proj + (size_t)row * NINP + C_Q + h * HD + 8 * q;
#pragma unroll
          for (int ks = 0; ks < 4; ++ks) B[ks] = *(const GAS h8*)(qp + 32 * ks); }
        f16s* op = qabs + (size_t)row * (NH * CL) + h * CL + nh * 128 + 4 * q;
#pragma unroll
        for (int nt = 0; nt < 8; ++nt) { f32x4 acc = zero4;
#pragma unroll
            for (int ks = 0; ks < 4; ++ks) acc = __builtin_amdgcn_mfma_f32_16x16x32_f16(W[nt][ks], B[ks], acc, 0, 0, 0);
            v2u o; o.x = pkh(acc[0], acc[1]); o.y = pkh(acc[2], acc[3]); *(GAS v2u*)(op + 16 * nt) = o; }
    }
}
__device__ __forceinline__ void glds16(const void* gsrc, unsigned lds_dst) { unsigned keep;
    asm volatile("s_mov_b32 %0, m0\n\ts_mov_b32 m0, %2\n\ts_nop 0\n\tglobal_load_lds_dwordx4 %1, off\n\ts_mov_b32 m0, %0" : "=&s"(keep) : "v"(gsrc), "s"(lds_dst) : "memory"); }
template <int CTRL> __device__ __forceinline__ float dppf(float oldv, float v) { return __builtin_bit_cast(float, __builtin_amdgcn_update_dpp(__builtin_bit_cast(int, oldv), __builtin_bit_cast(int, v), CTRL, 0xF, 0xF, false)); }
constexpr int XS_OFF = 32768, XS_WAVE = 10240, XS_BUF = 5120;
__device__ __forceinline__ void p2_gscan(Frame& F, const Params& P) {
    const f16s* proj = (const f16s*)(P.ws + WS_PROJ); f16s* pcb = (f16s*)(P.ws + WS_A); f16s* hlb = pcb + (size_t)M * LRU_W; float* agg = (float*)(P.ws + WS_AGG);
    LAS float* CW = (LAS float*)(F.lds + RING_OFF);
    LAS float* CB = CW + 4 * LRU_W; LAS float* NSP = CB + LRU_W; LAS float* BA = NSP + LRU_W; LAS float* BX = BA + LRU_W;
    for (int e = F.tid; e < 4 * LRU_W; e += NT) CW[e] = P.conv_w[e];
    for (int e = F.tid; e < LRU_W; e += NT) { CB[e] = P.conv_b[e]; NSP[e] = -8.f * log1pf(expf(-P.lam[e])); BA[e] = P.ba[e]; BX[e] = P.bx[e]; }
    __syncthreads();
    int lane = F.lane; asm volatile("" : "+v"(lane));
    const int q = lane >> 4, fr = lane & 15, gw = F.vcu * NWAVES + F.wave, NGW = F.G * NWAVES, role = gw & 31, g = role >> 2, nq = role & 3;
    h8 WA[2][4], WX[2][4];
    { const size_t wo = ((size_t)g * LRU_BD + nq * 32 + fr) * LRU_BD + 8 * q; const f16s* wap = (const f16s*)(P.ws + WS_WAT) + wo; const f16s* wxp = (const f16s*)(P.ws + WS_WXT) + wo;
#pragma unroll
      for (int nt = 0; nt < 2; ++nt)
#pragma unroll
          for (int ks = 0; ks < 4; ++ks) { WA[nt][ks] = *(const GAS h8*)(wap + (size_t)nt * 16 * LRU_BD + 32 * ks); WX[nt][ks] = *(const GAS h8*)(wxp + (size_t)nt * 16 * LRU_BD + 32 * ks); } }
    asm volatile("" :: "v"(WA[0][0]), "v"(WA[0][1]), "v"(WA[0][2]), "v"(WA[0][3]), "v"(WA[1][0]), "v"(WA[1][1]), "v"(WA[1][2]), "v"(WA[1][3]));
    asm volatile("" :: "v"(WX[0][0]), "v"(WX[0][1]), "v"(WX[0][2]), "v"(WX[0][3]), "v"(WX[1][0]), "v"(WX[1][1]), "v"(WX[1][2]), "v"(WX[1][3]));
    LAS unsigned char* xs = F.lds + XS_OFF + F.wave * XS_WAVE;
    const unsigned xsaddr = (unsigned)__builtin_amdgcn_readfirstlane((int)(unsigned)(size_t)xs);
    const f32x4 zero4 = {0.f, 0.f, 0.f, 0.f}, one4 = {1.f, 1.f, 1.f, 1.f};
    for (int idx = gw >> 5; idx < (M / 128); idx += NGW >> 5) {
        const int b = idx >> 4, rbase = idx * 128, bstart = b * SEQ;
        auto issue = [&](int k) {
#pragma unroll
            for (int p = 0; p < 5; ++p) { const int rr = 4 * p + q; int row = rbase + 16 * k - 4 + rr; row = row < bstart ? bstart : row;
                glds16(proj + (size_t)row * NINP + C_XA + g * 128 + 8 * (fr ^ (rr & 15)), xsaddr + (unsigned)((k & 1) * XS_BUF + p * 1024)); }
        };
        f32x4 hc[2] = {zero4, zero4}, Ac[2] = {one4, one4};
        issue(0);
#pragma unroll 1
        for (int k = 0; k < 8; ++k) {
            if (k + 1 < 8) { issue(k + 1); asm volatile("s_waitcnt vmcnt(5)" ::: "memory"); } else asm volatile("s_waitcnt vmcnt(0)" ::: "memory");
            const LAS unsigned char* xb = xs + (k & 1) * XS_BUF;
            const int row = rbase + 16 * k + fr, t = row & (SEQ - 1);
            h8 XB[4];
#pragma unroll
            for (int ks = 0; ks < 4; ++ks) { const int c0 = g * 128 + 32 * ks + 8 * q;
                float v[8];
                { const f32x4 b0 = *(const LAS f32x4*)(CB + c0), b1 = *(const LAS f32x4*)(CB + c0 + 4); v[0] = b0[0]; v[1] = b0[1]; v[2] = b0[2]; v[3] = b0[3]; v[4] = b1[0]; v[5] = b1[1]; v[6] = b1[2]; v[7] = b1[3]; }
#pragma unroll
                for (int j = 0; j < 4; ++j) { const int rr = fr + 1 + j; const h8 xv = *(const LAS h8*)(xb + 256 * rr + 16 * ((4 * ks + q) ^ (rr & 15)));
                    const f32x4 w0 = *(const LAS f32x4*)(CW + j * LRU_W + c0), w1 = *(const LAS f32x4*)(CW + j * LRU_W + c0 + 4); const float mk = (t - 3 + j >= 0) ? 1.f : 0.f;
#pragma unroll
                    for (int e = 0; e < 4; ++e) { v[e] += mk * (float)xv[e] * w0[e]; v[4 + e] += mk * (float)xv[4 + e] * w1[e]; } }
#pragma unroll
                for (int e = 0; e < 8; ++e) XB[ks][e] = (f16)v[e];
                asm volatile("" : "+v"(XB[ks])); }
            f32x4 av[2], bv[2];
#pragma unroll
            for (int nt = 0; nt < 2; ++nt) { f32x4 ar = zero4, ai = zero4;
#pragma unroll
                for (int ks = 0; ks < 4; ++ks) { ar = __builtin_amdgcn_mfma_f32_16x16x32_f16(WA[nt][ks], XB[ks], ar, 0, 0, 0); ai = __builtin_amdgcn_mfma_f32_16x16x32_f16(WX[nt][ks], XB[ks], ai, 0, 0, 0); }
                const int ch = g * 128 + nq * 32 + 16 * nt + 4 * q, cq = 4 * nq + 2 * nt + (q >> 1);
                f32x4 xc = *(const LAS f32x4*)(CB + ch);
#pragma unroll
                for (int j = 0; j < 4; ++j) { const int rr = fr + 1 + j; const h4 xv = *(const LAS h4*)(xb + 256 * rr + 16 * (cq ^ (rr & 15)) + 8 * (q & 1)); const f32x4 w0 = *(const LAS f32x4*)(CW + j * LRU_W + ch); const float mk = (t - 3 + j >= 0) ? 1.f : 0.f;
#pragma unroll
                    for (int e = 0; e < 4; ++e) xc[e] += mk * (float)xv[e] * w0[e]; }
                const f32x4 nsp = *(const LAS f32x4*)(NSP + ch), bav = *(const LAS f32x4*)(BA + ch), bxv = *(const LAS f32x4*)(BX + ch);
#pragma unroll
                for (int e = 0; e < 4; ++e) { const float rg = sigmoidf_(ar[e] + bav[e]), ig = sigmoidf_(ai[e] + bxv[e]), a = __expf(rg * nsp[e]);
                    float mult = __builtin_amdgcn_sqrtf(fmaxf(1.f - a * a, 0.f)); if (t == 0) mult = 1.f;
                    av[nt][e] = a; bv[nt][e] = mult * (ig * xc[e]); } }
#pragma unroll
            for (int nt = 0; nt < 2; ++nt)
#pragma unroll
                for (int e = 0; e < 4; ++e) { float a = av[nt][e], bb = bv[nt][e];
                    { const float ap = dppf<0x111>(1.f, a), bp = dppf<0x111>(0.f, bb); bb = a * bp + bb; a = a * ap; }
                    { const float ap = dppf<0x112>(1.f, a), bp = dppf<0x112>(0.f, bb); bb = a * bp + bb; a = a * ap; }
                    { const float ap = dppf<0x114>(1.f, a), bp = dppf<0x114>(0.f, bb); bb = a * bp + bb; a = a * ap; }
                    { const float ap = dppf<0x118>(1.f, a), bp = dppf<0x118>(0.f, bb); bb = a * bp + bb; a = a * ap; }
                    bv[nt][e] = a * hc[nt][e] + bb; av[nt][e] = a * Ac[nt][e]; }
#pragma unroll
            for (int nt = 0; nt < 2; ++nt) { const size_t o = (size_t)row * LRU_W + g * 128 + nq * 32 + 16 * nt + 4 * q;
                v2u w; w.x = pkh(av[nt][0], av[nt][1]); w.y = pkh(av[nt][2], av[nt][3]); *(GAS v2u*)(pcb + o) = w;
                w.x = pkh(bv[nt][0], bv[nt][1]); w.y = pkh(bv[nt][2], bv[nt][3]); *(GAS v2u*)(hlb + o) = w;
#pragma unroll
                for (int e = 0; e < 4; ++e) { hc[nt][e] = __shfl(bv[nt][e], 16 * q + 15); Ac[nt][e] = __shfl(av[nt][e], 16 * q + 15); } }
        }
        if (fr == 0) {
#pragma unroll
            for (int nt = 0; nt < 2; ++nt) { const int ch = g * 128 + nq * 32 + 16 * nt + 4 * q;
                *(GAS f32x4*)(agg + ((size_t)idx * 2 + 0) * LRU_W + ch) = Ac[nt]; *(GAS f32x4*)(agg + ((size_t)idx * 2 + 1) * LRU_W + ch) = hc[nt]; } }
    }
    __syncthreads();
}
__device__ __forceinline__ void p2_norms(Frame& F, const Params& P) {
    const f16s* proj = (const f16s*)(P.ws + WS_PROJ); f16s* cn = (f16s*)(P.ws + WS_CN); f16s* kn = (f16s*)(P.ws + WS_KN);
    const int gw = F.vcu * NWAVES + F.wave, NGW = F.G * NWAVES, lane = F.lane;
    for (int row = gw; row < M; row += NGW) {
        const h4 cv = *(const GAS h4*)(proj + (size_t)row * NINP + C_CKV + 4 * lane);
        const float c0 = (float)cv[0], c1 = (float)cv[1], c2 = (float)cv[2], c3 = (float)cv[3];
        const float r = rsqrtf(wave_sum(c0 * c0 + c1 * c1 + c2 * c2 + c3 * c3) * (1.f / CL) + EPS);
        const f32x4 g = *(const GAS f32x4*)(P.ckv_g + 4 * lane);
        v2u o; o.x = pkh(c0 * r * g.x, c1 * r * g.y); o.y = pkh(c2 * r * g.z, c3 * r * g.w);
        *(GAS v2u*)(cn + (size_t)row * CL + 4 * lane) = o;
        const float kv = h2f(proj[(size_t)row * NINP + C_KI + lane]);
        const float mu = wave_sum(kv) * (1.f / ID), d = kv - mu, var = wave_sum(d * d) * (1.f / ID);
        kn[(size_t)row * ID + lane] = __builtin_bit_cast(f16s, (f16)(d * rsqrtf(var + EPS) * P.ikg[lane] + P.ikb[lane]));
    }
}

__device__ __forceinline__ void p3_lru_fix(Frame& F, const Params& P) {
    const f16s* pcb = (const f16s*)(P.ws + WS_A); const f16s* hlb = pcb + (size_t)M * LRU_W; const float* agg = (const float*)(P.ws + WS_AGG);
    const f16s* proj = (const f16s*)(P.ws + WS_PROJ); f16s* y = (f16s*)(P.ws + WS_H);
    const int gw = F.vcu * NWAVES + F.wave, NGW = F.G * NWAVES;
    for (int it = gw; it < (M / 16) * 4; it += NGW) {
        const int tile = it >> 2, cg = it & 3, idx = tile >> 3, ck = idx & 15, ch = cg * 256 + 4 * F.lane; const size_t r0 = (size_t)tile * 16;
        f32x4 h = {0.f, 0.f, 0.f, 0.f};
        {   f32x4 ak[15], hk[15];
#pragma unroll
            for (int k = 0; k < 15; ++k) if (k < ck) { ak[k] = *(const GAS f32x4*)(agg + ((size_t)(idx - ck + k) * 2 + 0) * LRU_W + ch); hk[k] = *(const GAS f32x4*)(agg + ((size_t)(idx - ck + k) * 2 + 1) * LRU_W + ch); }
#pragma unroll
            for (int k = 0; k < 15; ++k) if (k < ck) h = ak[k] * h + hk[k]; }
#pragma unroll
        for (int s8 = 0; s8 < 2; ++s8) { h4 pv[8], lv[8], gv[8];
#pragma unroll
            for (int s = 0; s < 8; ++s) { const size_t r = r0 + 8 * s8 + s; pv[s] = *(const GAS h4*)(pcb + r * LRU_W + ch); lv[s] = *(const GAS h4*)(hlb + r * LRU_W + ch); gv[s] = *(const GAS h4*)(proj + r * NINP + C_GA + ch); }
#pragma unroll
            for (int s = 0; s < 8; ++s) { const size_t r = r0 + 8 * s8 + s; float o[4];
#pragma unroll
                for (int e = 0; e < 4; ++e) o[e] = ((float)pv[s][e] * h[e] + (float)lv[s][e]) * siluf_((float)gv[s][e]);
                v2u w; w.x = pkh(o[0], o[1]); w.y = pkh(o[2], o[3]); *(GAS v2u*)(y + r * DM + ch) = w; } }
    }
}
constexpr int AF_OFF = 0;
constexpr int TAB_OFF = RING_BYTES + 1024;
constexpr int IL_OFF = TAB_OFF;
constexpr int SGT_OFF = IL_OFF + 8192;
constexpr int CNT_OFF = SGT_OFF + 1024;
constexpr int WCNT_OFF = CNT_OFF + 128;
constexpr int CNTQ_OFF = WCNT_OFF + 256;
constexpr int BIAS_OFF = CNTQ_OFF + 64;
constexpr int MM_OFF = BIAS_OFF + 4224;
constexpr int NEED_OFF = MM_OFF + 128;
constexpr int SELB_OFF = NEED_OFF + 128;
constexpr int WC2_OFF = SELB_OFF + 64;
constexpr int TAB_END = WC2_OFF + 512;
constexpr int HIST_OFF = 36864;
static_assert(TAB_END <= LDS_BYTES, "LDS map");
typedef short v4i16 __attribute__((ext_vector_type(4)));
typedef _Float16 h4v __attribute__((ext_vector_type(4)));

__device__ __forceinline__ unsigned fkey(float f) { const unsigned u = __float_as_uint(f); return (u & 0x80000000u) ? ~u : (u | 0x80000000u); }
__device__ __forceinline__ float finv(unsigned k) { return __uint_as_float((k & 0x80000000u) ? (k ^ 0x80000000u) : ~k); }
__device__ __forceinline__ unsigned rowsum16(unsigned v) { v += __shfl_xor(v, 1); v += __shfl_xor(v, 2); v += __shfl_xor(v, 4); v += __shfl_xor(v, 8); return v; }

template <int MODE> __device__ __forceinline__ void p3_d1(Frame& F, const Params& P, int b, int i) {
    const f16s* proj = (const f16s*)(P.ws + WS_PROJ); const f16s* kn = (const f16s*)(P.ws + WS_KN);
    int tid = F.tid; asm volatile("" : "+v"(tid));
    const int lane = tid & 63, wave = F.wave, q = lane >> 4, fr = lane & 15;
    const int row0 = b * SEQ + 16 * i, ntile = i + 1;
    LAS unsigned char* AF = F.lds + AF_OFF;
    LAS float* SGT = (LAS float*)(F.lds + SGT_OFF);
    LAS unsigned* CNT = (LAS unsigned*)(F.lds + CNT_OFF);
    LAS unsigned* WCNT = (LAS unsigned*)(F.lds + WCNT_OFF);
    LAS unsigned* CNTQ = (LAS unsigned*)(F.lds + CNTQ_OFF);
    LAS unsigned short* IL = (LAS unsigned short*)(F.lds + IL_OFF);
#pragma unroll
    for (int e = 0; e < 4; ++e) { const int f = tid + NT * e, h = f >> 7, ks = (f >> 6) & 1, ln = f & 63, r = ln & 15, kq = ln >> 4;
        const f16s* rowp = proj + (size_t)(row0 + r) * NINP;
        const h8 v = *(const GAS h8*)(rowp + C_QI + h * 64 + 32 * ks + 8 * kq); const float w = fabsf(h2f(rowp[C_WI + h]));
        h8 o;
#pragma unroll
        for (int j = 0; j < 8; ++j) o[j] = (f16)((float)v[j] * w);
        *(LAS h8*)(AF + (h * 2 + ks) * 1024 + ln * 16) = o; }
    if (tid < 128) { const int ks = tid >> 6, ln = tid & 63, r = ln & 15, kq = ln >> 4; const f16s* rowp = proj + (size_t)(row0 + r) * NINP;
        float acc[8];
#pragma unroll
        for (int j = 0; j < 8; ++j) acc[j] = 0.f;
        h8 vv[IH]; h8 wv0 = *(const GAS h8*)(rowp + C_WI), wv1 = *(const GAS h8*)(rowp + C_WI + 8);
#pragma unroll
        for (int h = 0; h < IH; ++h) vv[h] = *(const GAS h8*)(rowp + C_QI + h * 64 + 32 * ks + 8 * kq);
#pragma unroll
        for (int h = 0; h < IH; ++h) { const float w = (float)(h < 8 ? wv0[h & 7] : wv1[h & 7]);
#pragma unroll
            for (int j = 0; j < 8; ++j) acc[j] += (float)vv[h][j] * w; }
        h8 o;
#pragma unroll
        for (int j = 0; j < 8; ++j) o[j] = (f16)acc[j];
        *(LAS h8*)(AF + (32 + ks) * 1024 + ln * 16) = o; }
    if (tid < 256) { const int r = tid >> 4, h = tid & 15; SGT[h * 16 + r] = h2f(proj[(size_t)(row0 + r) * NINP + C_WI + h]) >= 0.f ? 1.f : -1.f; }
    if (tid < 24) CNT[tid] = 0u;
    if (tid < 32) ((LAS unsigned*)(F.lds + MM_OFF))[tid] = (tid & 1) ? 0u : 0xFFFFFFFFu;
    if (tid < 16) ((LAS unsigned*)(F.lds + NEED_OFF))[tid] = (unsigned)TOPK;
    __syncthreads();
    unsigned key[16][4];
    const f32x4 zero4 = {0.f, 0.f, 0.f, 0.f};
#pragma unroll
    for (int p = 0; p < 4; ++p) {
        f32x4 sc[4] = {zero4, zero4, zero4, zero4};
        if (wave + 32 * p < ntile) {
            h8 bk[4][2];
#pragma unroll
            for (int jj = 0; jj < 4; ++jj) { int kt = wave + 8 * (4 * p + jj); kt = kt < ntile ? kt : ntile - 1;
                const f16s* kr = kn + ((size_t)b * SEQ + 16 * kt + fr) * ID + 8 * q; bk[jj][0] = *(const GAS h8*)kr; bk[jj][1] = *(const GAS h8*)(kr + 32); }
            h8 a0 = *(const LAS h8*)(AF + lane * 16), a1 = *(const LAS h8*)(AF + 1024 + lane * 16);
            f32x4 sg = *(const LAS f32x4*)(SGT + 4 * q);
#pragma unroll
            for (int h = 0; h <= IH; ++h) {
                h8 n0 = a0, n1 = a1; f32x4 ng = sg;
                if (h < IH) { n0 = *(const LAS h8*)(AF + (2 * h + 2) * 1024 + lane * 16); n1 = *(const LAS h8*)(AF + (2 * h + 3) * 1024 + lane * 16); if (h + 1 < IH) ng = *(const LAS f32x4*)(SGT + (h + 1) * 16 + 4 * q); }
#pragma unroll
                for (int jj = 0; jj < 4; ++jj) { f32x4 S = __builtin_amdgcn_mfma_f32_16x16x32_f16(a0, bk[jj][0], zero4, 0, 0, 0); S = __builtin_amdgcn_mfma_f32_16x16x32_f16(a1, bk[jj][1], S, 0, 0, 0);
                    if (h < IH) {
#pragma unroll
                        for (int e = 0; e < 4; ++e) sc[jj][e] = __builtin_fmaf(__builtin_fabsf(S[e]), sg[e], sc[jj][e]);
                    } else sc[jj] += S; }
                asm volatile("" : "+v"(sc[0]), "+v"(sc[1]), "+v"(sc[2]), "+v"(sc[3]));
                __builtin_amdgcn_sched_barrier(0);
                a0 = n0; a1 = n1; sg = ng;
            }
            __builtin_amdgcn_sched_barrier(0);
        }
#pragma unroll
        for (int jj = 0; jj < 4; ++jj) { const int kt = wave + 8 * (4 * p + jj);
#pragma unroll
            for (int e = 0; e < 4; ++e) { const bool valid = (kt < i) || (kt == i && fr <= 4 * q + e); key[4 * p + jj][e] = valid ? fkey(sc[jj][e]) : 0u; } }
        __builtin_amdgcn_sched_barrier(0);
    }
    LAS unsigned* MM = (LAS unsigned*)(F.lds + MM_OFF);
    LAS unsigned* NEED = (LAS unsigned*)(F.lds + NEED_OFF);
    LAS unsigned* SELB = (LAS unsigned*)(F.lds + SELB_OFF);
    LAS unsigned* HIST = (LAS unsigned*)(F.lds + HIST_OFF);
    LAS unsigned* WC2 = (LAS unsigned*)(F.lds + WC2_OFF);
    bool all[4];
#pragma unroll
    for (int e = 0; e < 4; ++e) all[e] = (16 * i + 4 * q + e + 1) <= TOPK;
    {   unsigned kmn[4] = {0xFFFFFFFFu, 0xFFFFFFFFu, 0xFFFFFFFFu, 0xFFFFFFFFu}, kmx[4] = {0u, 0u, 0u, 0u};
#pragma unroll
        for (int j = 0; j < 16; ++j)
#pragma unroll
            for (int e = 0; e < 4; ++e) { const unsigned k = key[j][e]; kmx[e] = k > kmx[e] ? k : kmx[e]; const unsigned k1 = k ? k : 0xFFFFFFFFu; kmn[e] = k1 < kmn[e] ? k1 : kmn[e]; }
#pragma unroll
        for (int e = 0; e < 4; ++e) {
#pragma unroll
            for (int o = 1; o < 16; o <<= 1) { const unsigned a = __shfl_xor(kmn[e], o), bq = __shfl_xor(kmx[e], o); kmn[e] = a < kmn[e] ? a : kmn[e]; kmx[e] = bq > kmx[e] ? bq : kmx[e]; }
            if (fr == 0) { __hip_atomic_fetch_min(&MM[2 * (4 * q + e)], kmn[e], __ATOMIC_RELAXED, __HIP_MEMORY_SCOPE_WORKGROUP); __hip_atomic_fetch_max(&MM[2 * (4 * q + e) + 1], kmx[e], __ATOMIC_RELAXED, __HIP_MEMORY_SCOPE_WORKGROUP); } }
    }
    __syncthreads();
    {   float mnf[4], scl[4];
#pragma unroll
        for (int e = 0; e < 4; ++e) { mnf[e] = finv(MM[2 * (4 * q + e)]); const float rng = finv(MM[2 * (4 * q + e) + 1]) - mnf[e]; scl[e] = rng > 0.f ? 16777215.f / rng : 0.f; }
#pragma unroll
        for (int j = 0; j < 16; ++j)
#pragma unroll
            for (int e = 0; e < 4; ++e) { const unsigned k = key[j][e]; unsigned u = (unsigned)((finv(k) - mnf[e]) * scl[e]); u = u > 16777215u ? 16777215u : u; key[j][e] = k ? u : 0xFFFFFFFFu; }
    }
    unsigned prefix[4] = {0u, 0u, 0u, 0u};
#pragma unroll
    for (int rd = 0; rd < (MODE == 8 ? 0 : 3); ++rd) {
        const int sh = 16 - 8 * rd;
#pragma unroll
        for (int k = 0; k < 8; ++k) HIST[tid + NT * k] = 0u;
        __syncthreads();
#pragma unroll
        for (int j = 0; j < 16; ++j)
#pragma unroll
            for (int e = 0; e < 4; ++e) { const unsigned u = key[j][e]; LAS unsigned* hp = &HIST[(4 * q + e) * 256 + ((u >> sh) & 255u)];
                if (rd == 0) __hip_atomic_fetch_add(hp, u != 0xFFFFFFFFu ? 1u : 0u, __ATOMIC_RELAXED, __HIP_MEMORY_SCOPE_WORKGROUP);
                else { const bool match = (u != 0xFFFFFFFFu) && ((u >> (sh + 8)) == prefix[e]); if (__any(match)) { if (match) __hip_atomic_fetch_add(hp, 1u, __ATOMIC_RELAXED, __HIP_MEMORY_SCOPE_WORKGROUP); } } }
        __syncthreads();
#pragma unroll
        for (int q2 = 0; q2 < 2; ++q2) { const int Q = 2 * wave + q2;
            const v4u h = *(const LAS v4u*)(HIST + Q * 256 + 4 * lane);
            const unsigned s4 = h.x + h.y + h.z + h.w; unsigned T = s4;
#pragma unroll
            for (int o = 1; o < 64; o <<= 1) { const unsigned t_ = __shfl_down(T, o); T += (lane + o < 64) ? t_ : 0u; }
            const unsigned above = T - s4, need = NEED[(rd & 1) * 16 + Q];
            if (above < need && need <= T) { unsigned cum = above, bsel, rem;
                if (need <= cum + h.w) { bsel = 3u; rem = need - cum; } else { cum += h.w;
                    if (need <= cum + h.z) { bsel = 2u; rem = need - cum; } else { cum += h.z;
                        if (need <= cum + h.y) { bsel = 1u; rem = need - cum; } else { cum += h.y; bsel = 0u; rem = need - cum; } } }
                SELB[Q] = 4u * lane + bsel; NEED[((rd + 1) & 1) * 16 + Q] = rem; } }
        __syncthreads();
#pragma unroll
        for (int e = 0; e < 4; ++e) prefix[e] = (prefix[e] << 8) | SELB[4 * q + e];
    }
    {
        unsigned nf[4];
#pragma unroll
        for (int e = 0; e < 4; ++e) nf[e] = NEED[16 + 4 * q + e];
        unsigned g01 = 0u, g23 = 0u, e01 = 0u, e23 = 0u;
#pragma unroll
        for (int j = 0; j < 16; ++j) {
            bool gt[4], eq[4];
#pragma unroll
            for (int e = 0; e < 4; ++e) { const unsigned u = key[j][e]; const bool valid = u != 0xFFFFFFFFu; gt[e] = valid && (all[e] || u > prefix[e]); eq[e] = valid && !all[e] && u == prefix[e]; }
            g01 += (gt[0] ? 1u : 0u) + (gt[1] ? 0x10000u : 0u); g23 += (gt[2] ? 1u : 0u) + (gt[3] ? 0x10000u : 0u);
            e01 += (eq[0] ? 1u : 0u) + (eq[1] ? 0x10000u : 0u); e23 += (eq[2] ? 1u : 0u) + (eq[3] ? 0x10000u : 0u); }
        g01 = rowsum16(g01); g23 = rowsum16(g23); e01 = rowsum16(e01); e23 = rowsum16(e23);
        if (fr == 0) { LAS unsigned* w = WC2 + (wave * 4 + q) * 4; w[0] = g01; w[1] = g23; w[2] = e01; w[3] = e23; }
        __syncthreads();
        unsigned bg01 = 0u, bg23 = 0u, be01 = 0u, be23 = 0u, tg01 = 0u, tg23 = 0u;
#pragma unroll
        for (int w = 0; w < NWAVES; ++w) { const v4u x = *(const LAS v4u*)(WC2 + (w * 4 + q) * 4); tg01 += x.x; tg23 += x.y; if (w < wave) { bg01 += x.x; bg23 += x.y; be01 += x.z; be23 += x.w; } }
        unsigned gbase[4] = {bg01 & 0xFFFFu, bg01 >> 16, bg23 & 0xFFFFu, bg23 >> 16}, ebase[4] = {be01 & 0xFFFFu, be01 >> 16, be23 & 0xFFFFu, be23 >> 16};
        const unsigned gtot[4] = {tg01 & 0xFFFFu, tg01 >> 16, tg23 & 0xFFFFu, tg23 >> 16};
        if (wave == 0 && fr == 0) {
#pragma unroll
            for (int e = 0; e < 4; ++e) CNTQ[4 * q + e] = all[e] ? (gtot[e] < (unsigned)TOPK ? gtot[e] : (unsigned)TOPK) : (unsigned)TOPK; }
        const unsigned ltmask = (1u << fr) - 1u;
#pragma unroll
        for (int j = 0; j < 16; ++j)
#pragma unroll
            for (int e = 0; e < 4; ++e) { const unsigned u = key[j][e]; const bool valid = u != 0xFFFFFFFFu; const bool gt = valid && (all[e] || u > prefix[e]), eq = valid && !all[e] && u == prefix[e];
                const unsigned kidx = 16 * (wave + 8 * j) + fr;
                { const unsigned long long m = __ballot(gt); const unsigned sub = (unsigned)(m >> (16 * q)) & 0xFFFFu; const unsigned pos = gbase[e] + __builtin_popcount(sub & ltmask);
                  if (gt && pos < (unsigned)TOPK) IL[(4 * q + e) * TOPK + pos] = (unsigned short)kidx; gbase[e] += __builtin_popcount(sub); }
                if (__any(eq)) { const unsigned long long m = __ballot(eq); const unsigned sub = (unsigned)(m >> (16 * q)) & 0xFFFFu; const unsigned rk = ebase[e] + __builtin_popcount(sub & ltmask);
                  if (eq && rk < nf[e] && gtot[e] + rk < (unsigned)TOPK) IL[(4 * q + e) * TOPK + gtot[e] + rk] = (unsigned short)kidx; ebase[e] += __builtin_popcount(sub); } }
    }
    __syncthreads();
}

__device__ __forceinline__ void attn_query_naive(Frame& F, const Params& P, int row, const LAS unsigned short* il, int cnt) {
    const f16s* proj = (const f16s*)(P.ws + WS_PROJ); const f16s* cn = (const f16s*)(P.ws + WS_CN);
    const f16s* qabs = (const f16s*)(P.ws + WS_QABS); f16s* y = (f16s*)(P.ws + WS_H);
    LAS float* qa = (LAS float*)(F.lds + 40960);
    LAS float* lg = qa + 2048;
    LAS float* os = lg + 2048;
    int tid = F.tid; asm volatile("" : "+v"(tid));
    const int lane = tid & 63, wave = F.wave;
    const int b = row >> 11, t = row & (SEQ - 1);
#pragma unroll
    for (int k = 0; k < 4; ++k) qa[tid + NT * k] = h2f(qabs[(size_t)row * (NH * CL) + tid + NT * k]);
    __syncthreads();
    {   const int j = tid & 255, hh = tid >> 8, s = j < cnt ? (int)il[j] : -1;
        float l[4] = {0.f, 0.f, 0.f, 0.f};
        if (s >= 0) {
            const GAS h8* cr = (const GAS h8*)(cn + ((size_t)b * SEQ + s) * CL);
            for (int c8 = 0; c8 < CL / 8; ++c8) { const h8 v = cr[c8];
#pragma unroll
                for (int e = 0; e < 8; ++e) { const float cv = (float)v[e];
#pragma unroll
                    for (int h = 0; h < 4; ++h) l[h] += qa[(hh * 4 + h) * CL + c8 * 8 + e] * cv; } }
            const int dist = t - s, bk = dist < 128 ? (int)BUCKET[dist] : 31;
#pragma unroll
            for (int h = 0; h < 4; ++h) l[h] = l[h] * 0.08838834764831845f + P.rel_bias[bk * NH + hh * 4 + h];
        } else {
#pragma unroll
            for (int h = 0; h < 4; ++h) l[h] = -INFINITY;
        }
#pragma unroll
        for (int h = 0; h < 4; ++h) lg[(hh * 4 + h) * TOPK + j] = l[h];
    }
    __syncthreads();
    {   float v[4], mx = -INFINITY;
#pragma unroll
        for (int k = 0; k < 4; ++k) { v[k] = lg[wave * TOPK + lane + 64 * k]; mx = fmaxf(mx, v[k]); }
        mx = wave_max(mx);
        float sm = 0.f;
#pragma unroll
        for (int k = 0; k < 4; ++k) { v[k] = expf(v[k] - mx); sm += v[k]; }
        const float inv = 1.f / wave_sum(sm);
#pragma unroll
        for (int k = 0; k < 4; ++k) lg[wave * TOPK + lane + 64 * k] = v[k] * inv;
    }
    __syncthreads();
    {   const int c = tid & 255, hh = tid >> 8;
        float o[4] = {0.f, 0.f, 0.f, 0.f};
        for (int j = 0; j < cnt; ++j) { const int s = il[j];
            const float cv = h2f(cn[((size_t)b * SEQ + s) * CL + c]);
#pragma unroll
            for (int h = 0; h < 4; ++h) o[h] += lg[(hh * 4 + h) * TOPK + j] * cv; }
#pragma unroll
        for (int h = 0; h < 4; ++h) os[(hh * 4 + h) * CL + c] = o[h];
    }
    __syncthreads();
#pragma unroll
    for (int k = 0; k < 2; ++k) { const int h = k * 4 + (tid >> 7), d = tid & 127;
        const float* wv = P.w_uv + (size_t)h * CL * HD + d; float acc = 0.f;
        for (int c = 0; c < CL; ++c) acc += os[h * CL + c] * wv[(size_t)c * HD];
        const float gb = h2f(proj[(size_t)row * NINP + C_GB + h * HD + d]);
        y[(size_t)row * DM + LRU_W + h * HD + d] = __builtin_bit_cast(f16s, (f16)(acc * siluf_(gb))); }
    __syncthreads();
}


template <int MODE> __device__ __forceinline__ void p3_d2_query(const Params& P, LAS unsigned char* lds, LAS unsigned char* buf, int lane, int b, int t, int row, int r) {
    const f16s* cn = (const f16s*)(P.ws + WS_CN); const f16s* qabs = (const f16s*)(P.ws + WS_QABS); f16s* obuf = (f16s*)P.out;
    const LAS unsigned short* il = (const LAS unsigned short*)(lds + IL_OFF) + r * TOPK;
    const LAS float* BIAS = (const LAS float*)(lds + BIAS_OFF);
    const int cnt = (int)((const LAS unsigned*)(lds + CNTQ_OFF))[r];
    const int q = lane >> 4, fr = lane & 15;
    h8 qb[8];
    { const f16s* qp = qabs + (size_t)row * (NH * CL) + (fr & 7) * CL + 8 * q;
#pragma unroll
      for (int ks = 0; ks < 8; ++ks) qb[ks] = *(const GAS h8*)(qp + 32 * ks); }
    asm volatile("" :: "v"(qb[0]), "v"(qb[1]), "v"(qb[2]), "v"(qb[3]), "v"(qb[4]), "v"(qb[5]), "v"(qb[6]), "v"(qb[7]));
    const unsigned bufaddr = (unsigned)__builtin_amdgcn_readfirstlane((int)(unsigned)(size_t)buf);
    const char* cnb = (const char*)(cn + (size_t)b * SEQ * CL) + 16 * ((lane & 15) ^ (q << 2));
    auto issue = [&](int c) {
        const unsigned dst = bufaddr + (unsigned)(c & 1) * 8192u;
        if (MODE == 1) return;
#pragma unroll
        for (int kq = 0; kq < 4; ++kq) { int pos = 16 * c + 4 * kq + q; pos = pos < cnt ? pos : 0;
            const char* src = cnb + (size_t)(MODE ? (il[pos] & 2047) : il[pos]) * (CL * 2);
            const char* s2 = (const char*)((size_t)src ^ (size_t)(16 * kq));
            glds16(s2, dst + kq * 1024); glds16(s2 + 256, dst + 4096 + kq * 1024); }
    };
    const int roff0 = 256 * fr + 64 * (fr & 3) + 16 * (q ^ ((fr >> 2) & 3));
    const int qq = fr >> 2, pp = fr & 3;
    const int trb = 256 * (4 * q + qq) + 16 * ((((pp >> 1) ^ (q & 1)) | (q & 2)) ^ (qq << 2)) + 8 * (pp & 1);
    f32x4 Y[16];
    const f32x4 zero4 = {0.f, 0.f, 0.f, 0.f};
#pragma unroll
    for (int ct = 0; ct < 16; ++ct) Y[ct] = zero4;
    float m = -INFINITY, ssum = 0.f;
    issue(0);
#pragma unroll 1
    for (int c = 0; c < 16; ++c) {
        if (c + 1 < 16) { issue(c + 1); asm volatile("s_waitcnt vmcnt(8)" ::: "memory"); }
        else asm volatile("s_waitcnt vmcnt(0)" ::: "memory");
        const LAS unsigned char* bb = buf + (c & 1) * 8192;
        if (MODE == 2 || MODE == 6 || MODE == 7) continue;
        f32x4 X = zero4;
        {   h8 a[8];
#pragma unroll
            for (int s = 0; s < 8; ++s) a[s] = *(const LAS h8*)(bb + (s >> 2) * 4096 + (roff0 ^ (64 * (s & 3))));
            asm volatile("" : "+v"(a[0]), "+v"(a[1]), "+v"(a[2]), "+v"(a[3]), "+v"(a[4]), "+v"(a[5]), "+v"(a[6]), "+v"(a[7]));
#pragma unroll
            for (int s = 0; s < 8; ++s) X = __builtin_amdgcn_mfma_f32_16x16x32_f16(a[s], qb[s], X, 0, 0, 0); }
        float l[4];
        {   const v4i16 kk = *(const LAS v4i16*)(il + 16 * c + 4 * q);
            float bs[4];
#pragma unroll
            for (int e = 0; e < 4; ++e) { int d = t - (int)(unsigned short)kk[e]; d = d < 0 ? 0 : (d > 128 ? 128 : d); bs[e] = BIAS[d * 8 + (fr & 7)]; }
            asm volatile("" : "+v"(bs[0]), "+v"(bs[1]), "+v"(bs[2]), "+v"(bs[3]));
#pragma unroll
            for (int e = 0; e < 4; ++e) { const int pa = 16 * c + 4 * q + e; l[e] = pa < cnt ? X[e] * 0.08838834764831845f + bs[e] : -INFINITY; } }
        float mx = fmaxf(fmaxf(l[0], l[1]), fmaxf(l[2], l[3]));
        if (c == 0) { mx = fmaxf(mx, __shfl_xor(mx, 16)); mx = fmaxf(mx, __shfl_xor(mx, 32)); m = mx; }
        else if (__any(mx > m + 8.f)) {
            mx = fmaxf(mx, __shfl_xor(mx, 16)); mx = fmaxf(mx, __shfl_xor(mx, 32));
            const float mn = fmaxf(m, mx), al = __expf(m - mn);
#pragma unroll
            for (int ct = 0; ct < 16; ++ct) Y[ct] *= al;
            ssum *= al; m = mn; }
        h8 pbl, pbh;
#pragma unroll
        for (int e = 0; e < 4; ++e) { const float p = __expf(l[e] - m); ssum += p; pbl[e] = (f16)p; pbl[4 + e] = (f16)0.f; pbh[e] = (f16)0.f; pbh[4 + e] = (f16)p; }
        if (MODE == 3) continue;
#pragma unroll
        for (int g = 0; g < 2; ++g) {
            v4i16 tv[8];
#pragma unroll
            for (int j = 0; j < 8; ++j) { const int ct = 8 * g + j; tv[j] = __builtin_amdgcn_ds_read_tr16_b64_v4i16((LAS v4i16*)(bb + (ct >> 3) * 4096 + (trb ^ (32 * (ct & 7))))); }
#pragma unroll
            for (int j = 0; j < 8; j += 2) { h8 a2 = __builtin_bit_cast(h8, __builtin_shufflevector(tv[j], tv[j + 1], 0, 1, 2, 3, 4, 5, 6, 7));
                asm volatile("" : "+v"(a2));
                Y[8 * g + j] = __builtin_amdgcn_mfma_f32_16x16x32_f16(a2, pbl, Y[8 * g + j], 0, 0, 0);
                Y[8 * g + j + 1] = __builtin_amdgcn_mfma_f32_16x16x32_f16(a2, pbh, Y[8 * g + j + 1], 0, 0, 0); }
        }
    }
    ssum += __shfl_xor(ssum, 16); ssum += __shfl_xor(ssum, 32);
    const float inv = 1.f / ssum;
    if (fr < 8) { f16s* op = obuf + (size_t)row * (NH * CL) + fr * CL + 4 * q;
#pragma unroll
        for (int ct = 0; ct < 16; ++ct) { v2u o; o.x = pkh(Y[ct][0] * inv, Y[ct][1] * inv); o.y = pkh(Y[ct][2] * inv, Y[ct][3] * inv); *(GAS v2u*)(op + 16 * ct) = o; } }
}

__device__ __forceinline__ void p3_v_stream(Frame& F, const Params& P) {
    const f16s* obuf = (const f16s*)P.out; const f16s* proj = (const f16s*)(P.ws + WS_PROJ); f16s* y = (f16s*)(P.ws + WS_H);
    int lane = F.lane; asm volatile("" : "+v"(lane));
    const int q = lane >> 4, fr = lane & 15, gw = F.vcu * NWAVES + F.wave, NGW = F.G * NWAVES, role = gw & 31, h = role >> 2, nq = role & 3;
    h8 W[2][8];
    { const f16s* wp = (const f16s*)(P.ws + WS_WUVT) + ((size_t)h * HD + nq * 32 + fr) * CL + 8 * q;
#pragma unroll
      for (int nt = 0; nt < 2; ++nt)
#pragma unroll
          for (int ks = 0; ks < 8; ++ks) W[nt][ks] = *(const GAS h8*)(wp + (size_t)nt * 16 * CL + 32 * ks); }
    const f32x4 zero4 = {0.f, 0.f, 0.f, 0.f};
    h8 ob[8], on[8];
    int rt = gw >> 5; const int step = NGW >> 5;
    if (rt < M / 16) {
        { const f16s* op = obuf + (size_t)(rt * 16 + fr) * (NH * CL) + h * CL + 8 * q;
#pragma unroll
          for (int ks = 0; ks < 8; ++ks) ob[ks] = *(const GAS h8*)(op + 32 * ks); }
        for (;;) {
            const int nx = rt + step; const bool more = nx < M / 16;
            if (more) { const f16s* op = obuf + (size_t)(nx * 16 + fr) * (NH * CL) + h * CL + 8 * q;
#pragma unroll
                for (int ks = 0; ks < 8; ++ks) on[ks] = *(const GAS h8*)(op + 32 * ks); }
            const int row = rt * 16 + fr; const size_t col0 = (size_t)h * HD + nq * 32 + 4 * q;
            h4v g[2];
#pragma unroll
            for (int nt = 0; nt < 2; ++nt) g[nt] = *(const GAS h4v*)(proj + (size_t)row * NINP + C_GB + col0 + 16 * nt);
#pragma unroll
            for (int nt = 0; nt < 2; ++nt) { f32x4 acc = zero4;
#pragma unroll
                for (int ks = 0; ks < 8; ++ks) acc = __builtin_amdgcn_mfma_f32_16x16x32_f16(W[nt][ks], ob[ks], acc, 0, 0, 0);
                v2u o; o.x = pkh(acc[0] * siluf_((float)g[nt][0]), acc[1] * siluf_((float)g[nt][1])); o.y = pkh(acc[2] * siluf_((float)g[nt][2]), acc[3] * siluf_((float)g[nt][3]));
                *(GAS v2u*)(y + (size_t)row * DM + LRU_W + col0 + 16 * nt) = o; }
            if (!more) break;
#pragma unroll
            for (int ks = 0; ks < 8; ++ks) ob[ks] = on[ks];
            rt = nx;
        }
    }
}

template <int MODE> __device__ __forceinline__ void p3_items(Frame& F, const Params& P) {
    {
        LAS float* BIAS = (LAS float*)(F.lds + BIAS_OFF);
        for (int e = F.tid; e < 129 * 8; e += NT) { const int d = e >> 3, h = e & 7; BIAS[e] = P.rel_bias[(d < 128 ? (int)BUCKET[d] : 31) * NH + h]; }
    }
    __syncthreads();
#ifndef PROBE_D
#define PROBE_D 0
#endif
    unsigned long long acc_[4] = {0ull, 0ull, 0ull, 0ull};
    for (int u = F.vcu; u < BATCH * (SEQ / 16); u += F.G) {
        const int up = u & 255, k = u >> 8, b = up >> 6, j = up & 63, i = k ? 127 - j : j;
        unsigned long long t0_ = PROBE_D ? __builtin_amdgcn_s_memrealtime() : 0ull;
        if (MODE != 5) p3_d1<MODE>(F, P, b, i);
        unsigned long long t1_ = PROBE_D ? __builtin_amdgcn_s_memrealtime() : 0ull;
        int lane = F.lane; asm volatile("" : "+v"(lane));
        LAS unsigned char* buf = F.lds + F.wave * 16384;
        if (MODE != 4 && MODE != 8)
#pragma unroll 1
        for (int rr = 0; rr < 2; ++rr) { const int r = 2 * F.wave + rr; p3_d2_query<MODE>(P, F.lds, buf, lane, b, 16 * i + r, b * SEQ + 16 * i + r, r); }
        asm volatile("s_waitcnt vmcnt(0)" ::: "memory");
        __syncthreads();
        unsigned long long t2_ = PROBE_D ? __builtin_amdgcn_s_memrealtime() : 0ull;
        unsigned long long t3_ = PROBE_D ? __builtin_amdgcn_s_memrealtime() : 0ull;
        acc_[1] += t1_ - t0_; acc_[2] += t2_ - t1_; acc_[3] += t3_ - t2_;
    }
    if (PROBE_D && PROBE_D < 4 && blockIdx.x == 0) { const unsigned long long t1 = __builtin_amdgcn_s_memrealtime(); while (__builtin_amdgcn_s_memrealtime() - t1 < acc_[PROBE_D]) __builtin_amdgcn_s_sleep(8); }
    if (PROBE_D >= 4 && F.tid == 0) { const unsigned tot = (unsigned)(acc_[1] + acc_[2] + acc_[3]), d1 = (unsigned)acc_[1], d2 = (unsigned)acc_[2];
        __hip_atomic_fetch_max((unsigned*)(F.ctl + 8), tot, __ATOMIC_RELAXED, __HIP_MEMORY_SCOPE_AGENT); __hip_atomic_fetch_add((unsigned*)(F.ctl + 9), tot, __ATOMIC_RELAXED, __HIP_MEMORY_SCOPE_AGENT);
        __hip_atomic_fetch_max((unsigned*)(F.ctl + 10), d1, __ATOMIC_RELAXED, __HIP_MEMORY_SCOPE_AGENT); __hip_atomic_fetch_max((unsigned*)(F.ctl + 11), d2, __ATOMIC_RELAXED, __HIP_MEMORY_SCOPE_AGENT);
        __hip_atomic_fetch_add((unsigned*)(F.ctl + 12), d1, __ATOMIC_RELAXED, __HIP_MEMORY_SCOPE_AGENT); __hip_atomic_fetch_add((unsigned*)(F.ctl + 13), d2, __ATOMIC_RELAXED, __HIP_MEMORY_SCOPE_AGENT); }
}

__device__ __forceinline__ void p5_final(Frame& F, const Params& P) {
    const int gw = F.vcu * NWAVES + F.wave, NGW = F.G * NWAVES, lane = F.lane;
    for (int m = gw; m < M; m += NGW) {
        GAS f32x4* xr = (GAS f32x4*)(P.out + (size_t)m * DM) + lane; const GAS f32x4* gr = (const GAS f32x4*)P.fin_g + lane;
        f32x4 v[8]; float s = 0.f;
#pragma unroll
        for (int j = 0; j < 8; ++j) { v[j] = xr[64 * j]; s += (v[j].x * v[j].x + v[j].y * v[j].y) + (v[j].z * v[j].z + v[j].w * v[j].w); }
        const float r = rsqrtf(wave_sum(s) * (1.f / DM) + EPS);
#pragma unroll
        for (int j = 0; j < 8; ++j) xr[64 * j] = v[j] * r * gr[64 * j];
    }
}

__global__ void __launch_bounds__(NT, 2) fwd_kernel(Params P) {
    extern __shared__ __attribute__((aligned(16))) unsigned char lds[];
    Frame F;
    F.lds = (LAS unsigned char*)lds;
    F.MISC = (volatile LAS unsigned*)(F.lds + MISC_OFF);
    F.tid = threadIdx.x; F.lane = F.tid & 63; F.wave = __builtin_amdgcn_readfirstlane(F.tid >> 6);
    F.G = gridDim.x; { const int bx = blockIdx.x; F.vcu = (F.G % 8 == 0) ? (bx % 8) * (F.G / 8) + bx / 8 : bx; }
    F.ctl = (gu32*)(P.ws + WS_CTL);
    for (int u = F.tid; u < (LDS_BYTES - LDSCTL_OFF) / 4; u += NT) ((LAS unsigned*)(F.lds + LDSCTL_OFF))[u] = 0u;
    __syncthreads();
    XcdBarrier bar = xcd_barrier_post((unsigned*)(F.ctl + CW_BAR), F.MISC + 8);
#ifdef PROBE_S
    for (int k_ = 0; k_ < 12; ++k_) F.pt_acc[k_] = 0u;
    F.pt_last = __builtin_amdgcn_s_memrealtime();
#endif

#ifndef PROBE_REP
#define PROBE_REP 0
#endif
#ifndef PROBE_T
#define PROBE_T 0
#endif
    unsigned long long ts_[8]; int nst_ = 0;
#define STAMP() do { if (PROBE_T) { ts_[nst_] = __builtin_amdgcn_s_memrealtime(); } ++nst_; } while (0)
    STAMP();
#if PROBE_REP == 0
#define REP(n)
#else
#define REP(n) for (int rep_ = 0; rep_ < ((PROBE_REP == (n)) ? 2 : 1); ++rep_)
#endif
    REP(1) { p0_prologue(F, P); xcd_barrier(bar); }
    STAMP();
#define P1_BLOCK { pg8::Gemm g{(const pg8::bf16_t*)(P.ws + WS_H), (const pg8::bf16_t*)(P.ws + WS_WIN), M, NINP, DM}; \
        pg8::StaticOrder S; S.init(M, NINP, F.G, (int)blockIdx.x); \
        pg8::EpiF16 E{(pg8::bf16_t*)(P.ws + WS_PROJ), NINP}; \
        pg8::gemm_phase<pg8::EpiF16, pg8::StaticOrder, true, true>(F.lds + RING_OFF, g, S, E); \
        xcd_barrier(bar); }
    P1_BLOCK
    STAMP();
#if PROBE_REP == 2
    P1_BLOCK
#endif
    REP(3) { PSTAMP(F, 11); p2_gscan(F, P); PSTAMP(F, 0); p2_qabs_mfma(F, P); PSTAMP(F, 1); p2_norms(F, P); PSTAMP(F, 2); xcd_barrier(bar); PSTAMP(F, 11); }
    STAMP();
    REP(4) { p3_lru_fix(F, P); }
    STAMP();
#ifdef PROBE_M
    p3_items<PROBE_M>(F, P); xcd_barrier(bar);
#endif
    REP(5) { p3_items<0>(F, P); xcd_barrier(bar); p3_v_stream(F, P); xcd_barrier(bar); }
    STAMP();
    REP(6) { const int rep6_ = 0;
        pg8::Gemm g{(const pg8::bf16_t*)(P.ws + WS_H), (const pg8::bf16_t*)(P.ws + WS_WOUT), M, DM, DM};
        pg8::StaticOrder S; S.init(M, DM, F.G, (int)blockIdx.x);
        pg8::EpiResF32 E{P.x, P.out, DM};
        pg8::gemm_phase<pg8::EpiResF32, pg8::StaticOrder, false, true>(F.lds + RING_OFF, g, S, E);
        xcd_barrier(bar);
        if (rep6_ == 0) STAMP();
        p5_final(F, P);
        if (PROBE_REP == 6) xcd_barrier(bar);
    }
#ifdef PROBE_S
    {   if (F.tid == 0) for (int k_ = 0; k_ < 11; ++k_) { __hip_atomic_fetch_max((unsigned*)(F.ctl + 32 + 2 * k_), F.pt_acc[k_], __ATOMIC_RELAXED, __HIP_MEMORY_SCOPE_AGENT); __hip_atomic_fetch_add((unsigned*)(F.ctl + 33 + 2 * k_), F.pt_acc[k_] >> 8, __ATOMIC_RELAXED, __HIP_MEMORY_SCOPE_AGENT); }
        xcd_barrier(bar);
        if (blockIdx.x == 0) { const unsigned v = __hip_atomic_load((unsigned*)(F.ctl + 32 + PROBE_S), RLX_AGENT);
            const unsigned long long t1 = __builtin_amdgcn_s_memrealtime(); while (__builtin_amdgcn_s_memrealtime() - t1 < (unsigned long long)v) __builtin_amdgcn_s_sleep(8); } }
#endif
#ifdef PROBE_D
    if (PROBE_D >= 4) { xcd_barrier(bar);
        if (blockIdx.x == 0) { unsigned v = __hip_atomic_load((unsigned*)(F.ctl + 8 + (PROBE_D - 4)), RLX_AGENT); if (PROBE_D == 5 || PROBE_D == 8 || PROBE_D == 9) v /= 256u;
            const unsigned long long t1 = __builtin_amdgcn_s_memrealtime(); while (__builtin_amdgcn_s_memrealtime() - t1 < (unsigned long long)v) __builtin_amdgcn_s_sleep(8); } }
#endif
    if (PROBE_T) {
        xcd_barrier(bar);
        const unsigned long long t1 = __builtin_amdgcn_s_memrealtime();
        if (PROBE_T == 7) ts_[7] = t1;
        const unsigned long long dt = ts_[PROBE_T] - ts_[PROBE_T - 1];
        if (blockIdx.x == 0) while (__builtin_amdgcn_s_memrealtime() - t1 < dt) __builtin_amdgcn_s_sleep(8);
    }
}

extern "C" void kernel_launch(void* const* d_in, const int* in_sizes, int n_in, void* d_out, int out_size, void* d_ws, size_t ws_size, hipStream_t stream) {
    static int grid = 0;
    if (grid == 0) {
        if (n_in != 18 || out_size != M * DM || ws_size < WS_END) { fprintf(stderr, "kernel_launch: unexpected shapes (n_in %d out %d ws %zu)\n", n_in, out_size, ws_size); grid = -1; return; }
        int dev = 0, cus = 0, per_cu = 0;
        if (hipGetDevice(&dev) != hipSuccess || hipDeviceGetAttribute(&cus, hipDeviceAttributeMultiprocessorCount, dev) != hipSuccess) { grid = -1; return; }
        if (hipFuncSetAttribute((const void*)fwd_kernel, hipFuncAttributeMaxDynamicSharedMemorySize, LDS_BYTES) != hipSuccess) { fprintf(stderr, "kernel_launch: hipFuncSetAttribute failed\n"); grid = -1; return; }
        if (hipOccupancyMaxActiveBlocksPerMultiprocessor(&per_cu, (const void*)fwd_kernel, NT, LDS_BYTES) != hipSuccess || per_cu < 1) fprintf(stderr, "kernel_launch: occupancy query says %d\n", per_cu);
        (void)hipGetLastError();
        grid = cus;
    }
    if (grid < 0) return;
    (void)hipMemsetAsync((char*)d_ws + WS_CTL, 0, CTL_ZERO_BYTES, stream);
    Params p{};
    p.x = (const float*)d_in[0]; p.norm_g = (const float*)d_in[1]; p.w_in = (const float*)d_in[2]; p.conv_w = (const float*)d_in[3]; p.conv_b = (const float*)d_in[4];
    p.wa = (const float*)d_in[5]; p.ba = (const float*)d_in[6]; p.wx = (const float*)d_in[7]; p.bx = (const float*)d_in[8]; p.lam = (const float*)d_in[9];
    p.ckv_g = (const float*)d_in[10]; p.ikg = (const float*)d_in[11]; p.ikb = (const float*)d_in[12]; p.w_uk = (const float*)d_in[13]; p.w_uv = (const float*)d_in[14];
    p.w_out = (const float*)d_in[15]; p.rel_bias = (const float*)d_in[16]; p.fin_g = (const float*)d_in[17];
    p.out = (float*)d_out; p.ws = (unsigned char*)d_ws;
    hipLaunchKernelGGL(fwd_kernel, dim3(grid), dim3(NT), LDS_BYTES, stream, p);
}
```

```cpp
#define PROBE_REP 0
#include <hip/hip_runtime.h>
#include <cstdio>
#include <cstdint>
#ifndef OPT_DMA_ASM
#define OPT_DMA_ASM 1
#endif
namespace pg8 {
#define PG8_LAS __attribute__((address_space(3)))
typedef unsigned short bf16_t;
typedef _Float16 f16x8 __attribute__((ext_vector_type(8)));
typedef _Float16 f16x2 __attribute__((ext_vector_type(2)));
typedef float f32x2 __attribute__((ext_vector_type(2)));
typedef float f32x4 __attribute__((ext_vector_type(4)));
typedef unsigned u32x4 __attribute__((ext_vector_type(4)));
constexpr int BM = 256, BK = 64, HALF = 128, HTB = HALF * BK * 2  , STAGE_BYTES = 8 * HTB, NXCD = 8, WGM = 8;

__host__ __device__ __forceinline__ int lds_byte(int r, int c) { const int st = (r >> 4) * 2 + (c >> 5), rr = r & 15, cc = c & 31, ob = rr * 64 + cc * 2; return st * 1024 + (ob ^ (((ob >> 9) & 1) << 5)); }
__host__ __device__ __forceinline__ void stage_rc(int b, int& R, int& C) { const int st = b / 1024, sb = b % 1024, swz = sb ^ (((sb >> 9) & 1) << 5); R = (st >> 1) * 16 + swz / 64; C = (st & 1) * 32 + (swz % 64) / 2; }
__host__ __device__ __forceinline__ int perm32(int rho) { const int n = rho >> 4, i = rho & 15; return 8 * (i >> 2) + 4 * n + (i & 3); }

struct Unit { int pm, pn; };
struct Gemm { const bf16_t* A; const bf16_t* Bt; int M, N, K; };

struct StaticOrder {
    int nM, nN, nwg, G, c;
    __host__ __device__ void init(int M, int N, int G_, int c_) { nM = M / BM; nN = N / BM; nwg = nM * nN; G = G_; c = c_; }
    __host__ __device__ bool next(int i, Unit& u) const {
        const long L = (long)i * G + c; if (L >= nwg) return false;
        int wgid = (int)L; { const int q = nwg / NXCD, r = nwg % NXCD, xcd = wgid % NXCD, off = wgid / NXCD; wgid = (xcd < r ? xcd * (q + 1) : r * (q + 1) + (xcd - r) * q) + off; }
        const int nig = WGM * nN, gid = wgid / nig, fm = gid * WGM, gsz = (nM - fm) < WGM ? (nM - fm) : WGM;
        u.pm = fm + ((wgid % nig) % gsz); u.pn = (wgid % nig) / gsz; return true;
    }
    __device__ __forceinline__ void a_ready(const Unit&) const {}
    __device__ __forceinline__ void done(const Unit&) const {}
};

__device__ __forceinline__ unsigned cvt_pk_f16(float lo, float hi) { const f32x2 v = {lo, hi}; return __builtin_bit_cast(unsigned, __builtin_convertvector(v, f16x2)); }
struct EpiF16 {
    static constexpr bool PERM = true, AFTER_DRAIN = false;
    bf16_t* O; int ldc;
    __device__ __forceinline__ void operator()(const f32x4 (&acc)[2][2][4][2], const Unit& u, int wr, int wc, int fr, int fq) const {
        const int row0 = u.pm * BM + wr * 64 + fr, col0 = u.pn * BM + wc * 32 + 8 * fq;
#pragma unroll
        for (int ai = 0; ai < 2; ++ai)
#pragma unroll
            for (int m = 0; m < 4; ++m) { bf16_t* rowp = O + (size_t)(row0 + ai * HALF + m * 16) * ldc + col0;
#pragma unroll
                for (int bj = 0; bj < 2; ++bj) { const f32x4 v0 = acc[ai][bj][m][0], v1 = acc[ai][bj][m][1];
                    u32x4 w; w.x = cvt_pk_f16(v0[0], v0[1]); w.y = cvt_pk_f16(v0[2], v0[3]); w.z = cvt_pk_f16(v1[0], v1[1]); w.w = cvt_pk_f16(v1[2], v1[3]);
                    *(u32x4*)(rowp + bj * HALF) = w; } }
    }
};
struct EpiResF32 {
    static constexpr bool PERM = false, AFTER_DRAIN = false;
    const float* base; float* out; int ldc;
    __device__ __forceinline__ void operator()(const f32x4 (&acc)[2][2][4][2], const Unit& u, int wr, int wc, int fr, int fq) const {
        const int row0 = u.pm * BM + wr * 64 + fr, col0 = u.pn * BM + wc * 32 + 4 * fq;
        const float* __restrict__ bp = base; float* __restrict__ op = out;
        f32x4 r[2][2][2];
#define EPI_LOAD(g) do { const size_t off_ = (size_t)(row0 + ((g) >> 2) * HALF + ((g) & 3) * 16) * ldc + col0; _Pragma("unroll") for (int bj = 0; bj < 2; ++bj) _Pragma("unroll") for (int n = 0; n < 2; ++n) r[(g) & 1][bj][n] = *(const f32x4*)(bp + off_ + bj * HALF + n * 16); } while (0)
        EPI_LOAD(0);
#pragma unroll
        for (int g = 0; g < 8; ++g) { const int ai = g >> 2, m = g & 3;
            if (g + 1 < 8) EPI_LOAD(g + 1);
            const size_t off = (size_t)(row0 + ai * HALF + m * 16) * ldc + col0;
#pragma unroll
            for (int bj = 0; bj < 2; ++bj)
#pragma unroll
                for (int n = 0; n < 2; ++n) *(f32x4*)(op + off + bj * HALF + n * 16) = r[g & 1][bj][n] + acc[ai][bj][m][n]; }
#undef EPI_LOAD
    }
};

template <class Epi, class Sched, bool ALIGN_EPI = false, bool SP2 = false>
__device__ __forceinline__ void gemm_phase(PG8_LAS unsigned char* lds, const Gemm g, const Sched& S, const Epi& E) {
    int tid = threadIdx.x; asm volatile("" : "+v"(tid));
    const int wid = __builtin_amdgcn_readfirstlane(tid >> 6), lane = tid & 63, wr = wid >> 2, wc = wid & 3, fr = lane & 15, fq = lane >> 4;
    const int K = g.K, nt = K / BK;
    unsigned voffA[2], voffB[2];
#pragma unroll
    for (int i = 0; i < 2; ++i) { int R, C; stage_rc(tid * 16 + i * 8192, R, C); const int Rb = Epi::PERM ? ((R & ~31) + perm32(R & 31)) : R;
        voffA[i] = (unsigned)(R * K + C) * 2u; voffB[i] = (unsigned)(Rb * K + C) * 2u; }
    const size_t kstep = (size_t)(BK * 2);
    const size_t hstep = (size_t)HALF * K * 2;
    const size_t tstep = 2 * hstep;
    const unsigned ldsw = (unsigned)wid * 1024u;
    const int aoff = lds_byte(wr * 64 + fr, fq * 8), boff = lds_byte(wc * 32 + fr, fq * 8);
#define PG8_SA(b, h) (((b) * 2 + (h)) * HTB)
#define PG8_SB(b, h) ((4 + (b) * 2 + (h)) * HTB)
#define PG8_STAGE(bufoff, gbase, voff) do { _Pragma("unroll") for (int _i = 0; _i < 2; ++_i) \
        __builtin_amdgcn_global_load_lds((const unsigned*)((const char*)(gbase) + (voff)[_i]), (PG8_LAS unsigned*)(lds + (bufoff) + ldsw + _i * 8192), 16, 0, 0); } while (0)
#define PG8_LDA(dst, b, h) do { _Pragma("unroll") for (int m = 0; m < 4; ++m) _Pragma("unroll") for (int k = 0; k < 2; ++k) dst[m][k] = *(const PG8_LAS f16x8*)(lds + PG8_SA(b, h) + aoff + m * 2048 + k * 1024); } while (0)
#define PG8_LDB(dst, b, h) do { _Pragma("unroll") for (int n = 0; n < 2; ++n) _Pragma("unroll") for (int k = 0; k < 2; ++k) dst[n][k] = *(const PG8_LAS f16x8*)(lds + PG8_SB(b, h) + boff + n * 2048 + k * 1024); } while (0)
#define PG8_MMA(ai, bj, At, Bt) do { __builtin_amdgcn_s_setprio(1); _Pragma("unroll") for (int m = 0; m < 4; ++m) _Pragma("unroll") for (int n = 0; n < 2; ++n) _Pragma("unroll") for (int k = 0; k < 2; ++k) \
        acc[ai][bj][m][n] = __builtin_amdgcn_mfma_f32_16x16x32_f16(Bt[n][k], At[m][k], acc[ai][bj][m][n], 0, 0, 0); __builtin_amdgcn_s_setprio(0); } while (0)
#define PG8_WAIT_V(n) asm volatile("s_waitcnt vmcnt(" #n ")" ::: "memory")
#define PG8_WAIT_L(n) asm volatile("s_waitcnt lgkmcnt(" #n ")" ::: "memory")
#define PG8_BAR __builtin_amdgcn_s_barrier()
#define PG8_SCHED __builtin_amdgcn_sched_barrier(0)
    Unit cur, nxt; int ui = 0;
    if (!S.next(0, cur)) return;
    f32x4 acc[2][2][4][2];
#pragma unroll
    for (int a = 0; a < 2; ++a)
#pragma unroll
        for (int b = 0; b < 2; ++b)
#pragma unroll
            for (int m = 0; m < 4; ++m)
#pragma unroll
                for (int n = 0; n < 2; ++n) acc[a][b][m][n] = (f32x4){0.f, 0.f, 0.f, 0.f};
    f16x8 At[4][2], B0[2][2], B1[2][2];
    const char* cA = (const char*)g.A + (size_t)cur.pm * tstep; const char* cB = (const char*)g.Bt + (size_t)cur.pn * tstep;
    S.a_ready(cur);
    if constexpr (SP2) {
        PG8_STAGE(PG8_SB(0, 0), cB, voffB); PG8_STAGE(PG8_SB(0, 1), cB + hstep, voffB); PG8_STAGE(PG8_SA(0, 0), cA, voffA); PG8_STAGE(PG8_SA(0, 1), cA + hstep, voffA);
        if (wr == 1) PG8_BAR;
        PG8_WAIT_V(2); PG8_BAR;
        PG8_STAGE(PG8_SB(1, 0), cB + kstep, voffB); PG8_STAGE(PG8_SA(1, 0), cA + kstep, voffA); PG8_STAGE(PG8_SB(1, 1), cB + hstep + kstep, voffB);
        PG8_WAIT_V(6); PG8_BAR;
    } else {
        PG8_STAGE(PG8_SB(0, 0), cB, voffB); PG8_STAGE(PG8_SA(0, 0), cA, voffA); PG8_STAGE(PG8_SB(0, 1), cB + hstep, voffB); PG8_STAGE(PG8_SA(0, 1), cA + hstep, voffA);
        if (wr == 1) PG8_BAR;
        PG8_WAIT_V(4); PG8_BAR;
        PG8_STAGE(PG8_SB(1, 0), cB + kstep, voffB); PG8_STAGE(PG8_SA(1, 0), cA + kstep, voffA); PG8_STAGE(PG8_SB(1, 1), cB + hstep + kstep, voffB);
        PG8_WAIT_V(6); PG8_BAR;
    }
    for (;;) {
        const bool has_next = S.next(ui + 1, nxt);
        const char* nA = has_next ? (const char*)g.A + (size_t)nxt.pm * tstep : cA; const char* nB = has_next ? (const char*)g.Bt + (size_t)nxt.pn * tstep : cB;
        for (int t = 0; t < nt; t += 2) {
            const bool last = (t == nt - 2);
            const char* a1 = cA + (size_t)(t + 1) * kstep;
            const char* a2 = last ? nA : cA + (size_t)(t + 2) * kstep; const char* b2 = last ? nB : cB + (size_t)(t + 2) * kstep;
            const char* a3 = a2 + kstep; const char* b3 = b2 + kstep;
            if (last && has_next) S.a_ready(nxt);
            if constexpr (SP2) {
            PG8_LDB(B0, 0, 0); PG8_LDB(B1, 0, 1); PG8_SCHED; PG8_LDA(At, 0, 0); PG8_STAGE(PG8_SA(1, 1), a1 + hstep, voffA);
            PG8_WAIT_V(8); PG8_WAIT_L(0); PG8_BAR; PG8_MMA(0, 0, At, B0); PG8_MMA(0, 1, At, B1); PG8_BAR; PG8_SCHED;
            PG8_LDA(At, 0, 1); PG8_STAGE(PG8_SB(0, 0), b2, voffB); PG8_STAGE(PG8_SB(0, 1), b2 + hstep, voffB); PG8_STAGE(PG8_SA(0, 0), a2, voffA);
            PG8_WAIT_V(8); PG8_WAIT_L(0); PG8_BAR; PG8_MMA(1, 0, At, B0); PG8_MMA(1, 1, At, B1); PG8_BAR; PG8_SCHED;
            PG8_LDB(B0, 1, 0); PG8_LDB(B1, 1, 1); PG8_SCHED; PG8_LDA(At, 1, 0); PG8_STAGE(PG8_SA(0, 1), a2 + hstep, voffA);
            PG8_WAIT_V(8); PG8_WAIT_L(0); PG8_BAR; PG8_MMA(0, 0, At, B0); PG8_MMA(0, 1, At, B1); PG8_BAR; PG8_SCHED;
            PG8_LDA(At, 1, 1); PG8_STAGE(PG8_SB(1, 0), b3, voffB); PG8_STAGE(PG8_SB(1, 1), b3 + hstep, voffB); PG8_STAGE(PG8_SA(1, 0), a3, voffA);
            PG8_WAIT_V(8); PG8_WAIT_L(0); PG8_BAR; PG8_MMA(1, 0, At, B0); PG8_MMA(1, 1, At, B1); PG8_BAR; PG8_SCHED;
            } else {
            PG8_LDB(B0, 0, 0); PG8_SCHED; PG8_LDA(At, 0, 0); PG8_STAGE(PG8_SA(1, 1), a1 + hstep, voffA);
            PG8_WAIT_L(8); PG8_BAR; PG8_WAIT_L(0); PG8_MMA(0, 0, At, B0); PG8_BAR; PG8_SCHED;
            PG8_LDB(B1, 0, 1); PG8_STAGE(PG8_SB(0, 0), b2, voffB);
            PG8_BAR; PG8_WAIT_L(0); PG8_MMA(0, 1, At, B1); PG8_BAR;
            PG8_LDA(At, 0, 1); PG8_STAGE(PG8_SA(0, 0), a2, voffA);
            PG8_BAR; PG8_WAIT_L(0); PG8_MMA(1, 0, At, B0); PG8_BAR; PG8_SCHED;
            PG8_STAGE(PG8_SB(0, 1), b2 + hstep, voffB);
            PG8_WAIT_V(6); PG8_BAR; PG8_MMA(1, 1, At, B1); PG8_BAR;
            PG8_LDB(B0, 1, 0); PG8_SCHED; PG8_LDA(At, 1, 0); PG8_STAGE(PG8_SA(0, 1), a2 + hstep, voffA);
            PG8_WAIT_L(8); PG8_BAR; PG8_WAIT_L(0); PG8_MMA(0, 0, At, B0); PG8_BAR; PG8_SCHED;
            PG8_LDB(B1, 1, 1); PG8_STAGE(PG8_SB(1, 0), b3, voffB);
            PG8_BAR; PG8_WAIT_L(0); PG8_MMA(0, 1, At, B1); PG8_BAR;
            PG8_LDA(At, 1, 1); PG8_STAGE(PG8_SA(1, 0), a3, voffA);
            PG8_BAR; PG8_WAIT_L(0); PG8_MMA(1, 0, At, B0); PG8_BAR; PG8_SCHED;
            PG8_STAGE(PG8_SB(1, 1), b3 + hstep, voffB);
            PG8_WAIT_V(6); PG8_BAR; PG8_MMA(1, 1, At, B1); PG8_BAR;
            }
        }
        if constexpr (ALIGN_EPI) { if (wr == 0) PG8_BAR; }
        if constexpr (!Epi::AFTER_DRAIN) { E(acc, cur, wr, wc, fr, fq); S.done(cur); }
        if (!has_next) break;
#pragma unroll
        for (int a = 0; a < 2; ++a)
#pragma unroll
            for (int b = 0; b < 2; ++b)
#pragma unroll
                for (int m = 0; m < 4; ++m)
#pragma unroll
                    for (int n = 0; n < 2; ++n) acc[a][b][m][n] = (f32x4){0.f, 0.f, 0.f, 0.f};
        cur = nxt; cA = nA; cB = nB; ++ui;
        if constexpr (ALIGN_EPI) { if (wr == 1) PG8_BAR; }
    }
    PG8_WAIT_V(0);
    if constexpr (!ALIGN_EPI) { if (wr == 0) PG8_BAR; }
    PG8_BAR;
    if constexpr (Epi::AFTER_DRAIN) { E.fused(acc, cur, wr, wc, fr, fq, lds, wid, lane); S.done(cur); }
#undef PG8_SA
#undef PG8_SB
#undef PG8_STAGE
#undef PG8_LDA
#undef PG8_LDB
#undef PG8_MMA
#undef PG8_WAIT_V
#undef PG8_WAIT_L
#undef PG8_BAR
#undef PG8_SCHED
}
}
constexpr int NWAVES = 8, NT = NWAVES * 64;
constexpr int BATCH = 4, SEQ = 2048, DM = 2048, M = BATCH * SEQ;
constexpr int LRU_W = 1024, LRU_BLK = 8, LRU_BD = 128;
constexpr int ATT_W = 1024, NH = 8, HD = 128, CL = 256, IH = 16, ID = 64, TOPK = 256;
constexpr int C_XA = 0, C_GA = 1024, C_Q = 2048, C_CKV = 3072, C_GB = 3328, C_QI = 4352, C_KI = 5376, C_WI = 5440, NIN = 5456, NINP = 5632;
constexpr float EPS = 1e-6f;
__constant__ unsigned char BUCKET[128] = {0, 1, 2, 3, 4, 5, 6, 7, 8, 9, 10, 11, 12, 13, 14, 15, 16, 16, 16, 17, 17, 18, 18, 18, 19, 19, 19, 20, 20, 20, 20, 21, 21, 21, 21, 22, 22, 22, 22, 22, 23, 23, 23, 23, 23, 23, 24, 24, 24, 24, 24, 24, 25, 25, 25, 25, 25, 25, 25, 26, 26, 26, 26, 26, 26, 26, 26, 27, 27, 27, 27, 27, 27, 27, 27, 27, 27, 28, 28, 28, 28, 28, 28, 28, 28, 28, 28, 29, 29, 29, 29, 29, 29, 29, 29, 29, 29, 29, 29, 30, 30, 30, 30, 30, 30, 30, 30, 30, 30, 30, 30, 30, 30, 31, 31, 31, 31, 31, 31, 31, 31, 31, 31, 31, 31, 31, 31, 31};

constexpr size_t MiB = 1u << 20;
constexpr size_t WS_CTL = 0, CTL_ZERO_BYTES = 1 * MiB;
constexpr size_t WS_WIN = 2 * MiB;
constexpr size_t WS_WOUT = 24 * MiB;
constexpr size_t WS_H = 32 * MiB;
constexpr size_t WS_PROJ = 64 * MiB;
constexpr size_t WS_A = 152 * MiB;
constexpr size_t WS_B = 184 * MiB;
constexpr size_t WS_QABS = 216 * MiB;
constexpr size_t WS_CN = 248 * MiB;
constexpr size_t WS_KN = 252 * MiB;
constexpr size_t WS_WUVT = 253 * MiB;
constexpr size_t WS_WUKT = WS_WUVT + 512 * 1024;
constexpr size_t WS_WAT = 254 * MiB;
constexpr size_t WS_WXT = WS_WAT + 256 * 1024;
constexpr size_t WS_AGG = WS_WXT + 256 * 1024;
constexpr size_t WS_END = 256 * MiB;
constexpr int CW_TMO = 0, CW_CODE = 1, CW_BAR = 4096;

constexpr int RING_OFF = 0, RING_BYTES = 131072;
constexpr int LDSCTL_OFF = RING_BYTES, MISC_OFF = LDSCTL_OFF + 320;
constexpr int LDS_BYTES = 163840;

#define GAS __attribute__((address_space(1)))
#define LAS __attribute__((address_space(3)))
typedef unsigned short f16s;
typedef _Float16 f16;
typedef _Float16 h4 __attribute__((ext_vector_type(4)));
typedef _Float16 h8 __attribute__((ext_vector_type(8)));
typedef unsigned v4u __attribute__((ext_vector_type(4)));
typedef unsigned v2u __attribute__((ext_vector_type(2)));
typedef float f32x4 __attribute__((ext_vector_type(4)));
typedef float f32x2 __attribute__((ext_vector_type(2)));
typedef GAS unsigned gu32;
#define RLX_AGENT __ATOMIC_RELAXED, __HIP_MEMORY_SCOPE_AGENT
#define LDS_WAIT() asm volatile("s_waitcnt lgkmcnt(0)" ::: "memory")
#define VM_WAIT() asm volatile("s_waitcnt vmcnt(0)" ::: "memory")
__device__ __forceinline__ unsigned pkh(float lo, float hi) { return pg8::cvt_pk_f16(lo, hi); }
__device__ __forceinline__ float sigmoidf_(float x) { return __builtin_amdgcn_rcpf(1.f + __expf(-x)); }
__device__ __forceinline__ float siluf_(float x) { return x * __builtin_amdgcn_rcpf(1.f + __expf(-x)); }
__device__ __forceinline__ float h2f(f16s v) { return (float)__builtin_bit_cast(f16, v); }

#define XB_TMO      128
#define XB_XCNT(j)  (256  + 64 * (j))
#define XB_XSUB(j)  (1280 + 64 * (j))
#define XB_XGEN(j)  (2304 + 64 * (j))
#define XB_TOP      3328
#define XB_TOPGEN   3392
#define XCD_BAR_WORDS 3456
#define XB_SPIN_CAP (1u << 18)

__device__ __forceinline__ unsigned xb_ld(unsigned* p)              { return __hip_atomic_load(p, __ATOMIC_RELAXED, __HIP_MEMORY_SCOPE_AGENT); }
__device__ __forceinline__ unsigned xb_add(unsigned* p, unsigned v) { return __hip_atomic_fetch_add(p, v, __ATOMIC_RELAXED, __HIP_MEMORY_SCOPE_AGENT); }
__device__ __forceinline__ unsigned xb_xcc_id() { return (unsigned)__builtin_amdgcn_s_getreg((3 << 11) | 20) & 0xFu; }
#define XB_SPIN(cond, bar) do { unsigned _sp = 0; while (cond) { __builtin_amdgcn_s_sleep(1); \
    if ((++_sp & 255u) == 0u) { if (xb_ld(&(bar)[XB_TMO])) break; if (_sp > XB_SPIN_CAP) { atomicAdd(&(bar)[XB_TMO], 1u); break; } } } } while (0)

struct XcdBarrier {
    unsigned* bar; unsigned x;
    volatile LAS unsigned* st;
};

__device__ __forceinline__ XcdBarrier xcd_barrier_post(unsigned* bar, volatile LAS unsigned* st) {
    XcdBarrier b; b.bar = bar; b.x = xb_xcc_id(); b.st = st;
    if (threadIdx.x == 0) (void)xb_add(&bar[XB_XCNT(b.x)], 1u);
    return b;
}
__device__ __forceinline__ void xcd_barrier_complete(unsigned* bar, unsigned x, unsigned& nloc, unsigned& nx) {
    const unsigned G = gridDim.x * gridDim.y * gridDim.z;
    unsigned sum, cnt, mine, sp = 0u;
    for (;;) {
        sum = 0u; cnt = 0u; mine = 0u;
#pragma unroll
        for (unsigned j = 0; j < 16; ++j) { const unsigned c = xb_ld(&bar[XB_XCNT(j)]); sum += c; cnt += (c > 0u) ? 1u : 0u; mine = (j == x) ? c : mine; }
        if (sum == G) break;
        __builtin_amdgcn_s_sleep(1);
        if ((++sp & 255u) == 0u) { if (xb_ld(&bar[XB_TMO])) break; if (sp > XB_SPIN_CAP) { atomicAdd(&bar[XB_TMO], 1u); break; } }
    }
    nloc = mine > 0u ? mine : 1u; nx = cnt > 0u ? cnt : 1u;
}

__device__ __forceinline__ void xcd_barrier(const XcdBarrier& b) {
    asm volatile("s_waitcnt vmcnt(0)" ::: "memory");
    __syncthreads();
    if (threadIdx.x == 0) {
        unsigned* bar = b.bar;
        __builtin_amdgcn_s_waitcnt(0);
        unsigned nloc = b.st[0], nx = b.st[1];
        if (nloc == 0u) { xcd_barrier_complete(bar, b.x, nloc, nx); b.st[0] = nloc; b.st[1] = nx; }
        const unsigned old = xb_add(&bar[XB_XSUB(b.x)], 1u);
        const unsigned gen = old / nloc;
        if (old + 1u == (gen + 1u) * nloc) {
            __builtin_amdgcn_fence(__ATOMIC_RELEASE, "agent");
            asm volatile("s_waitcnt vmcnt(0)" ::: "memory");
            const unsigned og = xb_add(&bar[XB_TOP], 1u);
            const unsigned tg = og / nx;
            if (og + 1u == (tg + 1u) * nx) xb_add(&bar[XB_TOPGEN], 1u);
            else XB_SPIN(xb_ld(&bar[XB_TOPGEN]) == tg, bar);
            __builtin_amdgcn_fence(__ATOMIC_ACQUIRE, "agent");
            xb_add(&bar[XB_XGEN(b.x)], 1u);
            asm volatile("s_waitcnt vmcnt(0)" ::: "memory");
        } else {
            XB_SPIN(xb_ld(&bar[XB_XGEN(b.x)]) == gen, bar);
            __builtin_amdgcn_fence(__ATOMIC_ACQUIRE, "agent");
            asm volatile("s_waitcnt vmcnt(0)" ::: "memory");
        }
    }
    __syncthreads();
}
struct Params {
    const float *x, *norm_g, *w_in, *conv_w, *conv_b, *wa, *ba, *wx, *bx, *lam, *ckv_g, *ikg, *ikb, *w_uk, *w_uv, *w_out, *rel_bias, *fin_g;
    float* out; unsigned char* ws;
};
struct Frame {
    LAS unsigned char* lds;
    volatile LAS unsigned* MISC;
    gu32* ctl;
    int tid, lane, wave, vcu, G;
#ifdef PROBE_S
    unsigned long long pt_last; unsigned pt_acc[12];
#endif
};
#ifdef PROBE_S
#define PSTAMP(F, k) do { const unsigned long long t_ = __builtin_amdgcn_s_memrealtime(); (F).pt_acc[k] += (unsigned)(t_ - (F).pt_last); (F).pt_last = t_; } while (0)
#else
#define PSTAMP(F, k) do { } while (0)
#endif
__device__ __forceinline__ float wave_sum(float v) {
#pragma unroll
    for (int o = 1; o < 64; o <<= 1) v += __shfl_xor(v, o);
    return v;
}
__device__ __forceinline__ int wave_sum_i(int v) {
#pragma unroll
    for (int o = 1; o < 64; o <<= 1) v += __shfl_xor(v, o);
    return v;
}
__device__ __forceinline__ float wave_max(float v) {
#pragma unroll
    for (int o = 1; o < 64; o <<= 1) v = fmaxf(v, __shfl_xor(v, o));
    return v;
}

struct TrDesc { const float* W; f16s* WT; int K, N, nblk, item; };
__device__ __forceinline__ void tr_load(const TrDesc& d, int lane, f32x4 (&v)[8]) {
    const int kb = d.item / d.nblk, nb = d.item % d.nblk, k0 = 64 * kb, n0 = 32 * nb, n4 = 4 * (lane & 7), kr = lane >> 3;
    const bool nok = (n0 + n4) < d.N;
#pragma unroll
    for (int i = 0; i < 8; ++i) v[i] = nok ? *(const GAS f32x4*)(d.W + (size_t)(k0 + 8 * i + kr) * d.N + n0 + n4) : (f32x4){0.f, 0.f, 0.f, 0.f};
}
__device__ __forceinline__ void tr_store(const TrDesc& d, int lane, const f32x4 (&v)[8], LAS float* scr) {
    const int kb = d.item / d.nblk, nb = d.item % d.nblk, k0 = 64 * kb, n0 = 32 * nb, n4 = 4 * (lane & 7), kr = lane >> 3;
#pragma unroll
    for (int i = 0; i < 8; ++i) { LAS float* p = scr + (8 * i + kr) * 33 + n4; p[0] = v[i][0]; p[1] = v[i][1]; p[2] = v[i][2]; p[3] = v[i][3]; }
    LDS_WAIT(); asm volatile("" ::: "memory");
    const int c = lane & 7;
#pragma unroll
    for (int j = 0; j < 4; ++j) { const int n = (lane >> 3) + 8 * j; const LAS float* s = scr + (8 * c) * 33 + n;
        v4u o; o.x = pkh(s[0 * 33], s[1 * 33]); o.y = pkh(s[2 * 33], s[3 * 33]); o.z = pkh(s[4 * 33], s[5 * 33]); o.w = pkh(s[6 * 33], s[7 * 33]);
        *(GAS v4u*)(d.WT + (size_t)(n0 + n) * d.K + k0 + 8 * c) = o; }
    LDS_WAIT(); asm volatile("" ::: "memory");
}
constexpr int NB_IN = NINP / 32, I_IN = (DM / 64) * NB_IN, I_OUT = (DM / 64) * (DM / 32), I_UV = NH * 16, I_UK = NH * 16, I_G = LRU_BLK * 16, I_ALL = I_IN + I_OUT + I_UV + I_UK + I_G;
__device__ __forceinline__ TrDesc tr_desc(const Params& P, int it) {
    TrDesc d;
    if (it < I_IN) { d.W = P.w_in; d.WT = (f16s*)(P.ws + WS_WIN); d.K = DM; d.N = NIN; d.nblk = NB_IN; d.item = it; return d; } it -= I_IN;
    if (it < I_OUT) { d.W = P.w_out; d.WT = (f16s*)(P.ws + WS_WOUT); d.K = DM; d.N = DM; d.nblk = DM / 32; d.item = it; return d; } it -= I_OUT;
    if (it < I_UV) { const int h = it >> 4; d.W = P.w_uv + (size_t)h * CL * HD; d.WT = (f16s*)(P.ws + WS_WUVT) + (size_t)h * HD * CL; d.K = CL; d.N = HD; d.nblk = HD / 32; d.item = it & 15; return d; } it -= I_UV;
    if (it < I_UK) { const int h = it >> 4; d.W = P.w_uk + (size_t)h * HD * CL; d.WT = (f16s*)(P.ws + WS_WUKT) + (size_t)h * CL * HD; d.K = HD; d.N = CL; d.nblk = CL / 32; d.item = it & 15; return d; } it -= I_UK;
    { const int g = it >> 4, w = (it >> 3) & 1; d.W = (w ? P.wx : P.wa) + (size_t)g * LRU_BD * LRU_BD; d.WT = (f16s*)(P.ws + (w ? WS_WXT : WS_WAT)) + (size_t)g * LRU_BD * LRU_BD; d.K = LRU_BD; d.N = LRU_BD; d.nblk = LRU_BD / 32; d.item = it & 7; return d; }
}
__device__ __forceinline__ void rms_load(const float* xrow, int lane, f32x4 (&v)[8]) {
    const GAS f32x4* xr = (const GAS f32x4*)xrow + lane;
#pragma unroll
    for (int j = 0; j < 8; ++j) v[j] = xr[64 * j];
}
__device__ __forceinline__ void rms_store(const f32x4 (&v)[8], const float* g, f16s* orow, int lane) {
    const GAS f32x4* gr = (const GAS f32x4*)g + lane; float s = 0.f;
#pragma unroll
    for (int j = 0; j < 8; ++j) s += (v[j].x * v[j].x + v[j].y * v[j].y) + (v[j].z * v[j].z + v[j].w * v[j].w);
    const float r = rsqrtf(wave_sum(s) * (1.f / DM) + EPS);
    GAS v2u* o8 = (GAS v2u*)orow + lane;
#pragma unroll
    for (int j = 0; j < 8; ++j) { const f32x4 gg = gr[64 * j]; v2u o; o.x = pkh(v[j].x * r * gg.x, v[j].y * r * gg.y); o.y = pkh(v[j].z * r * gg.z, v[j].w * r * gg.w); o8[64 * j] = o; }
}
__device__ __forceinline__ void p0_prologue(Frame& F, const Params& P) {
    LAS float* scr = (LAS float*)(F.lds + RING_OFF + F.wave * 16384);
    const int gw = F.vcu * NWAVES + F.wave, NGW = F.G * NWAVES, lane = F.lane;
    f16s* Hn = (f16s*)(P.ws + WS_H);
    {   f32x4 va[8], vb[8];
        int it = gw;
        if (it < I_ALL) { TrDesc d = tr_desc(P, it); tr_load(d, lane, va);
            for (;;) { const int nx = it + NGW; TrDesc dn = d; const bool more = nx < I_ALL;
                if (more) { dn = tr_desc(P, nx); tr_load(dn, lane, vb); }
                tr_store(d, lane, va, scr);
                if (!more) break;
#pragma unroll
                for (int i = 0; i < 8; ++i) va[i] = vb[i];
                d = dn; it = nx; } }
    }
    {   f32x4 va[8], vb[8];
        int m = gw;
        if (m < M) { rms_load(P.x + (size_t)m * DM, lane, va);
            for (;;) { const int nx = m + NGW; const bool more = nx < M;
                if (more) rms_load(P.x + (size_t)nx * DM, lane, vb);
                rms_store(va, P.norm_g, Hn + (size_t)m * DM, lane);
                if (!more) break;
#pragma unroll
                for (int i = 0; i < 8; ++i) va[i] = vb[i];
                m = nx; } }
    }
}

__device__ __forceinline__ void p2_gates_naive(Frame& F, const Params& P) {
    const f16s* proj = (const f16s*)(P.ws + WS_PROJ); float* abuf = (float*)(P.ws + WS_A); float* bbuf = (float*)(P.ws + WS_B);
    LAS float* xs = (LAS float*)(F.lds + RING_OFF);
    const int tid = F.tid;
    for (int it = F.vcu; it < (M / 16) * LRU_BLK; it += F.G) {
        const int rt = it >> 3, g = it & 7, r0 = rt * 16;
#pragma unroll
        for (int i = 0; i < 4; ++i) { const int e = tid + NT * i, r = e >> 7, c = e & 127, row = r0 + r, t = row & (SEQ - 1), ch = g * 128 + c;
            float v = P.conv_b[ch];
#pragma unroll
            for (int j = 0; j < 4; ++j) { const int tt = t - 3 + j; if (tt >= 0) v += h2f(proj[(size_t)(row - 3 + j) * NINP + C_XA + ch]) * P.conv_w[j * LRU_W + ch]; }
            xs[r * 128 + c] = v; }
        __syncthreads();
        const int j = tid & 127, rh = tid >> 7;
        float ar[4] = {0.f, 0.f, 0.f, 0.f}, ai[4] = {0.f, 0.f, 0.f, 0.f};
        const float* wag = P.wa + (size_t)g * 128 * 128; const float* wxg = P.wx + (size_t)g * 128 * 128;
        for (int i = 0; i < 128; ++i) { const float w1 = wag[i * 128 + j], w2 = wxg[i * 128 + j];
#pragma unroll
            for (int r = 0; r < 4; ++r) { const float xv = xs[(rh * 4 + r) * 128 + i]; ar[r] += xv * w1; ai[r] += xv * w2; } }
        const int ch = g * 128 + j; const float sp = log1pf(expf(-P.lam[ch])), bav = P.ba[ch], bxv = P.bx[ch];
#pragma unroll
        for (int r = 0; r < 4; ++r) { const int row = r0 + rh * 4 + r, t = row & (SEQ - 1);
            const float rg = sigmoidf_(ar[r] + bav), ig = sigmoidf_(ai[r] + bxv), la = -8.f * rg * sp, a = expf(la);
            float mult = sqrtf(-expm1f(2.f * la)); if (t == 0) mult = 1.f;
            abuf[(size_t)row * LRU_W + ch] = a; bbuf[(size_t)row * LRU_W + ch] = mult * (ig * xs[(rh * 4 + r) * 128 + j]); }
        __syncthreads();
    }
}
__device__ __forceinline__ void p2_qabs_naive(Frame& F, const Params& P) {
    const f16s* proj = (const f16s*)(P.ws + WS_PROJ); f16s* qabs = (f16s*)(P.ws + WS_QABS);
    LAS float* qs = (LAS float*)(F.lds + RING_OFF);
    const int tid = F.tid;
    for (int it = F.vcu; it < (M / 16) * NH; it += F.G) {
        const int rt = it >> 3, h = it & 7, r0 = rt * 16;
#pragma unroll
        for (int i = 0; i < 4; ++i) { const int e = tid + NT * i, r = e >> 7, c = e & 127; qs[r * 128 + c] = h2f(proj[(size_t)(r0 + r) * NINP + C_Q + h * HD + c]); }
        __syncthreads();
        const int c = tid & 255, rh = tid >> 8;
        float acc[8];
#pragma unroll
        for (int r = 0; r < 8; ++r) acc[r] = 0.f;
        const float* wk = P.w_uk + (size_t)h * HD * CL + c;
        for (int d = 0; d < HD; ++d) { const float w = wk[(size_t)d * CL];
#pragma unroll
            for (int r = 0; r < 8; ++r) acc[r] += qs[(rh * 8 + r) * 128 + d] * w; }
#pragma unroll
        for (int r = 0; r < 8; ++r) qabs[(size_t)(r0 + rh * 8 + r) * (NH * CL) + h * CL + c] = __builtin_bit_cast(f16s, (f16)acc[r]);
        __syncthreads();
    }
}
__device__ __forceinline__ void p2_qabs_mfma(Frame& F, const Params& P) {
    const f16s* proj = (const f16s*)(P.ws + WS_PROJ); f16s* qabs = (f16s*)(P.ws + WS_QABS);
    int lane = F.lane; asm volatile("" : "+v"(lane));
    const int q = lane >> 4, fr = lane & 15, gw = F.vcu * NWAVES + F.wave, NGW = F.G * NWAVES, role = gw & 15, h = role >> 1, nh = role & 1;
    h8 W[8][4];
    { const f16s* wp = (const f16s*)(P.ws + WS_WUKT) + ((size_t)h * CL + nh * 128 + fr) * HD + 8 * q;
#pragma unroll
      for (int nt = 0; nt < 8; ++nt)
#pragma unroll
          for (int ks = 0; ks < 4; ++ks) W[nt][ks] = *(const GAS h8*)(wp + (size_t)nt * 16 * HD + 32 * ks); }
    const f32x4 zero4 = {0.f, 0.f, 0.f, 0.f};
    for (int rt = gw >> 4; rt < M / 16; rt += NGW >> 4) {
        const int row = rt * 16 + fr;
        h8 B[4];
        { const f16s* qp = proj + (size_t)row * NINP + C_Q + h * HD + 8 * q;
#pragma unroll
          for (int ks = 0; ks < 4; ++ks) B[ks] = *(const GAS h8*)(qp + 32 * ks); }
        f16s* op = qabs + (size_t)row * (NH * CL) + h * CL + nh * 128 + 4 * q;
#pragma unroll
        for (int nt = 0; nt < 8; ++nt) { f32x4 acc = zero4;
#pragma unroll
            for (int ks = 0; ks < 4; ++ks) acc = __builtin_amdgcn_mfma_f32_16x16x32_f16(W[nt][ks], B[ks], acc, 0, 0, 0);
            v2u o; o.x = pkh(acc[0], acc[1]); o.y = pkh(acc[2], acc[3]); *(GAS v2u*)(op + 16 * nt) = o; }
    }
}
__device__ __forceinline__ void glds16(const void* gsrc, unsigned lds_dst) { unsigned keep;
    asm volatile("s_mov_b32 %0, m0\n\ts_mov_b32 m0, %2\n\ts_nop 0\n\tglobal_load_lds_dwordx4 %1, off\n\ts_mov_b32 m0, %0" : "=&s"(keep) : "v"(gsrc), "s"(lds_dst) : "memory"); }
template <int CTRL> __device__ __forceinline__ float dppf(float oldv, float v) { return __builtin_bit_cast(float, __builtin_amdgcn_update_dpp(__builtin_bit_cast(int, oldv), __builtin_bit_cast(int, v), CTRL, 0xF, 0xF, false)); }
constexpr int XS_OFF = 32768, XS_WAVE = 10240, XS_BUF = 5120;
__device__ __forceinline__ void p2_gscan(Frame& F, const Params& P) {
    const f16s* proj = (const f16s*)(P.ws + WS_PROJ); f16s* pcb = (f16s*)(P.ws + WS_A); f16s* hlb = pcb + (size_t)M * LRU_W; float* agg = (float*)(P.ws + WS_AGG);
    LAS float* CW = (LAS float*)(F.lds + RING_OFF);
    LAS float* CB = CW + 4 * LRU_W; LAS float* NSP = CB + LRU_W; LAS float* BA = NSP + LRU_W; LAS float* BX = BA + LRU_W;
    for (int e = F.tid; e < 4 * LRU_W; e += NT) CW[e] = P.conv_w[e];
    for (int e = F.tid; e < LRU_W; e += NT) { CB[e] = P.conv_b[e]; NSP[e] = -8.f * log1pf(expf(-P.lam[e])); BA[e] = P.ba[e]; BX[e] = P.bx[e]; }
    __syncthreads();
    int lane = F.lane; asm volatile("" : "+v"(lane));
    const int q = lane >> 4, fr = lane & 15, gw = F.vcu * NWAVES + F.wave, NGW = F.G * NWAVES, role = gw & 31, g = role >> 2, nq = role & 3;
    h8 WA[2][4], WX[2][4];
    { const size_t wo = ((size_t)g * LRU_BD + nq * 32 + fr) * LRU_BD + 8 * q; const f16s* wap = (const f16s*)(P.ws + WS_WAT) + wo; const f16s* wxp = (const f16s*)(P.ws + WS_WXT) + wo;
#pragma unroll
      for (int nt = 0; nt < 2; ++nt)
#pragma unroll
          for (int ks = 0; ks < 4; ++ks) { WA[nt][ks] = *(const GAS h8*)(wap + (size_t)nt * 16 * LRU_BD + 32 * ks); WX[nt][ks] = *(const GAS h8*)(wxp + (size_t)nt * 16 * LRU_BD + 32 * ks); } }
    asm volatile("" :: "v"(WA[0][0]), "v"(WA[0][1]), "v"(WA[0][2]), "v"(WA[0][3]), "v"(WA[1][0]), "v"(WA[1][1]), "v"(WA[1][2]), "v"(WA[1][3]));
    asm volatile("" :: "v"(WX[0][0]), "v"(WX[0][1]), "v"(WX[0][2]), "v"(WX[0][3]), "v"(WX[1][0]), "v"(WX[1][1]), "v"(WX[1][2]), "v"(WX[1][3]));
    LAS unsigned char* xs = F.lds + XS_OFF + F.wave * XS_WAVE;
    const unsigned xsaddr = (unsigned)__builtin_amdgcn_readfirstlane((int)(unsigned)(size_t)xs);
    const f32x4 zero4 = {0.f, 0.f, 0.f, 0.f}, one4 = {1.f, 1.f, 1.f, 1.f};
    for (int idx = gw >> 5; idx < (M / 128); idx += NGW >> 5) {
        const int b = idx >> 4, rbase = idx * 128, bstart = b * SEQ;
        auto issue = [&](int k) {
#pragma unroll
            for (int p = 0; p < 5; ++p) { const int rr = 4 * p + q; int row = rbase + 16 * k - 4 + rr; row = row < bstart ? bstart : row;
                glds16(proj + (size_t)row * NINP + C_XA + g * 128 + 8 * (fr ^ (rr & 15)), xsaddr + (unsigned)((k & 1) * XS_BUF + p * 1024)); }
        };
        f32x4 hc[2] = {zero4, zero4}, Ac[2] = {one4, one4};
        issue(0);
#pragma unroll 1
        for (int k = 0; k < 8; ++k) {
            if (k + 1 < 8) { issue(k + 1); asm volatile("s_waitcnt vmcnt(5)" ::: "memory"); } else asm volatile("s_waitcnt vmcnt(0)" ::: "memory");
            const LAS unsigned char* xb = xs + (k & 1) * XS_BUF;
            const int row = rbase + 16 * k + fr, t = row & (SEQ - 1);
            h8 XB[4];
#pragma unroll
            for (int ks = 0; ks < 4; ++ks) { const int c0 = g * 128 + 32 * ks + 8 * q;
                float v[8];
                { const f32x4 b0 = *(const LAS f32x4*)(CB + c0), b1 = *(const LAS f32x4*)(CB + c0 + 4); v[0] = b0[0]; v[1] = b0[1]; v[2] = b0[2]; v[3] = b0[3]; v[4] = b1[0]; v[5] = b1[1]; v[6] = b1[2]; v[7] = b1[3]; }
#pragma unroll
                for (int j = 0; j < 4; ++j) { const int rr = fr + 1 + j; const h8 xv = *(const LAS h8*)(xb + 256 * rr + 16 * ((4 * ks + q) ^ (rr & 15)));
                    const f32x4 w0 = *(const LAS f32x4*)(CW + j * LRU_W + c0), w1 = *(const LAS f32x4*)(CW + j * LRU_W + c0 + 4); const float mk = (t - 3 + j >= 0) ? 1.f : 0.f;
#pragma unroll
                    for (int e = 0; e < 4; ++e) { v[e] += mk * (float)xv[e] * w0[e]; v[4 + e] += mk * (float)xv[4 + e] * w1[e]; } }
#pragma unroll
                for (int e = 0; e < 8; ++e) XB[ks][e] = (f16)v[e];
                asm volatile("" : "+v"(XB[ks])); }
            f32x4 av[2], bv[2];
#pragma unroll
            for (int nt = 0; nt < 2; ++nt) { f32x4 ar = zero4, ai = zero4;
#pragma unroll
                for (int ks = 0; ks < 4; ++ks) { ar = __builtin_amdgcn_mfma_f32_16x16x32_f16(WA[nt][ks], XB[ks], ar, 0, 0, 0); ai = __builtin_amdgcn_mfma_f32_16x16x32_f16(WX[nt][ks], XB[ks], ai, 0, 0, 0); }
                const int ch = g * 128 + nq * 32 + 16 * nt + 4 * q, cq = 4 * nq + 2 * nt + (q >> 1);
                f32x4 xc = *(const LAS f32x4*)(CB + ch);
#pragma unroll
                for (int j = 0; j < 4; ++j) { const int rr = fr + 1 + j; const h4 xv = *(const LAS h4*)(xb + 256 * rr + 16 * (cq ^ (rr & 15)) + 8 * (q & 1)); const f32x4 w0 = *(const LAS f32x4*)(CW + j * LRU_W + ch); const float mk = (t - 3 + j >= 0) ? 1.f : 0.f;
#pragma unroll
                    for (int e = 0; e < 4; ++e) xc[e] += mk * (float)xv[e] * w0[e]; }
                const f32x4 nsp = *(const LAS f32x4*)(NSP + ch), bav = *(const LAS f32x4*)(BA + ch), bxv = *(const LAS f32x4*)(BX + ch);
#pragma unroll
                for (int e = 0; e < 4; ++e) { const float rg = sigmoidf_(ar[e] + bav[e]), ig = sigmoidf_(ai[e] + bxv[e]), a = __expf(rg * nsp[e]);
                    float mult = __builtin_amdgcn_sqrtf(fmaxf(1.f - a * a, 0.f)); if (t == 0) mult = 1.f;
                    av[nt][e] = a; bv[nt][e] = mult * (ig * xc[e]); } }
#pragma unroll
            for (int nt = 0; nt < 2; ++nt)
#pragma unroll
                for (int e = 0; e < 4; ++e) { float a = av[nt][e], bb = bv[nt][e];
                    { const float ap = dppf<0x111>(1.f, a), bp = dppf<0x111>(0.f, bb); bb = a * bp + bb; a = a * ap; }
                    { const float ap = dppf<0x112>(1.f, a), bp = dppf<0x112>(0.f, bb); bb = a * bp + bb; a = a * ap; }
                    { const float ap = dppf<0x114>(1.f, a), bp = dppf<0x114>(0.f, bb); bb = a * bp + bb; a = a * ap; }
                    { const float ap = dppf<0x118>(1.f, a), bp = dppf<0x118>(0.f, bb); bb = a * bp + bb; a = a * ap; }
                    bv[nt][e] = a * hc[nt][e] + bb; av[nt][e] = a * Ac[nt][e]; }
#pragma unroll
            for (int nt = 0; nt < 2; ++nt) { const size_t o = (size_t)row * LRU_W + g * 128 + nq * 32 + 16 * nt + 4 * q;
                v2u w; w.x = pkh(av[nt][0], av[nt][1]); w.y = pkh(av[nt][2], av[nt][3]); *(GAS v2u*)(pcb + o) = w;
                w.x = pkh(bv[nt][0], bv[nt][1]); w.y = pkh(bv[nt][2], bv[nt][3]); *(GAS v2u*)(hlb + o) = w;
#pragma unroll
                for (int e = 0; e < 4; ++e) { hc[nt][e] = __shfl(bv[nt][e], 16 * q + 15); Ac[nt][e] = __shfl(av[nt][e], 16 * q + 15); } }
        }
        if (fr == 0) {
#pragma unroll
            for (int nt = 0; nt < 2; ++nt) { const int ch = g * 128 + nq * 32 + 16 * nt + 4 * q;
                *(GAS f32x4*)(agg + ((size_t)idx * 2 + 0) * LRU_W + ch) = Ac[nt]; *(GAS f32x4*)(agg + ((size_t)idx * 2 + 1) * LRU_W + ch) = hc[nt]; } }
    }
    __syncthreads();
}
__device__ __forceinline__ void p2_norms(Frame& F, const Params& P) {
    const f16s* proj = (const f16s*)(P.ws + WS_PROJ); f16s* cn = (f16s*)(P.ws + WS_CN); f16s* kn = (f16s*)(P.ws + WS_KN);
    const int gw = F.vcu * NWAVES + F.wave, NGW = F.G * NWAVES, lane = F.lane;
    for (int row = gw; row < M; row += NGW) {
        const h4 cv = *(const GAS h4*)(proj + (size_t)row * NINP + C_CKV + 4 * lane);
        const float c0 = (float)cv[0], c1 = (float)cv[1], c2 = (float)cv[2], c3 = (float)cv[3];
        const float r = rsqrtf(wave_sum(c0 * c0 + c1 * c1 + c2 * c2 + c3 * c3) * (1.f / CL) + EPS);
        const f32x4 g = *(const GAS f32x4*)(P.ckv_g + 4 * lane);
        v2u o; o.x = pkh(c0 * r * g.x, c1 * r * g.y); o.y = pkh(c2 * r * g.z, c3 * r * g.w);
        *(GAS v2u*)(cn + (size_t)row * CL + 4 * lane) = o;
        const float kv = h2f(proj[(size_t)row * NINP + C_KI + lane]);
        const float mu = wave_sum(kv) * (1.f / ID), d = kv - mu, var = wave_sum(d * d) * (1.f / ID);
        kn[(size_t)row * ID + lane] = __builtin_bit_cast(f16s, (f16)(d * rsqrtf(var + EPS) * P.ikg[lane] + P.ikb[lane]));
    }
}

__device__ __forceinline__ void p3_lru_fix(Frame& F, const Params& P) {
    const f16s* pcb = (const f16s*)(P.ws + WS_A); const f16s* hlb = pcb + (size_t)M * LRU_W; const float* agg = (const float*)(P.ws + WS_AGG);
    const f16s* proj = (const f16s*)(P.ws + WS_PROJ); f16s* y = (f16s*)(P.ws + WS_H);
    const int gw = F.vcu * NWAVES + F.wave, NGW = F.G * NWAVES;
    for (int it = gw; it < (M / 16) * 4; it += NGW) {
        const int tile = it >> 2, cg = it & 3, idx = tile >> 3, ck = idx & 15, ch = cg * 256 + 4 * F.lane; const size_t r0 = (size_t)tile * 16;
        f32x4 h = {0.f, 0.f, 0.f, 0.f};
        {   f32x4 ak[15], hk[15];
#pragma unroll
            for (int k = 0; k < 15; ++k) if (k < ck) { ak[k] = *(const GAS f32x4*)(agg + ((size_t)(idx - ck + k) * 2 + 0) * LRU_W + ch); hk[k] = *(const GAS f32x4*)(agg + ((size_t)(idx - ck + k) * 2 + 1) * LRU_W + ch); }
#pragma unroll
            for (int k = 0; k < 15; ++k) if (k < ck) h = ak[k] * h + hk[k]; }
#pragma unroll
        for (int s8 = 0; s8 < 2; ++s8) { h4 pv[8], lv[8], gv[8];
#pragma unroll
            for (int s = 0; s < 8; ++s) { const size_t r = r0 + 8 * s8 + s; pv[s] = *(const GAS h4*)(pcb + r * LRU_W + ch); lv[s] = *(const GAS h4*)(hlb + r * LRU_W + ch); gv[s] = *(const GAS h4*)(proj + r * NINP + C_GA + ch); }
#pragma unroll
            for (int s = 0; s < 8; ++s) { const size_t r = r0 + 8 * s8 + s; float o[4];
#pragma unroll
                for (int e = 0; e < 4; ++e) o[e] = ((float)pv[s][e] * h[e] + (float)lv[s][e]) * siluf_((float)gv[s][e]);
                v2u w; w.x = pkh(o[0], o[1]); w.y = pkh(o[2], o[3]); *(GAS v2u*)(y + r * DM + ch) = w; } }
    }
}
constexpr int AF_OFF = 0;
constexpr int TAB_OFF = RING_BYTES + 1024;
constexpr int IL_OFF = TAB_OFF;
constexpr int SGT_OFF = IL_OFF + 8192;
constexpr int CNT_OFF = SGT_OFF + 1024;
constexpr int WCNT_OFF = CNT_OFF + 128;
constexpr int CNTQ_OFF = WCNT_OFF + 256;
constexpr int BIAS_OFF = CNTQ_OFF + 64;
constexpr int MM_OFF = BIAS_OFF + 4224;
constexpr int NEED_OFF = MM_OFF + 128;
constexpr int SELB_OFF = NEED_OFF + 128;
constexpr int WC2_OFF = SELB_OFF + 64;
constexpr int TAB_END = WC2_OFF + 512;
constexpr int HIST_OFF = 36864;
static_assert(TAB_END <= LDS_BYTES, "LDS map");
typedef short v4i16 __attribute__((ext_vector_type(4)));
typedef _Float16 h4v __attribute__((ext_vector_type(4)));

__device__ __forceinline__ unsigned fkey(float f) { const unsigned u = __float_as_uint(f); return (u & 0x80000000u) ? ~u : (u | 0x80000000u); }
__device__ __forceinline__ float finv(unsigned k) { return __uint_as_float((k & 0x80000000u) ? (k ^ 0x80000000u) : ~k); }
__device__ __forceinline__ unsigned rowsum16(unsigned v) { v += __shfl_xor(v, 1); v += __shfl_xor(v, 2); v += __shfl_xor(v, 4); v += __shfl_xor(v, 8); return v; }

template <int MODE> __device__ __forceinline__ void p3_d1(Frame& F, const Params& P, int b, int i) {
    const f16s* proj = (const f16s*)(P.ws + WS_PROJ); const f16s* kn = (const f16s*)(P.ws + WS_KN);
    int tid = F.tid; asm volatile("" : "+v"(tid));
    const int lane = tid & 63, wave = F.wave, q = lane >> 4, fr = lane & 15;
    const int row0 = b * SEQ + 16 * i, ntile = i + 1;
    LAS unsigned char* AF = F.lds + AF_OFF;
    LAS float* SGT = (LAS float*)(F.lds + SGT_OFF);
    LAS unsigned* CNT = (LAS unsigned*)(F.lds + CNT_OFF);
    LAS unsigned* WCNT = (LAS unsigned*)(F.lds + WCNT_OFF);
    LAS unsigned* CNTQ = (LAS unsigned*)(F.lds + CNTQ_OFF);
    LAS unsigned short* IL = (LAS unsigned short*)(F.lds + IL_OFF);
#pragma unroll
    for (int e = 0; e < 4; ++e) { const int f = tid + NT * e, h = f >> 7, ks = (f >> 6) & 1, ln = f & 63, r = ln & 15, kq = ln >> 4;
        const f16s* rowp = proj + (size_t)(row0 + r) * NINP;
        const h8 v = *(const GAS h8*)(rowp + C_QI + h * 64 + 32 * ks + 8 * kq); const float w = fabsf(h2f(rowp[C_WI + h]));
        h8 o;
#pragma unroll
        for (int j = 0; j < 8; ++j) o[j] = (f16)((float)v[j] * w);
        *(LAS h8*)(AF + (h * 2 + ks) * 1024 + ln * 16) = o; }
    if (tid < 128) { const int ks = tid >> 6, ln = tid & 63, r = ln & 15, kq = ln >> 4; const f16s* rowp = proj + (size_t)(row0 + r) * NINP;
        float acc[8];
#pragma unroll
        for (int j = 0; j < 8; ++j) acc[j] = 0.f;
        h8 vv[IH]; h8 wv0 = *(const GAS h8*)(rowp + C_WI), wv1 = *(const GAS h8*)(rowp + C_WI + 8);
#pragma unroll
        for (int h = 0; h < IH; ++h) vv[h] = *(const GAS h8*)(rowp + C_QI + h * 64 + 32 * ks + 8 * kq);
#pragma unroll
        for (int h = 0; h < IH; ++h) { const float w = (float)(h < 8 ? wv0[h & 7] : wv1[h & 7]);
#pragma unroll
            for (int j = 0; j < 8; ++j) acc[j] += (float)vv[h][j] * w; }
        h8 o;
#pragma unroll
        for (int j = 0; j < 8; ++j) o[j] = (f16)acc[j];
        *(LAS h8*)(AF + (32 + ks) * 1024 + ln * 16) = o; }
    if (tid < 256) { const int r = tid >> 4, h = tid & 15; SGT[h * 16 + r] = h2f(proj[(size_t)(row0 + r) * NINP + C_WI + h]) >= 0.f ? 1.f : -1.f; }
    if (tid < 24) CNT[tid] = 0u;
    if (tid < 32) ((LAS unsigned*)(F.lds + MM_OFF))[tid] = (tid & 1) ? 0u : 0xFFFFFFFFu;
    if (tid < 16) ((LAS unsigned*)(F.lds + NEED_OFF))[tid] = (unsigned)TOPK;
    __syncthreads();
    float key[16][4];
    const f32x4 zero4 = {0.f, 0.f, 0.f, 0.f};
#pragma unroll
    for (int p = 0; p < 4; ++p) {
        f32x4 sc[4] = {zero4, zero4, zero4, zero4};
        if (wave + 32 * p < ntile) {
            h8 bk[4][2];
#pragma unroll
            for (int jj = 0; jj < 4; ++jj) { int kt = wave + 8 * (4 * p + jj); kt = kt < ntile ? kt : ntile - 1;
                const f16s* kr = kn + ((size_t)b * SEQ + 16 * kt + fr) * ID + 8 * q; bk[jj][0] = *(const GAS h8*)kr; bk[jj][1] = *(const GAS h8*)(kr + 32); }
            h8 a0 = *(const LAS h8*)(AF + lane * 16), a1 = *(const LAS h8*)(AF + 1024 + lane * 16);
            f32x4 sg = *(const LAS f32x4*)(SGT + 4 * q);
#pragma unroll
            for (int h = 0; h <= IH; ++h) {
                h8 n0 = a0, n1 = a1; f32x4 ng = sg;
                if (h < IH) { n0 = *(const LAS h8*)(AF + (2 * h + 2) * 1024 + lane * 16); n1 = *(const LAS h8*)(AF + (2 * h + 3) * 1024 + lane * 16); if (h + 1 < IH) ng = *(const LAS f32x4*)(SGT + (h + 1) * 16 + 4 * q); }
#pragma unroll
                for (int jj = 0; jj < 4; ++jj) { f32x4 S = __builtin_amdgcn_mfma_f32_16x16x32_f16(a0, bk[jj][0], zero4, 0, 0, 0); S = __builtin_amdgcn_mfma_f32_16x16x32_f16(a1, bk[jj][1], S, 0, 0, 0);
                    if (h < IH) {
#pragma unroll
                        for (int e = 0; e < 4; ++e) sc[jj][e] = __builtin_fmaf(__builtin_fabsf(S[e]), sg[e], sc[jj][e]);
                    } else sc[jj] += S; }
                asm volatile("" : "+v"(sc[0]), "+v"(sc[1]), "+v"(sc[2]), "+v"(sc[3]));
                __builtin_amdgcn_sched_barrier(0);
                a0 = n0; a1 = n1; sg = ng;
            }
            __builtin_amdgcn_sched_barrier(0);
        }
#pragma unroll
        for (int jj = 0; jj < 4; ++jj) { const int kt = wave + 8 * (4 * p + jj);
#pragma unroll
            for (int e = 0; e < 4; ++e) { const bool valid = (kt < i) || (kt == i && fr <= 4 * q + e); key[4 * p + jj][e] = valid ? sc[jj][e] : -INFINITY; } }
        __builtin_amdgcn_sched_barrier(0);
    }
    __syncthreads();
#pragma unroll
    for (int j = 0; j < 16; ++j)
#pragma unroll
        for (int e = 0; e < 4; ++e) *(LAS float*)(F.lds + (4 * q + e) * 8192 + (16 * (wave + 8 * j) + fr) * 4) = key[j][e];
    __syncthreads();
}

__device__ __forceinline__ int p3_select(LAS unsigned char* lds, int lane, int r, int n  ) {
    const LAS unsigned char* rowp = lds + r * 8192 + 16 * lane;
    LAS unsigned short* il = (LAS unsigned short*)(lds + IL_OFF) + r * TOPK;
    f32x4 sv[8];
#pragma unroll
    for (int i = 0; i < 8; ++i) sv[i] = *(const LAS f32x4*)(rowp + 1024 * i);
    float thr = -3.0e38f;
    if (n > TOPK) {
        float lo = INFINITY, hi = -INFINITY;
#pragma unroll
        for (int i = 0; i < 8; ++i)
#pragma unroll
            for (int c = 0; c < 4; ++c) { const float x = sv[i][c]; hi = fmaxf(hi, x); lo = fminf(lo, x > -INFINITY ? x : INFINITY); }
#pragma unroll
        for (int o = 1; o < 64; o <<= 1) { lo = fminf(lo, __shfl_xor(lo, o)); hi = fmaxf(hi, __shfl_xor(hi, o)); }
        int clo = n, chi = 0;
#pragma unroll
        for (int i = 0; i < 8; ++i)
#pragma unroll
            for (int c = 0; c < 4; ++c) chi += __builtin_popcountll(__ballot(sv[i][c] >= hi));
        thr = lo;
        if (chi >= TOPK) thr = hi;
        else {
            for (int it = 0; it < 64; ++it) {
                float g = (it & 1) ? lo + 0.5f * (hi - lo) : lo + (hi - lo) * ((float)(clo - TOPK) / (float)(clo - chi));
                if (!(g > lo && g < hi)) g = lo + 0.5f * (hi - lo);
                if (!(g > lo && g < hi)) { thr = lo; break; }
                int cg = 0;
#pragma unroll
                for (int i = 0; i < 8; ++i)
#pragma unroll
                    for (int c = 0; c < 4; ++c) cg += __builtin_popcountll(__ballot(sv[i][c] >= g));
                if (cg == TOPK) { thr = g; break; }
                if (cg > TOPK) { lo = g; clo = cg; thr = g; } else { hi = g; chi = cg; }
            }
        }
    }
    int base = 0;
#pragma unroll
    for (int i = 0; i < 8; ++i)
#pragma unroll
        for (int c = 0; c < 4; ++c) { const bool sel = sv[i][c] >= thr; const unsigned long long mk = __ballot(sel);
            const int pos = base + (int)__builtin_amdgcn_mbcnt_hi((unsigned)(mk >> 32), __builtin_amdgcn_mbcnt_lo((unsigned)mk, 0u));
            if (sel && pos < TOPK) il[pos] = (unsigned short)(256 * i + 4 * lane + c);
            base += __builtin_popcountll(mk); }
    return base < TOPK ? base : TOPK;
}

__device__ __forceinline__ void attn_query_naive(Frame& F, const Params& P, int row, const LAS unsigned short* il, int cnt) {
    const f16s* proj = (const f16s*)(P.ws + WS_PROJ); const f16s* cn = (const f16s*)(P.ws + WS_CN);
    const f16s* qabs = (const f16s*)(P.ws + WS_QABS); f16s* y = (f16s*)(P.ws + WS_H);
    LAS float* qa = (LAS float*)(F.lds + 40960);
    LAS float* lg = qa + 2048;
    LAS float* os = lg + 2048;
    int tid = F.tid; asm volatile("" : "+v"(tid));
    const int lane = tid & 63, wave = F.wave;
    const int b = row >> 11, t = row & (SEQ - 1);
#pragma unroll
    for (int k = 0; k < 4; ++k) qa[tid + NT * k] = h2f(qabs[(size_t)row * (NH * CL) + tid + NT * k]);
    __syncthreads();
    {   const int j = tid & 255, hh = tid >> 8, s = j < cnt ? (int)il[j] : -1;
        float l[4] = {0.f, 0.f, 0.f, 0.f};
        if (s >= 0) {
            const GAS h8* cr = (const GAS h8*)(cn + ((size_t)b * SEQ + s) * CL);
            for (int c8 = 0; c8 < CL / 8; ++c8) { const h8 v = cr[c8];
#pragma unroll
                for (int e = 0; e < 8; ++e) { const float cv = (float)v[e];
#pragma unroll
                    for (int h = 0; h < 4; ++h) l[h] += qa[(hh * 4 + h) * CL + c8 * 8 + e] * cv; } }
            const int dist = t - s, bk = dist < 128 ? (int)BUCKET[dist] : 31;
#pragma unroll
            for (int h = 0; h < 4; ++h) l[h] = l[h] * 0.08838834764831845f + P.rel_bias[bk * NH + hh * 4 + h];
        } else {
#pragma unroll
            for (int h = 0; h < 4; ++h) l[h] = -INFINITY;
        }
#pragma unroll
        for (int h = 0; h < 4; ++h) lg[(hh * 4 + h) * TOPK + j] = l[h];
    }
    __syncthreads();
    {   float v[4], mx = -INFINITY;
#pragma unroll
        for (int k = 0; k < 4; ++k) { v[k] = lg[wave * TOPK + lane + 64 * k]; mx = fmaxf(mx, v[k]); }
        mx = wave_max(mx);
        float sm = 0.f;
#pragma unroll
        for (int k = 0; k < 4; ++k) { v[k] = expf(v[k] - mx); sm += v[k]; }
        const float inv = 1.f / wave_sum(sm);
#pragma unroll
        for (int k = 0; k < 4; ++k) lg[wave * TOPK + lane + 64 * k] = v[k] * inv;
    }
    __syncthreads();
    {   const int c = tid & 255, hh = tid >> 8;
        float o[4] = {0.f, 0.f, 0.f, 0.f};
        for (int j = 0; j < cnt; ++j) { const int s = il[j];
            const float cv = h2f(cn[((size_t)b * SEQ + s) * CL + c]);
#pragma unroll
            for (int h = 0; h < 4; ++h) o[h] += lg[(hh * 4 + h) * TOPK + j] * cv; }
#pragma unroll
        for (int h = 0; h < 4; ++h) os[(hh * 4 + h) * CL + c] = o[h];
    }
    __syncthreads();
#pragma unroll
    for (int k = 0; k < 2; ++k) { const int h = k * 4 + (tid >> 7), d = tid & 127;
        const float* wv = P.w_uv + (size_t)h * CL * HD + d; float acc = 0.f;
        for (int c = 0; c < CL; ++c) acc += os[h * CL + c] * wv[(size_t)c * HD];
        const float gb = h2f(proj[(size_t)row * NINP + C_GB + h * HD + d]);
        y[(size_t)row * DM + LRU_W + h * HD + d] = __builtin_bit_cast(f16s, (f16)(acc * siluf_(gb))); }
    __syncthreads();
}


template <int MODE> __device__ __forceinline__ void p3_d2_query(const Params& P, LAS unsigned char* lds, LAS unsigned char* buf, int lane, int b, int t, int row, int r, int cnt) {
    const f16s* cn = (const f16s*)(P.ws + WS_CN); const f16s* qabs = (const f16s*)(P.ws + WS_QABS); f16s* obuf = (f16s*)P.out;
    const LAS unsigned short* il = (const LAS unsigned short*)(lds + IL_OFF) + r * TOPK;
    const LAS float* BIAS = (const LAS float*)(lds + BIAS_OFF);
    const int q = lane >> 4, fr = lane & 15;
    h8 qb[8];
    { const f16s* qp = qabs + (size_t)row * (NH * CL) + (fr & 7) * CL + 8 * q;
#pragma unroll
      for (int ks = 0; ks < 8; ++ks) qb[ks] = *(const GAS h8*)(qp + 32 * ks); }
    asm volatile("" :: "v"(qb[0]), "v"(qb[1]), "v"(qb[2]), "v"(qb[3]), "v"(qb[4]), "v"(qb[5]), "v"(qb[6]), "v"(qb[7]));
    const unsigned bufaddr = (unsigned)__builtin_amdgcn_readfirstlane((int)(unsigned)(size_t)buf);
    const char* cnb = (const char*)(cn + (size_t)b * SEQ * CL) + 16 * ((lane & 15) ^ (q << 2));
    auto issue = [&](int c) {
        const unsigned dst = bufaddr + (unsigned)(c & 1) * 8192u;
        if (MODE == 1) return;
#pragma unroll
        for (int kq = 0; kq < 4; ++kq) { int pos = 16 * c + 4 * kq + q; pos = pos < cnt ? pos : 0;
            const char* src = cnb + (size_t)(MODE ? (il[pos] & 2047) : il[pos]) * (CL * 2);
            const char* s2 = (const char*)((size_t)src ^ (size_t)(16 * kq));
            glds16(s2, dst + kq * 1024); glds16(s2 + 256, dst + 4096 + kq * 1024); }
    };
    const int roff0 = 256 * fr + 64 * (fr & 3) + 16 * (q ^ ((fr >> 2) & 3));
    const int qq = fr >> 2, pp = fr & 3;
    const int trb = 256 * (4 * q + qq) + 16 * ((((pp >> 1) ^ (q & 1)) | (q & 2)) ^ (qq << 2)) + 8 * (pp & 1);
    f32x4 Y[16];
    const f32x4 zero4 = {0.f, 0.f, 0.f, 0.f};
#pragma unroll
    for (int ct = 0; ct < 16; ++ct) Y[ct] = zero4;
    float m = -INFINITY, ssum = 0.f;
    issue(0);
#pragma unroll 1
    for (int c = 0; c < 16; ++c) {
        if (c + 1 < 16) { issue(c + 1); asm volatile("s_waitcnt vmcnt(8)" ::: "memory"); }
        else asm volatile("s_waitcnt vmcnt(0)" ::: "memory");
        const LAS unsigned char* bb = buf + (c & 1) * 8192;
        if (MODE == 2 || MODE == 6 || MODE == 7) continue;
        f32x4 X = zero4;
        {   h8 a[8];
#pragma unroll
            for (int s = 0; s < 8; ++s) a[s] = *(const LAS h8*)(bb + (s >> 2) * 4096 + (roff0 ^ (64 * (s & 3))));
            asm volatile("" : "+v"(a[0]), "+v"(a[1]), "+v"(a[2]), "+v"(a[3]), "+v"(a[4]), "+v"(a[5]), "+v"(a[6]), "+v"(a[7]));
#pragma unroll
            for (int s = 0; s < 8; ++s) X = __builtin_amdgcn_mfma_f32_16x16x32_f16(a[s], qb[s], X, 0, 0, 0); }
        float l[4];
        {   const v4i16 kk = *(const LAS v4i16*)(il + 16 * c + 4 * q);
            float bs[4];
#pragma unroll
            for (int e = 0; e < 4; ++e) { int d = t - (int)(unsigned short)kk[e]; d = d < 0 ? 0 : (d > 128 ? 128 : d); bs[e] = BIAS[d * 8 + (fr & 7)]; }
            asm volatile("" : "+v"(bs[0]), "+v"(bs[1]), "+v"(bs[2]), "+v"(bs[3]));
#pragma unroll
            for (int e = 0; e < 4; ++e) { const int pa = 16 * c + 4 * q + e; l[e] = pa < cnt ? X[e] * 0.08838834764831845f + bs[e] : -INFINITY; } }
        float mx = fmaxf(fmaxf(l[0], l[1]), fmaxf(l[2], l[3]));
        if (c == 0) { mx = fmaxf(mx, __shfl_xor(mx, 16)); mx = fmaxf(mx, __shfl_xor(mx, 32)); m = mx; }
        else if (__any(mx > m + 8.f)) {
            mx = fmaxf(mx, __shfl_xor(mx, 16)); mx = fmaxf(mx, __shfl_xor(mx, 32));
            const float mn = fmaxf(m, mx), al = __expf(m - mn);
#pragma unroll
            for (int ct = 0; ct < 16; ++ct) Y[ct] *= al;
            ssum *= al; m = mn; }
        h8 pbl, pbh;
#pragma unroll
        for (int e = 0; e < 4; ++e) { const float p = __expf(l[e] - m); ssum += p; pbl[e] = (f16)p; pbl[4 + e] = (f16)0.f; pbh[e] = (f16)0.f; pbh[4 + e] = (f16)p; }
        if (MODE == 3) continue;
#pragma unroll
        for (int g = 0; g < 2; ++g) {
            v4i16 tv[8];
#pragma unroll
            for (int j = 0; j < 8; ++j) { const int ct = 8 * g + j; tv[j] = __builtin_amdgcn_ds_read_tr16_b64_v4i16((LAS v4i16*)(bb + (ct >> 3) * 4096 + (trb ^ (32 * (ct & 7))))); }
#pragma unroll
            for (int j = 0; j < 8; j += 2) { h8 a2 = __builtin_bit_cast(h8, __builtin_shufflevector(tv[j], tv[j + 1], 0, 1, 2, 3, 4, 5, 6, 7));
                asm volatile("" : "+v"(a2));
                Y[8 * g + j] = __builtin_amdgcn_mfma_f32_16x16x32_f16(a2, pbl, Y[8 * g + j], 0, 0, 0);
                Y[8 * g + j + 1] = __builtin_amdgcn_mfma_f32_16x16x32_f16(a2, pbh, Y[8 * g + j + 1], 0, 0, 0); }
        }
    }
    ssum += __shfl_xor(ssum, 16); ssum += __shfl_xor(ssum, 32);
    const float inv = 1.f / ssum;
    if (fr < 8) { f16s* op = obuf + (size_t)row * (NH * CL) + fr * CL + 4 * q;
#pragma unroll
        for (int ct = 0; ct < 16; ++ct) { v2u o; o.x = pkh(Y[ct][0] * inv, Y[ct][1] * inv); o.y = pkh(Y[ct][2] * inv, Y[ct][3] * inv); *(GAS v2u*)(op + 16 * ct) = o; } }
}

__device__ __forceinline__ void p3_v_stream(Frame& F, const Params& P) {
    const f16s* obuf = (const f16s*)P.out; const f16s* proj = (const f16s*)(P.ws + WS_PROJ); f16s* y = (f16s*)(P.ws + WS_H);
    int lane = F.lane; asm volatile("" : "+v"(lane));
    const int q = lane >> 4, fr = lane & 15, gw = F.vcu * NWAVES + F.wave, NGW = F.G * NWAVES, role = gw & 31, h = role >> 2, nq = role & 3;
    h8 W[2][8];
    { const f16s* wp = (const f16s*)(P.ws + WS_WUVT) + ((size_t)h * HD + nq * 32 + fr) * CL + 8 * q;
#pragma unroll
      for (int nt = 0; nt < 2; ++nt)
#pragma unroll
          for (int ks = 0; ks < 8; ++ks) W[nt][ks] = *(const GAS h8*)(wp + (size_t)nt * 16 * CL + 32 * ks); }
    const f32x4 zero4 = {0.f, 0.f, 0.f, 0.f};
    h8 ob[8], on[8];
    int rt = gw >> 5; const int step = NGW >> 5;
    if (rt < M / 16) {
        { const f16s* op = obuf + (size_t)(rt * 16 + fr) * (NH * CL) + h * CL + 8 * q;
#pragma unroll
          for (int ks = 0; ks < 8; ++ks) ob[ks] = *(const GAS h8*)(op + 32 * ks); }
        for (;;) {
            const int nx = rt + step; const bool more = nx < M / 16;
            if (more) { const f16s* op = obuf + (size_t)(nx * 16 + fr) * (NH * CL) + h * CL + 8 * q;
#pragma unroll
                for (int ks = 0; ks < 8; ++ks) on[ks] = *(const GAS h8*)(op + 32 * ks); }
            const int row = rt * 16 + fr; const size_t col0 = (size_t)h * HD + nq * 32 + 4 * q;
            h4v g[2];
#pragma unroll
            for (int nt = 0; nt < 2; ++nt) g[nt] = *(const GAS h4v*)(proj + (size_t)row * NINP + C_GB + col0 + 16 * nt);
#pragma unroll
            for (int nt = 0; nt < 2; ++nt) { f32x4 acc = zero4;
#pragma unroll
                for (int ks = 0; ks < 8; ++ks) acc = __builtin_amdgcn_mfma_f32_16x16x32_f16(W[nt][ks], ob[ks], acc, 0, 0, 0);
                v2u o; o.x = pkh(acc[0] * siluf_((float)g[nt][0]), acc[1] * siluf_((float)g[nt][1])); o.y = pkh(acc[2] * siluf_((float)g[nt][2]), acc[3] * siluf_((float)g[nt][3]));
                *(GAS v2u*)(y + (size_t)row * DM + LRU_W + col0 + 16 * nt) = o; }
            if (!more) break;
#pragma unroll
            for (int ks = 0; ks < 8; ++ks) ob[ks] = on[ks];
            rt = nx;
        }
    }
}

template <int MODE> __device__ __forceinline__ void p3_items(Frame& F, const Params& P) {
    {
        LAS float* BIAS = (LAS float*)(F.lds + BIAS_OFF);
        for (int e = F.tid; e < 129 * 8; e += NT) { const int d = e >> 3, h = e & 7; BIAS[e] = P.rel_bias[(d < 128 ? (int)BUCKET[d] : 31) * NH + h]; }
    }
    __syncthreads();
#ifndef PROBE_D
#define PROBE_D 0
#endif
    unsigned long long acc_[4] = {0ull, 0ull, 0ull, 0ull};
    for (int u = F.vcu; u < BATCH * (SEQ / 16); u += F.G) {
        const int up = u & 255, k = u >> 8, b = up >> 6, j = up & 63, i = k ? 127 - j : j;
        unsigned long long t0_ = PROBE_D ? __builtin_amdgcn_s_memrealtime() : 0ull;
        if (MODE != 5) p3_d1<MODE>(F, P, b, i);
        unsigned long long t1_ = PROBE_D ? __builtin_amdgcn_s_memrealtime() : 0ull;
        int lane = F.lane; asm volatile("" : "+v"(lane));
        LAS unsigned char* buf = F.lds + F.wave * 16384;
        int cnt0 = 0, cnt1 = 0;
        if (MODE != 8) { cnt0 = p3_select(F.lds, lane, 2 * F.wave, 16 * i + 2 * F.wave + 1); cnt1 = p3_select(F.lds, lane, 2 * F.wave + 1, 16 * i + 2 * F.wave + 2); }
        if (MODE != 4 && MODE != 8)
#pragma unroll 1
        for (int rr = 0; rr < 2; ++rr) { const int r = 2 * F.wave + rr; p3_d2_query<MODE>(P, F.lds, buf, lane, b, 16 * i + r, b * SEQ + 16 * i + r, r, rr ? cnt1 : cnt0); }
        asm volatile("s_waitcnt vmcnt(0)" ::: "memory");
        __syncthreads();
        unsigned long long t2_ = PROBE_D ? __builtin_amdgcn_s_memrealtime() : 0ull;
        unsigned long long t3_ = PROBE_D ? __builtin_amdgcn_s_memrealtime() : 0ull;
        acc_[1] += t1_ - t0_; acc_[2] += t2_ - t1_; acc_[3] += t3_ - t2_;
    }
    if (PROBE_D && PROBE_D < 4 && blockIdx.x == 0) { const unsigned long long t1 = __builtin_amdgcn_s_memrealtime(); while (__builtin_amdgcn_s_memrealtime() - t1 < acc_[PROBE_D]) __builtin_amdgcn_s_sleep(8); }
    if (PROBE_D >= 4 && F.tid == 0) { const unsigned tot = (unsigned)(acc_[1] + acc_[2] + acc_[3]), d1 = (unsigned)acc_[1], d2 = (unsigned)acc_[2];
        __hip_atomic_fetch_max((unsigned*)(F.ctl + 8), tot, __ATOMIC_RELAXED, __HIP_MEMORY_SCOPE_AGENT); __hip_atomic_fetch_add((unsigned*)(F.ctl + 9), tot, __ATOMIC_RELAXED, __HIP_MEMORY_SCOPE_AGENT);
        __hip_atomic_fetch_max((unsigned*)(F.ctl + 10), d1, __ATOMIC_RELAXED, __HIP_MEMORY_SCOPE_AGENT); __hip_atomic_fetch_max((unsigned*)(F.ctl + 11), d2, __ATOMIC_RELAXED, __HIP_MEMORY_SCOPE_AGENT);
        __hip_atomic_fetch_add((unsigned*)(F.ctl + 12), d1, __ATOMIC_RELAXED, __HIP_MEMORY_SCOPE_AGENT); __hip_atomic_fetch_add((unsigned*)(F.ctl + 13), d2, __ATOMIC_RELAXED, __HIP_MEMORY_SCOPE_AGENT); }
}

__device__ __forceinline__ void p5_final(Frame& F, const Params& P) {
    const int gw = F.vcu * NWAVES + F.wave, NGW = F.G * NWAVES, lane = F.lane;
    for (int m = gw; m < M; m += NGW) {
        GAS f32x4* xr = (GAS f32x4*)(P.out + (size_t)m * DM) + lane; const GAS f32x4* gr = (const GAS f32x4*)P.fin_g + lane;
        f32x4 v[8]; float s = 0.f;
#pragma unroll
        for (int j = 0; j < 8; ++j) { v[j] = xr[64 * j]; s += (v[j].x * v[j].x + v[j].y * v[j].y) + (v[j].z * v[j].z + v[j].w * v[j].w); }
        const float r = rsqrtf(wave_sum(s) * (1.f / DM) + EPS);
#pragma unroll
        for (int j = 0; j < 8; ++j) xr[64 * j] = v[j] * r * gr[64 * j];
    }
}

__global__ void __launch_bounds__(NT, 2) fwd_kernel(Params P) {
    extern __shared__ __attribute__((aligned(16))) unsigned char lds[];
    Frame F;
    F.lds = (LAS unsigned char*)lds;
    F.MISC = (volatile LAS unsigned*)(F.lds + MISC_OFF);
    F.tid = threadIdx.x; F.lane = F.tid & 63; F.wave = __builtin_amdgcn_readfirstlane(F.tid >> 6);
    F.G = gridDim.x; { const int bx = blockIdx.x; F.vcu = (F.G % 8 == 0) ? (bx % 8) * (F.G / 8) + bx / 8 : bx; }
    F.ctl = (gu32*)(P.ws + WS_CTL);
    for (int u = F.tid; u < (LDS_BYTES - LDSCTL_OFF) / 4; u += NT) ((LAS unsigned*)(F.lds + LDSCTL_OFF))[u] = 0u;
    __syncthreads();
    XcdBarrier bar = xcd_barrier_post((unsigned*)(F.ctl + CW_BAR), F.MISC + 8);
#ifdef PROBE_S
    for (int k_ = 0; k_ < 12; ++k_) F.pt_acc[k_] = 0u;
    F.pt_last = __builtin_amdgcn_s_memrealtime();
#endif

#ifndef PROBE_REP
#define PROBE_REP 0
#endif
#ifndef PROBE_T
#define PROBE_T 0
#endif
    unsigned long long ts_[8]; int nst_ = 0;
#define STAMP() do { if (PROBE_T) { ts_[nst_] = __builtin_amdgcn_s_memrealtime(); } ++nst_; } while (0)
    STAMP();
#if PROBE_REP == 0
#define REP(n)
#else
#define REP(n) for (int rep_ = 0; rep_ < ((PROBE_REP == (n)) ? 2 : 1); ++rep_)
#endif
    REP(1) { p0_prologue(F, P); xcd_barrier(bar); }
    STAMP();
#define P1_BLOCK { pg8::Gemm g{(const pg8::bf16_t*)(P.ws + WS_H), (const pg8::bf16_t*)(P.ws + WS_WIN), M, NINP, DM}; \
        pg8::StaticOrder S; S.init(M, NINP, F.G, (int)blockIdx.x); \
        pg8::EpiF16 E{(pg8::bf16_t*)(P.ws + WS_PROJ), NINP}; \
        pg8::gemm_phase<pg8::EpiF16, pg8::StaticOrder, true, true>(F.lds + RING_OFF, g, S, E); \
        xcd_barrier(bar); }
    P1_BLOCK
    STAMP();
#if PROBE_REP == 2
    P1_BLOCK
#endif
    REP(3) { PSTAMP(F, 11); p2_gscan(F, P); PSTAMP(F, 0); p2_qabs_mfma(F, P); PSTAMP(F, 1); p2_norms(F, P); PSTAMP(F, 2); xcd_barrier(bar); PSTAMP(F, 11); }
    STAMP();
    REP(4) { p3_lru_fix(F, P); }
    STAMP();
#ifdef PROBE_M
    p3_items<PROBE_M>(F, P); xcd_barrier(bar);
#endif
    REP(5) { p3_items<0>(F, P); xcd_barrier(bar); p3_v_stream(F, P); xcd_barrier(bar); }
    STAMP();
    REP(6) { const int rep6_ = 0;
        pg8::Gemm g{(const pg8::bf16_t*)(P.ws + WS_H), (const pg8::bf16_t*)(P.ws + WS_WOUT), M, DM, DM};
        pg8::StaticOrder S; S.init(M, DM, F.G, (int)blockIdx.x);
        pg8::EpiResF32 E{P.x, P.out, DM};
        pg8::gemm_phase<pg8::EpiResF32, pg8::StaticOrder, false, true>(F.lds + RING_OFF, g, S, E);
        xcd_barrier(bar);
        if (rep6_ == 0) STAMP();
        p5_final(F, P);
        if (PROBE_REP == 6) xcd_barrier(bar);
    }
#ifdef PROBE_S
    {   if (F.tid == 0) for (int k_ = 0; k_ < 11; ++k_) { __hip_atomic_fetch_max((unsigned*)(F.ctl + 32 + 2 * k_), F.pt_acc[k_], __ATOMIC_RELAXED, __HIP_MEMORY_SCOPE_AGENT); __hip_atomic_fetch_add((unsigned*)(F.ctl + 33 + 2 * k_), F.pt_acc[k_] >> 8, __ATOMIC_RELAXED, __HIP_MEMORY_SCOPE_AGENT); }
        xcd_barrier(bar);
        if (blockIdx.x == 0) { const unsigned v = __hip_atomic_load((unsigned*)(F.ctl + 32 + PROBE_S), RLX_AGENT);
            const unsigned long long t1 = __builtin_amdgcn_s_memrealtime(); while (__builtin_amdgcn_s_memrealtime() - t1 < (unsigned long long)v) __builtin_amdgcn_s_sleep(8); } }
#endif
#ifdef PROBE_D
    if (PROBE_D >= 4) { xcd_barrier(bar);
        if (blockIdx.x == 0) { unsigned v = __hip_atomic_load((unsigned*)(F.ctl + 8 + (PROBE_D - 4)), RLX_AGENT); if (PROBE_D == 5 || PROBE_D == 8 || PROBE_D == 9) v /= 256u;
            const unsigned long long t1 = __builtin_amdgcn_s_memrealtime(); while (__builtin_amdgcn_s_memrealtime() - t1 < (unsigned long long)v) __builtin_amdgcn_s_sleep(8); } }
#endif
    if (PROBE_T) {
        xcd_barrier(bar);
        const unsigned long long t1 = __builtin_amdgcn_s_memrealtime();
        if (PROBE_T == 7) ts_[7] = t1;
        const unsigned long long dt = ts_[PROBE_T] - ts_[PROBE_T - 1];
        if (blockIdx.x == 0) while (__builtin_amdgcn_s_memrealtime() - t1 < dt) __builtin_amdgcn_s_sleep(8);
    }
}

extern "C" void kernel_launch(void* const* d_in, const int* in_sizes, int n_in, void* d_out, int out_size, void* d_ws, size_t ws_size, hipStream_t stream) {
    static int grid = 0;
    if (grid == 0) {
        if (n_in != 18 || out_size != M * DM || ws_size < WS_END) { fprintf(stderr, "kernel_launch: unexpected shapes (n_in %d out %d ws %zu)\n", n_in, out_size, ws_size); grid = -1; return; }
        int dev = 0, cus = 0, per_cu = 0;
        if (hipGetDevice(&dev) != hipSuccess || hipDeviceGetAttribute(&cus, hipDeviceAttributeMultiprocessorCount, dev) != hipSuccess) { grid = -1; return; }
        if (hipFuncSetAttribute((const void*)fwd_kernel, hipFuncAttributeMaxDynamicSharedMemorySize, LDS_BYTES) != hipSuccess) { fprintf(stderr, "kernel_launch: hipFuncSetAttribute failed\n"); grid = -1; return; }
        if (hipOccupancyMaxActiveBlocksPerMultiprocessor(&per_cu, (const void*)fwd_kernel, NT, LDS_BYTES) != hipSuccess || per_cu < 1) fprintf(stderr, "kernel_launch: occupancy query says %d\n", per_cu);
        (void)hipGetLastError();
        grid = cus;
    }
    if (grid < 0) return;
    (void)hipMemsetAsync((char*)d_ws + WS_CTL, 0, CTL_ZERO_BYTES, stream);
    Params p{};
    p.x = (const float*)d_in[0]; p.norm_g = (const float*)d_in[1]; p.w_in = (const float*)d_in[2]; p.conv_w = (const float*)d_in[3]; p.conv_b = (const float*)d_in[4];
    p.wa = (const float*)d_in[5]; p.ba = (const float*)d_in[6]; p.wx = (const float*)d_in[7]; p.bx = (const float*)d_in[8]; p.lam = (const float*)d_in[9];
    p.ckv_g = (const float*)d_in[10]; p.ikg = (const float*)d_in[11]; p.ikb = (const float*)d_in[12]; p.w_uk = (const float*)d_in[13]; p.w_uv = (const float*)d_in[14];
    p.w_out = (const float*)d_in[15]; p.rel_bias = (const float*)d_in[16]; p.fin_g = (const float*)d_in[17];
    p.out = (float*)d_out; p.ws = (unsigned char*)d_ws;
    hipLaunchKernelGGL(fwd_kernel, dim3(grid), dim3(NT), LDS_BYTES, stream, p);
}
```
